# Optimizing an MI355X kernel written in HIP

```python
import functools
import jax, jax.numpy as jnp
from jax import lax
import numpy as np

D_MODEL = 1024
BATCH = 8
SEQ = 4096
DEPTH = 1

GRID_W = 64
CTX_LEN = 256
EPS = 1e-6
N_MOD = 6
D_RNN = 1024
RG_BLOCKS = 8
RG_BLOCK = D_RNN // RG_BLOCKS
CONV_W = 4
CONV_PAD_L = 2
RG_C = 8.0
MLA_HEADS = 8
QK_NOPE = 64
QK_ROPE = 32
V_HEAD = 64
Q_LORA = 256
KV_LORA = 128
ROPE_BASE = 10000.0
ATTN_SCALE = (QK_NOPE + QK_ROPE) ** -0.5
Q_BLOCK = 128
N_BRANCH = 2
N_EXPERTS = 16
CAPACITY_FACTOR = 2
D_EXPERT = 1024
SPLIT_POINTS = (D_RNN, 2 * D_RNN, 2 * D_RNN + Q_LORA, 2 * D_RNN + Q_LORA + KV_LORA, 2 * D_RNN + Q_LORA + KV_LORA + QK_ROPE)
D_IN = 2 * D_RNN + Q_LORA + KV_LORA + QK_ROPE + N_BRANCH * D_MODEL

kernel_name = "hybrid_rglru_mla_ecmoe_diffusion_layer"


def rmsnorm(x, g):
    xf = x.astype(jnp.float32)
    y = xf * lax.rsqrt(jnp.mean(xf * xf, axis=-1, keepdims=True) + EPS)
    return (y * g.astype(jnp.float32)).astype(x.dtype)


def modulate(x, shift, scale):
    return x * (1 + scale) + shift


def axial_rope_tables(n_tokens, dtype):
    rows = n_tokens // GRID_W
    row = jnp.repeat(jnp.arange(rows, dtype=jnp.float32), GRID_W)
    col = jnp.tile(jnp.arange(GRID_W, dtype=jnp.float32), rows)
    n_pairs = QK_ROPE // 4
    inv_freq = ROPE_BASE ** (-jnp.arange(n_pairs, dtype=jnp.float32) / n_pairs)
    ang = jnp.concatenate([row[:, None] * inv_freq, col[:, None] * inv_freq], axis=-1)
    return jnp.cos(ang).astype(dtype), jnp.sin(ang).astype(dtype)


def apply_rope(x, cos, sin):
    x1, x2 = jnp.split(x, 2, axis=-1)
    return jnp.concatenate([x1 * cos - x2 * sin, x1 * sin + x2 * cos], axis=-1)


def centred_depthwise_conv(x, w, b):
    L = x.shape[1]
    xp = jnp.pad(x, ((0, 0), (CONV_PAD_L, CONV_W - 1 - CONV_PAD_L), (0, 0)))
    return sum(xp[:, k:k + L] * w[k] for k in range(CONV_W)) + b


def block_diag_linear(x, w, b):
    xb = x.reshape(*x.shape[:-1], RG_BLOCKS, RG_BLOCK)
    return jnp.einsum('blni,nij->blnj', xb, w).reshape(x.shape) + b


def rglru_coeffs(x, w_a, b_a, w_x, b_x, lam):
    r = jax.nn.sigmoid(block_diag_linear(x, w_a, b_a))
    i = jax.nn.sigmoid(block_diag_linear(x, w_x, b_x))
    log_a = -RG_C * r * jax.nn.softplus(-lam)
    a = jnp.exp(log_a)
    return a, jnp.sqrt(-jnp.expm1(2.0 * log_a)) * (i * x)


def linear_scan(a, b, h0, reverse):
    def comb(l, r):
        return (l[0] * r[0], r[0] * l[1] + r[1])
    a_cum, b_cum = lax.associative_scan(comb, (a, b), axis=1, reverse=reverse)
    return a_cum * h0[:, None, :] + b_cum


def rglru_bidir(xr_c, xr_l, p):
    B = xr_l.shape[0]
    hs_c, hs_l = [], []
    for d, rev in enumerate((False, True)):
        coeff = functools.partial(rglru_coeffs, w_a=p['rg_wa'][d], b_a=p['rg_ba'][d],
                                  w_x=p['rg_wx'][d], b_x=p['rg_bx'][d], lam=p['rg_lambda'][d])
        a_c, b_c = coeff(xr_c)
        h_c = linear_scan(a_c, b_c, jnp.zeros((B, D_RNN), jnp.float32), rev)
        h_last = h_c[:, 0] if rev else h_c[:, -1]
        a_l, b_l = coeff(xr_l)
        hs_c.append(h_c)
        hs_l.append(linear_scan(a_l, b_l, h_last, rev))
    return hs_c[0] + hs_c[1], hs_l[0] + hs_l[1]


def mla_queries(zq, p, cos, sin):
    B, L, _ = zq.shape
    q = (rmsnorm(zq, p['g_q_lora']) @ p['w_uq']).reshape(B, L, MLA_HEADS, QK_NOPE + QK_ROPE)
    q_nope = rmsnorm(q[..., :QK_NOPE], p['g_q_nope'])
    q_rope = rmsnorm(q[..., QK_NOPE:], p['g_q_rope'])
    if cos is not None:
        q_rope = apply_rope(q_rope, cos[:, None, :], sin[:, None, :])
    return q_nope, q_rope


def mla_keys(zkv, zkr, p, cos, sin):
    B, L, _ = zkv.shape
    ckv = rmsnorm(zkv, p['g_kv_lora'])
    k_nope = rmsnorm((ckv @ p['w_uk']).reshape(B, L, MLA_HEADS, QK_NOPE), p['g_k_nope'])
    v = (ckv @ p['w_uv']).reshape(B, L, MLA_HEADS, V_HEAD)
    k_rope = rmsnorm(zkr, p['g_k_rope'])
    if cos is not None:
        k_rope = apply_rope(k_rope, cos, sin)
    return k_nope, k_rope, v


def attend(q_nope, q_rope, k_nope, k_rope, v):
    s = (jnp.einsum('bqhd,bkhd->bhqk', q_nope, k_nope)
         + jnp.einsum('bqhr,bkr->bhqk', q_rope, k_rope)).astype(jnp.float32) * ATTN_SCALE
    prob = jax.nn.softmax(s, axis=-1).astype(v.dtype)
    return jnp.einsum('bhqk,bkhd->bqhd', prob, v)


def blocked_attention(q_nope, q_rope, k_nope, k_rope, v):
    B, L = q_nope.shape[:2]
    nb = L // Q_BLOCK

    def to_blocks(t):
        return jnp.moveaxis(t.reshape(B, nb, Q_BLOCK, *t.shape[2:]), 1, 0)

    out = lax.map(lambda qs: attend(qs[0], qs[1], k_nope, k_rope, v), (to_blocks(q_nope), to_blocks(q_rope)))
    return jnp.moveaxis(out, 0, 1).reshape(B, L, MLA_HEADS * V_HEAD)


def merge_branches(rnn, attn, zg, p):
    B, L, _ = zg.shape
    g = jax.nn.sigmoid(zg).reshape(B, L, N_BRANCH, D_MODEL)
    merged = g[:, :, 0] * (rnn @ p['w_rnn_out']) + g[:, :, 1] * (attn @ p['w_mla_out'])
    return merged @ p['w_o']


def ec_moe(h, p):
    B, L, _ = h.shape
    cap = CAPACITY_FACTOR * L // N_EXPERTS
    aff = jax.nn.softmax((h @ p['w_router']).astype(jnp.float32), axis=-1)
    gate, idx = lax.top_k(jnp.swapaxes(aff, 1, 2), cap)
    bidx = jnp.arange(B)[:, None, None]
    xg = h[bidx, idx]
    hid = jax.nn.silu(jnp.einsum('becd,edf->becf', xg, p['w_e_gate'])) * jnp.einsum('becd,edf->becf', xg, p['w_e_up'])
    y = jnp.einsum('becf,efd->becd', hid, p['w_e_down']) * gate[..., None].astype(h.dtype)
    return jnp.zeros_like(h).at[bidx, idx].add(y)


def layer(x, ctx, c, c_ctx, p, update_ctx):
    B, S, _ = x.shape
    Lc = ctx.shape[1]
    mod_l = jnp.split((jax.nn.silu(c) @ p['w_ada'] + p['b_ada'])[:, None, :], N_MOD, axis=-1)
    mod_c = jnp.split(jax.nn.silu(c_ctx) @ p['w_ada'] + p['b_ada'], N_MOD, axis=-1)
    cos, sin = axial_rope_tables(S, x.dtype)

    z_l = jnp.split(modulate(rmsnorm(x, p['g_norm1']), mod_l[0], mod_l[1]) @ p['w_in'], SPLIT_POINTS, axis=-1)
    z_c = jnp.split(modulate(rmsnorm(ctx, p['g_norm1']), mod_c[0], mod_c[1]) @ p['w_in'], SPLIT_POINTS, axis=-1)

    xr_l = centred_depthwise_conv(z_l[0], p['conv_w'], p['conv_b']).astype(jnp.float32)
    xr_c = centred_depthwise_conv(z_c[0], p['conv_w'], p['conv_b']).astype(jnp.float32)
    h_c, h_l = rglru_bidir(xr_c, xr_l, p)
    rnn_l = (h_l * jax.nn.gelu(z_l[1].astype(jnp.float32))).astype(x.dtype)

    qn_l, qr_l = mla_queries(z_l[2], p, cos, sin)
    kn_l, kr_l, v_l = mla_keys(z_l[3], z_l[4], p, cos, sin)
    kn_c, kr_c, v_c = mla_keys(z_c[3], z_c[4], p, None, None)
    attn_l = blocked_attention(qn_l, qr_l, jnp.concatenate([kn_c, kn_l], axis=1),
                               jnp.concatenate([kr_c, kr_l], axis=1), jnp.concatenate([v_c, v_l], axis=1))

    x_new = x + mod_l[2] * merge_branches(rnn_l, attn_l, z_l[5], p)
    x_new = x_new + mod_l[5] * ec_moe(modulate(rmsnorm(x_new, p['g_norm2']), mod_l[3], mod_l[4]), p)

    if update_ctx:
        rnn_c = (h_c * jax.nn.gelu(z_c[1].astype(jnp.float32))).astype(ctx.dtype)
        qn_c, qr_c = mla_queries(z_c[2], p, None, None)
        attn_c = attend(qn_c, qr_c, kn_c, kr_c, v_c).reshape(B, Lc, MLA_HEADS * V_HEAD)
        ctx = ctx + mod_c[2] * merge_branches(rnn_c, attn_c, z_c[5], p)
        ctx = ctx + mod_c[5] * ec_moe(modulate(rmsnorm(ctx, p['g_norm2']), mod_c[3], mod_c[4]), p)
    return x_new, ctx


def setup_inputs(seed: int = 0) -> dict:
    key = jax.random.key(seed)
    ks = iter(jax.random.split(key, 40))

    def nrm(shape, fan_in, scale=1.0):
        return scale * fan_in ** -0.5 * jax.random.normal(next(ks), shape, jnp.float32)

    def gain(shape):
        return 1.0 + 0.05 * jax.random.normal(next(ks), shape, jnp.float32)

    def small(shape):
        return 0.02 * jax.random.normal(next(ks), shape, jnp.float32)

    a0 = jax.random.uniform(next(ks), (DEPTH, 2, D_RNN), jnp.float32, minval=0.9, maxval=0.999)
    return {
        "x": jax.random.normal(next(ks), (BATCH, SEQ, D_MODEL), jnp.float32),
        "c": jax.random.normal(next(ks), (BATCH, D_MODEL), jnp.float32),
        "ctx": jax.random.normal(next(ks), (BATCH, CTX_LEN, D_MODEL), jnp.float32),
        "c_ctx": jax.random.normal(next(ks), (D_MODEL,), jnp.float32),
        "w_ada": nrm((DEPTH, D_MODEL, N_MOD * D_MODEL), D_MODEL, 0.5),
        "b_ada": small((DEPTH, N_MOD * D_MODEL)),
        "g_norm1": gain((DEPTH, D_MODEL)),
        "g_norm2": gain((DEPTH, D_MODEL)),
        "w_in": nrm((DEPTH, D_MODEL, D_IN), D_MODEL),
        "conv_w": nrm((DEPTH, CONV_W, D_RNN), CONV_W),
        "conv_b": small((DEPTH, D_RNN)),
        "rg_wa": nrm((DEPTH, 2, RG_BLOCKS, RG_BLOCK, RG_BLOCK), RG_BLOCK),
        "rg_ba": small((DEPTH, 2, D_RNN)),
        "rg_wx": nrm((DEPTH, 2, RG_BLOCKS, RG_BLOCK, RG_BLOCK), RG_BLOCK),
        "rg_bx": small((DEPTH, 2, D_RNN)),
        "rg_lambda": jnp.log(a0) - jnp.log1p(-a0),
        "w_rnn_out": nrm((DEPTH, D_RNN, D_MODEL), D_RNN),
        "g_q_lora": gain((DEPTH, Q_LORA)),
        "w_uq": nrm((DEPTH, Q_LORA, MLA_HEADS * (QK_NOPE + QK_ROPE)), Q_LORA),
        "g_kv_lora": gain((DEPTH, KV_LORA)),
        "w_uk": nrm((DEPTH, KV_LORA, MLA_HEADS * QK_NOPE), KV_LORA),
        "w_uv": nrm((DEPTH, KV_LORA, MLA_HEADS * V_HEAD), KV_LORA),
        "g_q_nope": gain((DEPTH, QK_NOPE)),
        "g_q_rope": gain((DEPTH, QK_ROPE)),
        "g_k_nope": gain((DEPTH, QK_NOPE)),
        "g_k_rope": gain((DEPTH, QK_ROPE)),
        "w_mla_out": nrm((DEPTH, MLA_HEADS * V_HEAD, D_MODEL), MLA_HEADS * V_HEAD),
        "w_o": nrm((DEPTH, D_MODEL, D_MODEL), D_MODEL),
        "w_router": nrm((DEPTH, D_MODEL, N_EXPERTS), D_MODEL),
        "w_e_gate": nrm((DEPTH, N_EXPERTS, D_MODEL, D_EXPERT), D_MODEL),
        "w_e_up": nrm((DEPTH, N_EXPERTS, D_MODEL, D_EXPERT), D_MODEL),
        "w_e_down": nrm((DEPTH, N_EXPERTS, D_EXPERT, D_MODEL), D_EXPERT),
    }


def reference(x, c, ctx, c_ctx, w_ada, b_ada, g_norm1, g_norm2, w_in, conv_w, conv_b, rg_wa, rg_ba, rg_wx, rg_bx,
              rg_lambda, w_rnn_out, g_q_lora, w_uq, g_kv_lora, w_uk, w_uv, g_q_nope, g_q_rope, g_k_nope, g_k_rope,
              w_mla_out, w_o, w_router, w_e_gate, w_e_up, w_e_down):
    for l in range(DEPTH):
        p = dict(w_ada=w_ada[l], b_ada=b_ada[l], g_norm1=g_norm1[l], g_norm2=g_norm2[l], w_in=w_in[l],
                 conv_w=conv_w[l], conv_b=conv_b[l], rg_wa=rg_wa[l], rg_ba=rg_ba[l], rg_wx=rg_wx[l],
                 rg_bx=rg_bx[l], rg_lambda=rg_lambda[l], w_rnn_out=w_rnn_out[l], g_q_lora=g_q_lora[l],
                 w_uq=w_uq[l], g_kv_lora=g_kv_lora[l], w_uk=w_uk[l], w_uv=w_uv[l], g_q_nope=g_q_nope[l],
                 g_q_rope=g_q_rope[l], g_k_nope=g_k_nope[l], g_k_rope=g_k_rope[l], w_mla_out=w_mla_out[l],
                 w_o=w_o[l], w_router=w_router[l], w_e_gate=w_e_gate[l], w_e_up=w_e_up[l], w_e_down=w_e_down[l])
        x, ctx = layer(x, ctx, c, c_ctx, p, l < DEPTH - 1)
    return x
```

```cpp
#include <hip/hip_runtime.h>
#include <stdint.h>
#include <stdio.h>

#define DEVI __device__ __forceinline__
typedef unsigned short bf16_t;
typedef float f32x4 __attribute__((ext_vector_type(4)));
typedef unsigned u32x4 __attribute__((ext_vector_type(4)));
typedef unsigned u32x2 __attribute__((ext_vector_type(2)));

constexpr int NTHR = 512;
constexpr int DM = 1024, NB = 8, SEQ = 4096, CTXL = 256;
constexpr int NLAT = NB * SEQ, NCTX = NB * CTXL, NROW = NLAT + NCTX, NKEY = SEQ + CTXL;
constexpr int NE = 16, CAP = 512;
constexpr float EPS = 1e-6f;
constexpr float QSCALE = 0.10206207261596575f * 1.4426950408889634f;

constexpr size_t MiB = 1u << 20;
constexpr size_t WS_CTL = 0;
constexpr size_t WS_MOD = 1 * MiB;
constexpr size_t WS_ROPE = WS_MOD + 256 * 1024;
constexpr size_t WS_SP = WS_ROPE + 4096;
constexpr size_t WS_SMAX = WS_SP + 8192;
constexpr size_t WS_RSTDQ = 1 * MiB + 512 * 1024;
constexpr size_t WS_RSTDKV = WS_RSTDQ + 128 * 1024;
constexpr size_t WS_WIN = 2 * MiB;
constexpr size_t WS_WRNN = 11 * MiB;
constexpr size_t WS_WMLA = 13 * MiB;
constexpr size_t WS_WO = 14 * MiB;
constexpr size_t WS_RNNSUM = 18 * MiB;
constexpr size_t WS_AFF = 27 * MiB;
constexpr size_t WS_IDX = 29 * MiB;
constexpr size_t WS_GATE = WS_IDX + 256 * 1024;
constexpr size_t WS_SLOT = WS_GATE + 256 * 1024;
constexpr size_t WS_A = 32 * MiB;
constexpr size_t WS_ZRNN = 100 * MiB;
constexpr size_t WS_GELU = 168 * MiB;
constexpr size_t WS_ZQ = 232 * MiB;
constexpr size_t WS_ZKVR = 248 * MiB;
constexpr size_t WS_ATTN = 232 * MiB;
constexpr size_t WS_G = 265 * MiB;
constexpr size_t WS_K = 393 * MiB;
constexpr size_t WS_VT = 444 * MiB;
constexpr size_t WS_HID = 265 * MiB;
constexpr size_t WS_Y = 100 * MiB;
constexpr size_t WS_WGU = 393 * MiB;
constexpr size_t WS_WD = 457 * MiB;
constexpr size_t WS_HF = 393 * MiB;
constexpr size_t WS_END = 489 * MiB;

struct P {
    const float *x, *c, *ctx, *c_ctx, *w_ada, *b_ada, *g_norm1, *g_norm2, *w_in, *conv_w, *conv_b, *rg_wa, *rg_ba, *rg_wx, *rg_bx, *rg_lambda,
        *w_rnn_out, *g_q_lora, *w_uq, *g_kv_lora, *w_uk, *w_uv, *g_q_nope, *g_q_rope, *g_k_nope, *g_k_rope, *w_mla_out, *w_o, *w_router, *w_e_gate,
        *w_e_up, *w_e_down;
    float* out;
    unsigned char* ws;
};

DEVI unsigned f2bf(float f) { unsigned u = __float_as_uint(f); return (u + 0x7fffu + ((u >> 16) & 1u)) >> 16; }
DEVI unsigned pk2(float lo, float hi) { return f2bf(lo) | (f2bf(hi) << 16); }
DEVI float bflo(unsigned u) { return __uint_as_float(u << 16); }
DEVI float bfhi(unsigned u) { return __uint_as_float(u & 0xffff0000u); }
DEVI float bf2f(bf16_t h) { return __uint_as_float(((unsigned)h) << 16); }
DEVI float wave_sum(float v) {
#pragma unroll
    for (int o = 32; o > 0; o >>= 1) v += __shfl_xor(v, o);
    return v;
}
DEVI float sigm(float x) { return 1.f / (1.f + __expf(-x)); }
DEVI float gelu_tanh(float x) { const float u = 0.7978845608028654f * (x + 0.044715f * x * x * x); return x * sigm(2.f * u); }
DEVI void store4bf(bf16_t* o, f32x4 v) { u32x2 w; w.x = pk2(v.x, v.y); w.y = pk2(v.z, v.w); *(u32x2*)o = w; }
DEVI f32x4 load4bf(const bf16_t* o) { const u32x2 w = *(const u32x2*)o; return (f32x4){bflo(w.x), bfhi(w.x), bflo(w.y), bfhi(w.y)}; }
DEVI float dot8(u32x4 a, u32x4 b, float acc) {
    acc = fmaf(bflo(a.x), bflo(b.x), acc); acc = fmaf(bfhi(a.x), bfhi(b.x), acc);
    acc = fmaf(bflo(a.y), bflo(b.y), acc); acc = fmaf(bfhi(a.y), bfhi(b.y), acc);
    acc = fmaf(bflo(a.z), bflo(b.z), acc); acc = fmaf(bfhi(a.z), bfhi(b.z), acc);
    acc = fmaf(bflo(a.w), bflo(b.w), acc); acc = fmaf(bfhi(a.w), bfhi(b.w), acc);
    return acc;
}
#define LDS_WAIT() asm volatile("s_waitcnt lgkmcnt(0)" ::: "memory")

template <class RM>
DEVI void transpose_item(const float* W, int ldw, int K, bf16_t* WT, RM rm, float* scr, int k0, int n0, int lane) {
#pragma unroll 8
    for (int i = 0; i < 32; ++i) { const int kk = 2 * i + (lane >> 5); scr[kk * 33 + (lane & 31)] = W[(size_t)(k0 + kk) * ldw + n0 + (lane & 31)]; }
    LDS_WAIT();
    const int c = lane & 7;
#pragma unroll
    for (int j = 0; j < 4; ++j) {
        const int n = (lane >> 3) + 8 * j; const float* s = scr + (8 * c) * 33 + n;
        u32x4 o; o.x = pk2(s[0 * 33], s[1 * 33]); o.y = pk2(s[2 * 33], s[3 * 33]); o.z = pk2(s[4 * 33], s[5 * 33]); o.w = pk2(s[6 * 33], s[7 * 33]);
        *(u32x4*)(WT + (size_t)rm(n0 + n) * K + k0 + 8 * c) = o;
    }
    LDS_WAIT();
}
struct RmId { DEVI int operator()(int n) const { return n; } };
struct RmWin { DEVI int operator()(int n) const { return n < 2464 ? n : n + 96; } };
struct RmGU { int up; DEVI int operator()(int n) const { return (n >> 4) * 32 + (n & 15) + up * 16; } };

DEVI void phase_prep(const P& p, int bid, int nblk, unsigned char* lds) {
    const int tid = threadIdx.x, lane = tid & 63, wave = tid >> 6;
    float* mod = (float*)(p.ws + WS_MOD);
    if (bid < 192) {
        float* sc = (float*)lds; float* red = sc + 9 * 1024;
        for (int i = tid; i < 9 * 1024; i += NTHR) { const int r = i >> 10, k = i & 1023; const float v = r < 8 ? p.c[r * 1024 + k] : p.c_ctx[k]; sc[i] = v * sigm(v); }
        __syncthreads();
        for (int item = bid; item < 192; item += nblk) {
            const int n0 = item * 32, col = tid & 31, kg = tid >> 5;
            float acc[9];
#pragma unroll
            for (int r = 0; r < 9; ++r) acc[r] = 0.f;
            for (int kk = 0; kk < 64; ++kk) {
                const int k = kg * 64 + kk; const float w = p.w_ada[(size_t)k * 6144 + n0 + col];
#pragma unroll
                for (int r = 0; r < 9; ++r) acc[r] = fmaf(sc[r * 1024 + k], w, acc[r]);
            }
#pragma unroll
            for (int r = 0; r < 9; ++r) red[(kg * 9 + r) * 32 + col] = acc[r];
            __syncthreads();
            if (tid < 9 * 32) { const int r = tid >> 5, cc = tid & 31; float s = 0.f; for (int g = 0; g < 16; ++g) s += red[(g * 9 + r) * 32 + cc]; mod[r * 6144 + n0 + cc] = s + p.b_ada[n0 + cc]; }
            __syncthreads();
        }
    }
    __syncthreads();
    if (bid == nblk - 1) {
        float* rope = (float*)(p.ws + WS_ROPE); float* sp = (float*)(p.ws + WS_SP); float* smax = (float*)(p.ws + WS_SMAX);
        { const int pos = tid >> 3, j = tid & 7; const float inv = powf(10000.f, -(float)j / 8.f); const float ang = (float)pos * inv;
          const float n = rintf(ang * 0.15915494309189535f); float r = fmaf(-n, 6.2831854820251465f, ang); r = fmaf(-n, -1.7484555e-7f, r);
          rope[2 * tid] = __cosf(r); rope[2 * tid + 1] = __sinf(r); }
        for (int i = tid; i < 2048; i += NTHR) { const float lam = p.rg_lambda[i]; sp[i] = 8.f * log1pf(__expf(-lam)); }
        if (tid == 0) {
            float a = 0.f, b = 0.f, cc = 0.f, d = 0.f;
            for (int i = 0; i < 64; ++i) { a = fmaxf(a, fabsf(p.g_q_nope[i])); cc = fmaxf(cc, fabsf(p.g_k_nope[i])); }
            for (int i = 0; i < 32; ++i) { b = fmaxf(b, fabsf(p.g_q_rope[i])); d = fmaxf(d, fabsf(p.g_k_rope[i])); }
            smax[0] = (64.f * a * cc + 32.f * b * d) * QSCALE * 1.01f + 0.5f;
        }
    }
    { u32x4* z = (u32x4*)(p.ws + WS_WIN + (size_t)2464 * 1024 * 2); const u32x4 zero = {0u, 0u, 0u, 0u};
      for (int i = bid * NTHR + tid; i < 96 * 1024 * 2 / 16; i += nblk * NTHR) z[i] = zero; }
    float* scr = (float*)lds + wave * (64 * 33);
    const int gw = bid * 8 + wave, NGW = nblk * 8;
    constexpr int I_WIN = 16 * 141, I_RNN = 16 * 32, I_MLA = 8 * 32, I_WO = 16 * 32;
    for (int it = gw; it < I_WIN + I_RNN + I_MLA + I_WO; it += NGW) {
        int r = it;
        if (r < I_WIN) { transpose_item(p.w_in, 4512, 1024, (bf16_t*)(p.ws + WS_WIN), RmWin(), scr, 64 * (r / 141), 32 * (r % 141), lane); continue; } r -= I_WIN;
        if (r < I_RNN) { transpose_item(p.w_rnn_out, 1024, 1024, (bf16_t*)(p.ws + WS_WRNN), RmId(), scr, 64 * (r / 32), 32 * (r % 32), lane); continue; } r -= I_RNN;
        if (r < I_MLA) { transpose_item(p.w_mla_out, 1024, 512, (bf16_t*)(p.ws + WS_WMLA), RmId(), scr, 64 * (r / 32), 32 * (r % 32), lane); continue; } r -= I_MLA;
        transpose_item(p.w_o, 1024, 1024, (bf16_t*)(p.ws + WS_WO), RmId(), scr, 64 * (r / 32), 32 * (r % 32), lane);
    }
}

DEVI void phase_expert_convert(const P& p, int bid, int nblk, unsigned char* lds) {
    const int tid = threadIdx.x, lane = tid & 63, wave = tid >> 6;
    float* scr = (float*)lds + wave * (64 * 33);
    const int gw = bid * 8 + wave, NGW = nblk * 8;
    for (int it = gw; it < 3 * 16 * 512; it += NGW) {
        const int which = it / 8192, r = it % 8192, e = r / 512, t = r % 512, k0 = 64 * (t / 32), n0 = 32 * (t % 32);
        if (which == 0) transpose_item(p.w_e_gate + (size_t)e * 1048576, 1024, 1024, (bf16_t*)(p.ws + WS_WGU) + (size_t)e * 2048 * 1024, RmGU{0}, scr, k0, n0, lane);
        else if (which == 1) transpose_item(p.w_e_up + (size_t)e * 1048576, 1024, 1024, (bf16_t*)(p.ws + WS_WGU) + (size_t)e * 2048 * 1024, RmGU{1}, scr, k0, n0, lane);
        else transpose_item(p.w_e_down + (size_t)e * 1048576, 1024, 1024, (bf16_t*)(p.ws + WS_WD) + (size_t)e * 1024 * 1024, RmId(), scr, k0, n0, lane);
    }
}

DEVI void phase_norm1(const P& p, int bid, int nblk) {
    const int tid = threadIdx.x, lane = tid & 63, wave = tid >> 6;
    const float* mod = (const float*)(p.ws + WS_MOD);
    bf16_t* A1 = (bf16_t*)(p.ws + WS_A);
    for (int m = bid * 8 + wave; m < NROW; m += nblk * 8) {
        const float* src = m < NLAT ? p.x + (size_t)m * 1024 : p.ctx + (size_t)(m - NLAT) * 1024;
        const int mr = m < NLAT ? (m >> 12) : 8;
        const f32x4* xr = (const f32x4*)src + lane;
        f32x4 v[4]; float s = 0.f;
#pragma unroll
        for (int j = 0; j < 4; ++j) { v[j] = xr[64 * j]; s += v[j].x * v[j].x + v[j].y * v[j].y + v[j].z * v[j].z + v[j].w * v[j].w; }
        const float rstd = rsqrtf(wave_sum(s) * (1.f / 1024.f) + EPS);
        u32x2* o = (u32x2*)(A1 + (size_t)m * 1024) + lane;
#pragma unroll
        for (int j = 0; j < 4; ++j) {
            const int k = 4 * (lane + 64 * j);
            const f32x4 g = *(const f32x4*)(p.g_norm1 + k), sh = *(const f32x4*)(mod + mr * 6144 + k), sc = *(const f32x4*)(mod + mr * 6144 + 1024 + k);
            const f32x4 y = (v[j] * rstd * g) * (sc + 1.f) + sh;
            u32x2 w; w.x = pk2(y.x, y.y); w.y = pk2(y.z, y.w); o[64 * j] = w;
        }
    }
}

template <class G>
DEVI void gemm_naive(const G& g, int bid, int nblk) {
    const int tid = threadIdx.x;
    for (int u = bid; u < g.nunits(); u += nblk) {
        const typename G::U U = g.unit(u);
        for (int sub = 0; sub < g.nsub(); ++sub) {
            const int K = g.K(U, sub);
            const bf16_t* B = g.bbase(U, sub);
            for (int it = tid; it < 2048; it += NTHR) {
                const int q = it & 31, rg = it >> 5, c0 = (q >> 2) * 32 + (q & 3) * 4;
                float acc[4][8];
#pragma unroll
                for (int i = 0; i < 4; ++i)
#pragma unroll
                    for (int j = 0; j < 8; ++j) acc[i][j] = 0.f;
                const bf16_t* a0 = g.arow(U, sub, rg * 4 + 0); const bf16_t* a1 = g.arow(U, sub, rg * 4 + 1);
                const bf16_t* a2 = g.arow(U, sub, rg * 4 + 2); const bf16_t* a3 = g.arow(U, sub, rg * 4 + 3);
                for (int k = 0; k < K; k += 8) {
                    const u32x4 x0 = *(const u32x4*)(a0 + k), x1 = *(const u32x4*)(a1 + k), x2 = *(const u32x4*)(a2 + k), x3 = *(const u32x4*)(a3 + k);
#pragma unroll
                    for (int j = 0; j < 8; ++j) {
                        const int n = c0 + (j & 3) + (j >> 2) * 16;
                        const u32x4 b = *(const u32x4*)(B + (size_t)n * K + k);
                        acc[0][j] = dot8(x0, b, acc[0][j]); acc[1][j] = dot8(x1, b, acc[1][j]); acc[2][j] = dot8(x2, b, acc[2][j]); acc[3][j] = dot8(x3, b, acc[3][j]);
                    }
                }
#pragma unroll
                for (int i = 0; i < 4; ++i)
                    g.epi(U, sub, rg * 4 + i, c0, (f32x4){acc[i][0], acc[i][1], acc[i][2], acc[i][3]}, (f32x4){acc[i][4], acc[i][5], acc[i][6], acc[i][7]});
            }
        }
    }
}

struct G1 {
    const bf16_t* A; const bf16_t* Bt; bf16_t *zrnn, *zgelu, *zq, *zkvr, *g;
    struct U { int pm, pn; };
    DEVI int nunits() const { return 128 * 18 + 8 * 5; }
    DEVI int nsub() const { return 1; }
    DEVI U unit(int u) const { U r; if (u < 2304) { r.pm = u / 18; r.pn = u % 18; } else { const int v = u - 2304, j = v % 5; r.pm = 128 + v / 5; r.pn = j < 4 ? j : 9; } return r; }
    DEVI int K(const U&, int) const { return 1024; }
    DEVI const bf16_t* arow(const U& u, int, int r) const { return A + (size_t)(u.pm * 256 + r) * 1024; }
    DEVI const bf16_t* bbase(const U& u, int) const { return Bt + (size_t)u.pn * 256 * 1024; }
    DEVI void epi(const U& u, int, int r, int c0, f32x4 v0, f32x4 v1) const {
        const size_t row = (size_t)u.pm * 256 + r;
        if (u.pn < 4) { bf16_t* o = zrnn + row * 1024 + u.pn * 256 + c0; store4bf(o, v0); store4bf(o + 16, v1); }
        else if (u.pn < 8) {
            bf16_t* o = zgelu + row * 1024 + (u.pn - 4) * 256 + c0;
            store4bf(o, (f32x4){gelu_tanh(v0.x), gelu_tanh(v0.y), gelu_tanh(v0.z), gelu_tanh(v0.w)});
            store4bf(o + 16, (f32x4){gelu_tanh(v1.x), gelu_tanh(v1.y), gelu_tanh(v1.z), gelu_tanh(v1.w)});
        } else if (u.pn == 8) { bf16_t* o = zq + row * 256 + c0; store4bf(o, v0); store4bf(o + 16, v1); }
        else if (u.pn == 9) { bf16_t* o = zkvr + row * 256 + c0; store4bf(o, v0); store4bf(o + 16, v1); }
        else {
            bf16_t* o = g + row * 2048 + (u.pn - 10) * 256 + c0;
            store4bf(o, (f32x4){sigm(v0.x), sigm(v0.y), sigm(v0.z), sigm(v0.w)});
            store4bf(o + 16, (f32x4){sigm(v1.x), sigm(v1.y), sigm(v1.z), sigm(v1.w)});
        }
    }
};

struct G2 {
    const bf16_t *rnn, *attn, *WrT, *WmT, *g; bf16_t* merged;
    struct U { int pm, pn; };
    DEVI int nunits() const { return 128 * 4; }
    DEVI int nsub() const { return 2; }
    DEVI U unit(int u) const { U r; r.pm = u >> 2; r.pn = u & 3; return r; }
    DEVI int K(const U&, int sub) const { return sub ? 512 : 1024; }
    DEVI const bf16_t* arow(const U& u, int sub, int r) const { const size_t row = (size_t)u.pm * 256 + r; return sub ? attn + row * 512 : rnn + row * 1024; }
    DEVI const bf16_t* bbase(const U& u, int sub) const { return sub ? WmT + (size_t)u.pn * 256 * 512 : WrT + (size_t)u.pn * 256 * 1024; }
    DEVI void epi(const U& u, int sub, int r, int c0, f32x4 v0, f32x4 v1) const {
        const size_t row = (size_t)u.pm * 256 + r; const int col = u.pn * 256 + c0;
        const bf16_t* gp = g + row * 2048 + sub * 1024 + col; bf16_t* o = merged + row * 1024 + col;
        f32x4 r0 = load4bf(gp) * v0, r1 = load4bf(gp + 16) * v1;
        if (sub) { r0 += load4bf(o); r1 += load4bf(o + 16); }
        store4bf(o, r0); store4bf(o + 16, r1);
    }
};

struct G3 {
    const bf16_t *A, *Bt; const float *x, *mod; float* out;
    struct U { int pm, pn; };
    DEVI int nunits() const { return 128 * 4; }
    DEVI int nsub() const { return 1; }
    DEVI U unit(int u) const { U r; r.pm = u >> 2; r.pn = u & 3; return r; }
    DEVI int K(const U&, int) const { return 1024; }
    DEVI const bf16_t* arow(const U& u, int, int r) const { return A + (size_t)(u.pm * 256 + r) * 1024; }
    DEVI const bf16_t* bbase(const U& u, int) const { return Bt + (size_t)u.pn * 256 * 1024; }
    DEVI void epi(const U& u, int, int r, int c0, f32x4 v0, f32x4 v1) const {
        const size_t row = (size_t)u.pm * 256 + r; const int col = u.pn * 256 + c0; const int b = (int)(row >> 12);
        const float* mp = mod + b * 6144 + 2048 + col; const float* xp = x + row * 1024 + col; float* o = out + row * 1024 + col;
        *(f32x4*)o = *(const f32x4*)xp + *(const f32x4*)mp * v0;
        *(f32x4*)(o + 16) = *(const f32x4*)(xp + 16) + *(const f32x4*)(mp + 16) * v1;
    }
};

struct GM1 {
    const bf16_t *h, *Wgu; const int* idx; bf16_t* hid;
    struct U { int be, pm, pn; };
    DEVI int nunits() const { return 128 * 16; }
    DEVI int nsub() const { return 1; }
    DEVI U unit(int u) const { U r; r.be = u >> 4; r.pm = (u >> 3) & 1; r.pn = u & 7; return r; }
    DEVI int K(const U&, int) const { return 1024; }
    DEVI const bf16_t* arow(const U& u, int, int r) const { const int t = idx[u.be * 512 + u.pm * 256 + r]; return h + ((size_t)(u.be >> 4) * 4096 + t) * 1024; }
    DEVI const bf16_t* bbase(const U& u, int) const { return Wgu + ((size_t)(u.be & 15) * 2048 + u.pn * 256) * 1024; }
    DEVI void epi(const U& u, int, int r, int c0, f32x4 v0, f32x4 v1) const {
        const int hidx = u.pn * 128 + (c0 >> 5) * 16 + (c0 & 15);
        bf16_t* o = hid + ((size_t)u.be * 512 + u.pm * 256 + r) * 1024 + hidx;
        store4bf(o, (f32x4){v0.x * sigm(v0.x) * v1.x, v0.y * sigm(v0.y) * v1.y, v0.z * sigm(v0.z) * v1.z, v0.w * sigm(v0.w) * v1.w});
    }
};

struct GM2 {
    const bf16_t *hid, *Wd; const float* gate; bf16_t* Y;
    struct U { int be, pm, pn; };
    DEVI int nunits() const { return 128 * 8; }
    DEVI int nsub() const { return 1; }
    DEVI U unit(int u) const { U r; r.be = u >> 3; r.pm = (u >> 2) & 1; r.pn = u & 3; return r; }
    DEVI int K(const U&, int) const { return 1024; }
    DEVI const bf16_t* arow(const U& u, int, int r) const { return hid + ((size_t)u.be * 512 + u.pm * 256 + r) * 1024; }
    DEVI const bf16_t* bbase(const U& u, int) const { return Wd + ((size_t)(u.be & 15) * 1024 + u.pn * 256) * 1024; }
    DEVI void epi(const U& u, int, int r, int c0, f32x4 v0, f32x4 v1) const {
        const size_t row = (size_t)u.be * 512 + u.pm * 256 + r; const float gt = gate[row];
        bf16_t* o = Y + row * 1024 + u.pn * 256 + c0;
        store4bf(o, v0 * gt); store4bf(o + 16, v1 * gt);
    }
};

DEVI void phase_conv_naive(const P& p, int bid, int nblk) {
    const bf16_t* z = (const bf16_t*)(p.ws + WS_ZRNN); bf16_t* xr = (bf16_t*)(p.ws + WS_A);
    for (size_t i = (size_t)bid * NTHR + threadIdx.x; i < (size_t)NROW * 256; i += (size_t)nblk * NTHR) {
        const int m = (int)(i >> 8), c4 = (int)(i & 255) * 4;
        int pos, len; if (m < NLAT) { pos = m & 4095; len = SEQ; } else { pos = (m - NLAT) & 255; len = CTXL; }
        f32x4 acc = *(const f32x4*)(p.conv_b + c4);
#pragma unroll
        for (int k = 0; k < 4; ++k) { const int q = pos - 2 + k; if (q >= 0 && q < len) acc += *(const f32x4*)(p.conv_w + k * 1024 + c4) * load4bf(z + (size_t)(m - 2 + k) * 1024 + c4); }
        store4bf(xr + (size_t)m * 1024 + c4, acc);
    }
}

template <int DIR>
DEVI void phase_scan_naive(const P& p, int bid, int nblk) {
    const bf16_t* xr = (const bf16_t*)(p.ws + WS_A); bf16_t* hf = (bf16_t*)(p.ws + WS_HF); bf16_t* gl = (bf16_t*)(p.ws + WS_GELU);
    const float* sp = (const float*)(p.ws + WS_SP);
    for (int id = bid * NTHR + threadIdx.x; id < NB * 1024 * 2; id += nblk * NTHR) {
        const int half = id & 1, b = id >> 11, ch = (id >> 1) & 1023, blk = ch >> 7, j = ch & 127;
        const float* wa = p.rg_wa + ((size_t)(DIR * 8 + blk) * 128 + half * 64) * 128 + j; const float* wx = p.rg_wx + ((size_t)(DIR * 8 + blk) * 128 + half * 64) * 128 + j;
        unsigned w[64];
#pragma unroll
        for (int i = 0; i < 64; ++i) w[i] = pk2(wa[i * 128], wx[i * 128]);
        const float ba = p.rg_ba[DIR * 1024 + ch], bx = p.rg_bx[DIR * 1024 + ch], spv = sp[DIR * 1024 + ch];
        float h = 0.f;
        for (int step = 0; step < NKEY; ++step) {
            int m;
            if (step < CTXL) m = NLAT + b * CTXL + (DIR ? CTXL - 1 - step : step);
            else m = b * SEQ + (DIR ? SEQ - 1 - (step - CTXL) : (step - CTXL));
            const u32x4* xp = (const u32x4*)(xr + (size_t)m * 1024 + blk * 128 + half * 64);
            float ar = 0.f, ai = 0.f;
#pragma unroll
            for (int q = 0; q < 8; ++q) {
                const u32x4 v = xp[q];
                ar = fmaf(bflo(v.x), bflo(w[8 * q + 0]), ar); ai = fmaf(bflo(v.x), bfhi(w[8 * q + 0]), ai);
                ar = fmaf(bfhi(v.x), bflo(w[8 * q + 1]), ar); ai = fmaf(bfhi(v.x), bfhi(w[8 * q + 1]), ai);
                ar = fmaf(bflo(v.y), bflo(w[8 * q + 2]), ar); ai = fmaf(bflo(v.y), bfhi(w[8 * q + 2]), ai);
                ar = fmaf(bfhi(v.y), bflo(w[8 * q + 3]), ar); ai = fmaf(bfhi(v.y), bfhi(w[8 * q + 3]), ai);
                ar = fmaf(bflo(v.z), bflo(w[8 * q + 4]), ar); ai = fmaf(bflo(v.z), bfhi(w[8 * q + 4]), ai);
                ar = fmaf(bfhi(v.z), bflo(w[8 * q + 5]), ar); ai = fmaf(bfhi(v.z), bfhi(w[8 * q + 5]), ai);
                ar = fmaf(bflo(v.w), bflo(w[8 * q + 6]), ar); ai = fmaf(bflo(v.w), bfhi(w[8 * q + 6]), ai);
                ar = fmaf(bfhi(v.w), bflo(w[8 * q + 7]), ar); ai = fmaf(bfhi(v.w), bfhi(w[8 * q + 7]), ai);
            }
            ar = ar + __shfl_xor(ar, 1) + ba; ai = ai + __shfl_xor(ai, 1) + bx;
            const float xo = bf2f(xr[(size_t)m * 1024 + ch]);
            const float r = sigm(ar), ig = sigm(ai), la = -spv * r, a = __expf(la);
            const float bc = sqrtf(fmaxf(-expm1f(2.f * la), 0.f)) * ig * xo;
            h = fmaf(a, h, bc);
            if (step >= CTXL && half == 0) {
                if (DIR == 0) hf[(size_t)m * 1024 + ch] = (bf16_t)f2bf(h);
                else { const size_t o = (size_t)m * 1024 + ch; gl[o] = (bf16_t)f2bf((bf2f(hf[o]) + h) * bf2f(gl[o])); }
            }
        }
    }
}

DEVI void phase_mla_pre(const P& p, int bid, int nblk) {
    const int tid = threadIdx.x, lane = tid & 63, wave = tid >> 6;
    const bf16_t* zq = (const bf16_t*)(p.ws + WS_ZQ); const bf16_t* zkvr = (const bf16_t*)(p.ws + WS_ZKVR);
    float* rq = (float*)(p.ws + WS_RSTDQ); float* rkv = (float*)(p.ws + WS_RSTDKV); bf16_t* Kb = (bf16_t*)(p.ws + WS_K);
    const float* rope = (const float*)(p.ws + WS_ROPE);
    for (int m = bid * 8 + wave; m < NROW; m += nblk * 8) {
        if (m < NLAT) { const f32x4 v = load4bf(zq + (size_t)m * 256 + 4 * lane); const float s = wave_sum(v.x * v.x + v.y * v.y + v.z * v.z + v.w * v.w); if (lane == 0) rq[m] = rsqrtf(s * (1.f / 256.f) + EPS); }
        const bf16_t* zr = zkvr + (size_t)m * 256;
        float s1 = 0.f; if (lane < 32) { const f32x4 v = load4bf(zr + 4 * lane); s1 = v.x * v.x + v.y * v.y + v.z * v.z + v.w * v.w; }
        s1 = wave_sum(s1); if (lane == 0) rkv[m] = rsqrtf(s1 * (1.f / 128.f) + EPS);
        float e = 0.f; if (lane < 32) { e = bf2f(zr[128 + lane]); }
        const float s2 = wave_sum(e * e); const float rkr = rsqrtf(s2 * (1.f / 32.f) + EPS);
        if (lane < 16) {
            const float y1 = bf2f(zr[128 + lane]) * rkr * p.g_k_rope[lane], y2 = bf2f(zr[128 + 16 + lane]) * rkr * p.g_k_rope[16 + lane];
            float cs = 1.f, sn = 0.f; int b, key;
            if (m < NLAT) { const int t = m & 4095; b = m >> 12; key = CTXL + t; const int pos = lane < 8 ? (t >> 6) : (t & 63); cs = rope[(pos * 8 + (lane & 7)) * 2]; sn = rope[(pos * 8 + (lane & 7)) * 2 + 1]; }
            else { b = (m - NLAT) >> 8; key = (m - NLAT) & 255; }
            const bf16_t o1 = (bf16_t)f2bf(y1 * cs - y2 * sn), o2 = (bf16_t)f2bf(y1 * sn + y2 * cs);
#pragma unroll
            for (int h = 0; h < 8; ++h) { bf16_t* kp = Kb + ((size_t)(b * 8 + h) * NKEY + key) * 96 + 64; kp[lane] = o1; kp[16 + lane] = o2; }
        }
    }
}

DEVI void phase_mla_q_naive(const P& p, int bid, int nblk) {
    const bf16_t* zq = (const bf16_t*)(p.ws + WS_ZQ); const float* rq = (const float*)(p.ws + WS_RSTDQ); bf16_t* Q = (bf16_t*)(p.ws + WS_A);
    const float* rope = (const float*)(p.ws + WS_ROPE);
    for (int id = bid * NTHR + threadIdx.x; id < NLAT * 8; id += nblk * NTHR) {
        const int m = id >> 3, h = id & 7, b = m >> 12, t = m & 4095;
        float acc[96];
#pragma unroll
        for (int j = 0; j < 96; ++j) acc[j] = 0.f;
        const float rs = rq[m];
        for (int k = 0; k < 256; ++k) {
            const float c = bf2f(zq[(size_t)m * 256 + k]) * rs * p.g_q_lora[k];
            const f32x4* wp = (const f32x4*)(p.w_uq + (size_t)k * 768 + h * 96);
#pragma unroll
            for (int j = 0; j < 24; ++j) { const f32x4 w = wp[j]; acc[4 * j] = fmaf(c, w.x, acc[4 * j]); acc[4 * j + 1] = fmaf(c, w.y, acc[4 * j + 1]); acc[4 * j + 2] = fmaf(c, w.z, acc[4 * j + 2]); acc[4 * j + 3] = fmaf(c, w.w, acc[4 * j + 3]); }
        }
        float s = 0.f;
#pragma unroll
        for (int j = 0; j < 64; ++j) s = fmaf(acc[j], acc[j], s);
        const float r1 = rsqrtf(s * (1.f / 64.f) + EPS) * QSCALE;
        float s2 = 0.f;
#pragma unroll
        for (int j = 64; j < 96; ++j) s2 = fmaf(acc[j], acc[j], s2);
        const float r2 = rsqrtf(s2 * (1.f / 32.f) + EPS) * QSCALE;
        bf16_t* qo = Q + ((size_t)(b * 8 + h) * SEQ + t) * 96;
#pragma unroll
        for (int j = 0; j < 64; j += 2) *(unsigned*)(qo + j) = pk2(acc[j] * r1 * p.g_q_nope[j], acc[j + 1] * r1 * p.g_q_nope[j + 1]);
        float o[32];
#pragma unroll
        for (int i = 0; i < 16; ++i) {
            const int pos = i < 8 ? (t >> 6) : (t & 63); const float cs = rope[(pos * 8 + (i & 7)) * 2], sn = rope[(pos * 8 + (i & 7)) * 2 + 1];
            const float y1 = acc[64 + i] * r2 * p.g_q_rope[i], y2 = acc[80 + i] * r2 * p.g_q_rope[16 + i];
            o[i] = y1 * cs - y2 * sn; o[16 + i] = y1 * sn + y2 * cs;
        }
#pragma unroll
        for (int j = 0; j < 32; j += 2) *(unsigned*)(qo + 64 + j) = pk2(o[j], o[j + 1]);
    }
}

DEVI void phase_mla_kv_naive(const P& p, int bid, int nblk) {
    const bf16_t* zkvr = (const bf16_t*)(p.ws + WS_ZKVR); const float* rkv = (const float*)(p.ws + WS_RSTDKV);
    bf16_t* Kb = (bf16_t*)(p.ws + WS_K); bf16_t* VT = (bf16_t*)(p.ws + WS_VT);
    for (int id = bid * NTHR + threadIdx.x; id < NROW * 8; id += nblk * NTHR) {
        const int m = id >> 3, h = id & 7;
        int b, key; if (m < NLAT) { b = m >> 12; key = CTXL + (m & 4095); } else { b = (m - NLAT) >> 8; key = (m - NLAT) & 255; }
        float ak[64], av[64];
#pragma unroll
        for (int j = 0; j < 64; ++j) { ak[j] = 0.f; av[j] = 0.f; }
        const float rs = rkv[m];
        for (int k = 0; k < 128; ++k) {
            const float c = bf2f(zkvr[(size_t)m * 256 + k]) * rs * p.g_kv_lora[k];
            const f32x4* wk = (const f32x4*)(p.w_uk + (size_t)k * 512 + h * 64); const f32x4* wv = (const f32x4*)(p.w_uv + (size_t)k * 512 + h * 64);
#pragma unroll
            for (int j = 0; j < 16; ++j) {
                const f32x4 a = wk[j], v = wv[j];
                ak[4 * j] = fmaf(c, a.x, ak[4 * j]); ak[4 * j + 1] = fmaf(c, a.y, ak[4 * j + 1]); ak[4 * j + 2] = fmaf(c, a.z, ak[4 * j + 2]); ak[4 * j + 3] = fmaf(c, a.w, ak[4 * j + 3]);
                av[4 * j] = fmaf(c, v.x, av[4 * j]); av[4 * j + 1] = fmaf(c, v.y, av[4 * j + 1]); av[4 * j + 2] = fmaf(c, v.z, av[4 * j + 2]); av[4 * j + 3] = fmaf(c, v.w, av[4 * j + 3]);
            }
        }
        float s = 0.f;
#pragma unroll
        for (int j = 0; j < 64; ++j) s = fmaf(ak[j], ak[j], s);
        const float r1 = rsqrtf(s * (1.f / 64.f) + EPS);
        bf16_t* ko = Kb + ((size_t)(b * 8 + h) * NKEY + key) * 96;
#pragma unroll
        for (int j = 0; j < 64; j += 2) *(unsigned*)(ko + j) = pk2(ak[j] * r1 * p.g_k_nope[j], ak[j + 1] * r1 * p.g_k_nope[j + 1]);
        bf16_t* vo = VT + ((size_t)(b * 8 + h) * 64) * NKEY + key;
#pragma unroll
        for (int j = 0; j < 64; ++j) vo[(size_t)j * NKEY] = (bf16_t)f2bf(av[j]);
    }
}

DEVI void phase_attn_naive(const P& p, int bid, int nblk) {
    const bf16_t* Q = (const bf16_t*)(p.ws + WS_A); const bf16_t* Kb = (const bf16_t*)(p.ws + WS_K); const bf16_t* VT = (const bf16_t*)(p.ws + WS_VT);
    bf16_t* O = (bf16_t*)(p.ws + WS_ATTN); const float shift = ((const float*)(p.ws + WS_SMAX))[0];
    for (int id = bid * NTHR + threadIdx.x; id < NB * 8 * SEQ; id += nblk * NTHR) {
        const int bh = id >> 12, t = id & 4095;
        float q[96];
        { const u32x4* qp = (const u32x4*)(Q + (size_t)id * 96);
#pragma unroll
          for (int j = 0; j < 12; ++j) { const u32x4 v = qp[j]; q[8 * j] = bflo(v.x); q[8 * j + 1] = bfhi(v.x); q[8 * j + 2] = bflo(v.y); q[8 * j + 3] = bfhi(v.y); q[8 * j + 4] = bflo(v.z); q[8 * j + 5] = bfhi(v.z); q[8 * j + 6] = bflo(v.w); q[8 * j + 7] = bfhi(v.w); } }
        float o[64];
#pragma unroll
        for (int j = 0; j < 64; ++j) o[j] = 0.f;
        float l = 0.f;
        const bf16_t* kp = Kb + (size_t)bh * NKEY * 96; const bf16_t* vp = VT + (size_t)bh * 64 * NKEY;
        for (int k0 = 0; k0 < NKEY; k0 += 8) {
            float pr[8];
#pragma unroll
            for (int kk = 0; kk < 8; ++kk) {
                const u32x4* kr = (const u32x4*)(kp + (size_t)(k0 + kk) * 96); float s = 0.f;
#pragma unroll
                for (int j = 0; j < 12; ++j) { const u32x4 v = kr[j];
                    s = fmaf(q[8 * j], bflo(v.x), s); s = fmaf(q[8 * j + 1], bfhi(v.x), s); s = fmaf(q[8 * j + 2], bflo(v.y), s); s = fmaf(q[8 * j + 3], bfhi(v.y), s);
                    s = fmaf(q[8 * j + 4], bflo(v.z), s); s = fmaf(q[8 * j + 5], bfhi(v.z), s); s = fmaf(q[8 * j + 6], bflo(v.w), s); s = fmaf(q[8 * j + 7], bfhi(v.w), s); }
                pr[kk] = exp2f(s - shift); l += pr[kk];
            }
#pragma unroll
            for (int d = 0; d < 64; ++d) {
                const u32x4 v = *(const u32x4*)(vp + (size_t)d * NKEY + k0); float a = o[d];
                a = fmaf(pr[0], bflo(v.x), a); a = fmaf(pr[1], bfhi(v.x), a); a = fmaf(pr[2], bflo(v.y), a); a = fmaf(pr[3], bfhi(v.y), a);
                a = fmaf(pr[4], bflo(v.z), a); a = fmaf(pr[5], bfhi(v.z), a); a = fmaf(pr[6], bflo(v.w), a); a = fmaf(pr[7], bfhi(v.w), a);
                o[d] = a;
            }
        }
        const float inv = 1.f / l; const int b = bh >> 3, h = bh & 7;
        bf16_t* op = O + ((size_t)(b * SEQ + t)) * 512 + h * 64;
#pragma unroll
        for (int d = 0; d < 64; d += 2) *(unsigned*)(op + d) = pk2(o[d] * inv, o[d + 1] * inv);
    }
}

DEVI void phase_norm2_router(const P& p, int bid, int nblk, unsigned char* lds) {
    const int tid = threadIdx.x, lane = tid & 63, wave = tid >> 6;
    float* wrT = (float*)lds;
    for (int i = tid; i < 16384; i += NTHR) { const int k = i >> 4, e = i & 15; wrT[e * 1024 + k] = p.w_router[i]; }
    __syncthreads();
    const float* mod = (const float*)(p.ws + WS_MOD); bf16_t* hb = (bf16_t*)(p.ws + WS_A); float* aff = (float*)(p.ws + WS_AFF);
    for (int m = bid * 8 + wave; m < NLAT; m += nblk * 8) {
        const int b = m >> 12, t = m & 4095;
        const f32x4* xr = (const f32x4*)(p.out + (size_t)m * 1024) + lane;
        f32x4 v[4]; float s = 0.f;
#pragma unroll
        for (int j = 0; j < 4; ++j) { v[j] = xr[64 * j]; s += v[j].x * v[j].x + v[j].y * v[j].y + v[j].z * v[j].z + v[j].w * v[j].w; }
        const float rstd = rsqrtf(wave_sum(s) * (1.f / 1024.f) + EPS);
        u32x2* o = (u32x2*)(hb + (size_t)m * 1024) + lane;
#pragma unroll
        for (int j = 0; j < 4; ++j) {
            const int k = 4 * (lane + 64 * j);
            const f32x4 g = *(const f32x4*)(p.g_norm2 + k), sh = *(const f32x4*)(mod + b * 6144 + 3072 + k), sc = *(const f32x4*)(mod + b * 6144 + 4096 + k);
            v[j] = (v[j] * rstd * g) * (sc + 1.f) + sh;
            u32x2 w; w.x = pk2(v[j].x, v[j].y); w.y = pk2(v[j].z, v[j].w); o[64 * j] = w;
        }
        float lg[16];
#pragma unroll
        for (int e = 0; e < 16; ++e) {
            float a = 0.f;
#pragma unroll
            for (int j = 0; j < 4; ++j) { const f32x4 w = *(const f32x4*)(wrT + e * 1024 + 4 * (lane + 64 * j)); a += v[j].x * w.x + v[j].y * w.y + v[j].z * w.z + v[j].w * w.w; }
            lg[e] = wave_sum(a);
            asm volatile("" ::: "memory");
        }
        float mx = lg[0];
#pragma unroll
        for (int e = 1; e < 16; ++e) mx = fmaxf(mx, lg[e]);
        float den = 0.f;
#pragma unroll
        for (int e = 0; e < 16; ++e) { lg[e] = expf(lg[e] - mx); den += lg[e]; }
        const float inv = 1.f / den;
        float mine = 0.f;
#pragma unroll
        for (int e = 0; e < 16; ++e) mine = (lane == e) ? lg[e] * inv : mine;
        if (lane < 16) aff[((size_t)(b * 16 + lane)) * 4096 + t] = mine;
    }
}

DEVI void phase_topk(const P& p, int bid, int nblk, unsigned char* lds) {
    const int tid = threadIdx.x, lane = tid & 63, wave = tid >> 6;
    unsigned* hist = (unsigned*)lds; unsigned* sh = hist + 256;
    const float* aff = (const float*)(p.ws + WS_AFF); int* idx = (int*)(p.ws + WS_IDX); float* gate = (float*)(p.ws + WS_GATE); int* slot_of = (int*)(p.ws + WS_SLOT);
    for (int item = bid; item < NB * NE; item += nblk) {
        const float* a = aff + (size_t)item * 4096 + tid * 8;
        unsigned u[8];
        { const u32x4 t0 = *(const u32x4*)a, t1 = *(const u32x4*)(a + 4); u[0] = t0.x; u[1] = t0.y; u[2] = t0.z; u[3] = t0.w; u[4] = t1.x; u[5] = t1.y; u[6] = t1.z; u[7] = t1.w; }
        unsigned prefix = 0u, mask = 0u, need = CAP;
        for (int pass = 0; pass < 4; ++pass) {
            const int shift = 24 - 8 * pass;
            if (tid < 256) hist[tid] = 0u;
            __syncthreads();
#pragma unroll
            for (int j = 0; j < 8; ++j) if ((u[j] & mask) == prefix) atomicAdd(&hist[(u[j] >> shift) & 255u], 1u);
            __syncthreads();
            if (tid == 0) { unsigned cum = 0u; int bsel = 255; for (; bsel > 0; --bsel) { const unsigned hc = hist[bsel]; if (cum + hc >= need) break; cum += hc; } sh[0] = (unsigned)bsel; sh[1] = need - cum; }
            __syncthreads();
            prefix |= sh[0] << shift; mask |= 255u << shift; need = sh[1];
            __syncthreads();
        }
        const unsigned T = prefix;
        unsigned cg = 0u, ce = 0u;
#pragma unroll
        for (int j = 0; j < 8; ++j) { cg += (u[j] > T) ? 1u : 0u; ce += (u[j] == T) ? 1u : 0u; }
        const unsigned packed = cg | (ce << 16);
        unsigned incl = packed;
#pragma unroll
        for (int o = 1; o < 64; o <<= 1) { const unsigned n = __shfl_up(incl, o); if (lane >= o) incl += n; }
        if (lane == 63) sh[8 + wave] = incl;
        __syncthreads();
        unsigned woff = 0u;
        for (int w = 0; w < wave; ++w) woff += sh[8 + w];
        const unsigned excl = incl - packed + woff;
        unsigned gb = excl & 0xffffu, eb = excl >> 16;
#pragma unroll
        for (int j = 0; j < 8; ++j) {
            const int i = tid * 8 + j; const bool gt = u[j] > T, eq = u[j] == T;
            int slot = -1;
            if (gt) slot = (int)(gb + (eb < need ? eb : need));
            else if (eq && eb < need) slot = (int)(gb + eb);
            if (slot >= 0) { idx[item * CAP + slot] = i; gate[item * CAP + slot] = __uint_as_float(u[j]); }
            slot_of[(size_t)item * 4096 + i] = slot;
            gb += gt ? 1u : 0u; eb += eq ? 1u : 0u;
        }
        __syncthreads();
    }
}

DEVI void phase_combine(const P& p, int bid, int nblk) {
    const int tid = threadIdx.x, lane = tid & 63, wave = tid >> 6;
    const float* mod = (const float*)(p.ws + WS_MOD); const int* slot_of = (const int*)(p.ws + WS_SLOT); const bf16_t* Y = (const bf16_t*)(p.ws + WS_Y);
    for (int m = bid * 8 + wave; m < NLAT; m += nblk * 8) {
        const int b = m >> 12, t = m & 4095;
        f32x4 acc[4];
#pragma unroll
        for (int j = 0; j < 4; ++j) acc[j] = (f32x4){0.f, 0.f, 0.f, 0.f};
        for (int e = 0; e < NE; ++e) {
            const int s = slot_of[((size_t)(b * 16 + e)) * 4096 + t];
            if (s >= 0) {
                const u32x2* yp = (const u32x2*)(Y + ((size_t)(b * 16 + e) * CAP + s) * 1024) + lane;
#pragma unroll
                for (int j = 0; j < 4; ++j) { const u32x2 w = yp[64 * j]; acc[j] += (f32x4){bflo(w.x), bfhi(w.x), bflo(w.y), bfhi(w.y)}; }
            }
        }
        f32x4* op = (f32x4*)(p.out + (size_t)m * 1024) + lane;
#pragma unroll
        for (int j = 0; j < 4; ++j) { const f32x4 md = *(const f32x4*)(mod + b * 6144 + 5120 + 4 * (lane + 64 * j)); op[64 * j] = op[64 * j] + md * acc[j]; }
    }
}

template <int PH>
DEVI void run_phase(const P& p, int bid, int nblk, unsigned char* lds) {
    if (PH == 0) phase_prep(p, bid, nblk, lds);
    if (PH == 1) phase_norm1(p, bid, nblk);
    if (PH == 2) { G1 g{(const bf16_t*)(p.ws + WS_A), (const bf16_t*)(p.ws + WS_WIN), (bf16_t*)(p.ws + WS_ZRNN), (bf16_t*)(p.ws + WS_GELU), (bf16_t*)(p.ws + WS_ZQ), (bf16_t*)(p.ws + WS_ZKVR), (bf16_t*)(p.ws + WS_G)}; gemm_naive(g, bid, nblk); }
    if (PH == 3) phase_conv_naive(p, bid, nblk);
    if (PH == 4) phase_scan_naive<0>(p, bid, nblk);
    if (PH == 5) phase_scan_naive<1>(p, bid, nblk);
    if (PH == 6) phase_mla_pre(p, bid, nblk);
    if (PH == 7) { phase_mla_q_naive(p, bid, nblk); phase_mla_kv_naive(p, bid, nblk); }
    if (PH == 8) phase_attn_naive(p, bid, nblk);
    if (PH == 9) phase_expert_convert(p, bid, nblk, lds);
    if (PH == 10) { G2 g{(const bf16_t*)(p.ws + WS_GELU), (const bf16_t*)(p.ws + WS_ATTN), (const bf16_t*)(p.ws + WS_WRNN), (const bf16_t*)(p.ws + WS_WMLA), (const bf16_t*)(p.ws + WS_G), (bf16_t*)(p.ws + WS_A)}; gemm_naive(g, bid, nblk); }
    if (PH == 11) { G3 g{(const bf16_t*)(p.ws + WS_A), (const bf16_t*)(p.ws + WS_WO), p.x, (const float*)(p.ws + WS_MOD), p.out}; gemm_naive(g, bid, nblk); }
    if (PH == 12) phase_norm2_router(p, bid, nblk, lds);
    if (PH == 13) phase_topk(p, bid, nblk, lds);
    if (PH == 14) { GM1 g{(const bf16_t*)(p.ws + WS_A), (const bf16_t*)(p.ws + WS_WGU), (const int*)(p.ws + WS_IDX), (bf16_t*)(p.ws + WS_HID)}; gemm_naive(g, bid, nblk); }
    if (PH == 15) { GM2 g{(const bf16_t*)(p.ws + WS_HID), (const bf16_t*)(p.ws + WS_WD), (const float*)(p.ws + WS_GATE), (bf16_t*)(p.ws + WS_Y)}; gemm_naive(g, bid, nblk); }
    if (PH == 16) phase_combine(p, bid, nblk);
}

constexpr int LDS_BYTES = 70 * 1024;
template <int PH>
__global__ void __launch_bounds__(NTHR, 2) k_phase(P p) {
    extern __shared__ __attribute__((aligned(16))) unsigned char lds[];
    run_phase<PH>(p, (int)blockIdx.x, (int)gridDim.x, lds);
}

template <int PH>
static void launch_phase(const P& p, int grid, hipStream_t stream) {
    static bool attr = false;
    if (!attr) { (void)hipFuncSetAttribute((const void*)k_phase<PH>, hipFuncAttributeMaxDynamicSharedMemorySize, LDS_BYTES); attr = true; }
    hipLaunchKernelGGL(k_phase<PH>, dim3(grid), dim3(NTHR), LDS_BYTES, stream, p);
}

extern "C" void kernel_launch(void* const* d_in, const int* in_sizes, int n_in, void* d_out, int out_size, void* d_ws, size_t ws_size, hipStream_t stream) {
    if (n_in != 32 || ws_size < WS_END) { fprintf(stderr, "kernel_launch: unexpected n_in %d / ws_size %zu\n", n_in, ws_size); return; }
    P p{};
    const float** fp = (const float**)&p;
    for (int i = 0; i < 32; ++i) fp[i] = (const float*)d_in[i];
    p.out = (float*)d_out; p.ws = (unsigned char*)d_ws;
    (void)hipMemsetAsync((char*)d_ws + WS_CTL, 0, 1 * MiB, stream);
    const int G = 1024;
    launch_phase<0>(p, G, stream);
    launch_phase<1>(p, G, stream);
    launch_phase<2>(p, G, stream);
    launch_phase<3>(p, G, stream);
    launch_phase<4>(p, G, stream);
    launch_phase<5>(p, G, stream);
    launch_phase<6>(p, G, stream);
    launch_phase<7>(p, G, stream);
    launch_phase<8>(p, G, stream);
    launch_phase<9>(p, G, stream);
    launch_phase<10>(p, G, stream);
    launch_phase<11>(p, G, stream);
    launch_phase<12>(p, G, stream);
    launch_phase<13>(p, G, stream);
    launch_phase<14>(p, G, stream);
    launch_phase<15>(p, G, stream);
    launch_phase<16>(p, G, stream);
}
```

```cpp
#include <hip/hip_runtime.h>
#include <stdint.h>
#include <stdio.h>

#define DEVI __device__ __forceinline__
typedef unsigned short bf16_t;
typedef float f32x4 __attribute__((ext_vector_type(4)));
typedef unsigned u32x4 __attribute__((ext_vector_type(4)));
typedef unsigned u32x2 __attribute__((ext_vector_type(2)));

constexpr int NTHR = 512;
constexpr int DM = 1024, NB = 8, SEQ = 4096, CTXL = 256;
constexpr int NLAT = NB * SEQ, NCTX = NB * CTXL, NROW = NLAT + NCTX, NKEY = SEQ + CTXL;
constexpr int NE = 16, CAP = 512;
constexpr float EPS = 1e-6f;
constexpr float QSCALE = 0.10206207261596575f * 1.4426950408889634f;

constexpr size_t MiB = 1u << 20;
constexpr size_t WS_CTL = 0;
constexpr size_t WS_MOD = 1 * MiB;
constexpr size_t WS_ROPE = WS_MOD + 256 * 1024;
constexpr size_t WS_SP = WS_ROPE + 4096;
constexpr size_t WS_SMAX = WS_SP + 8192;
constexpr size_t WS_RSTDQ = 1 * MiB + 512 * 1024;
constexpr size_t WS_RSTDKV = WS_RSTDQ + 128 * 1024;
constexpr size_t WS_WIN = 2 * MiB;
constexpr size_t WS_WRNN = 11 * MiB;
constexpr size_t WS_WMLA = 13 * MiB;
constexpr size_t WS_WO = 14 * MiB;
constexpr size_t WS_WUQ = 16 * MiB;
constexpr size_t WS_WUK = WS_WUQ + 384 * 1024;
constexpr size_t WS_WUV = WS_WUK + 256 * 1024;
constexpr size_t WS_WRG = 17 * MiB;
constexpr size_t WS_RNNSUM = 18 * MiB;
constexpr size_t WS_AFF = 27 * MiB;
constexpr size_t WS_IDX = 29 * MiB;
constexpr size_t WS_GATE = WS_IDX + 256 * 1024;
constexpr size_t WS_SLOT = WS_GATE + 256 * 1024;
constexpr size_t WS_A = 32 * MiB;
constexpr size_t WS_ZRNN = 100 * MiB;
constexpr size_t WS_GELU = 168 * MiB;
constexpr size_t WS_ZQ = 232 * MiB;
constexpr size_t WS_ZKVR = 248 * MiB;
constexpr size_t WS_ATTN = 232 * MiB;
constexpr size_t WS_G = 265 * MiB;
constexpr size_t WS_K = 393 * MiB;
constexpr size_t WS_VT = 444 * MiB;
constexpr size_t WS_HID = 265 * MiB;
constexpr size_t WS_Y = 100 * MiB;
constexpr size_t WS_WGU = 393 * MiB;
constexpr size_t WS_WD = 457 * MiB;
constexpr size_t WS_HF = 393 * MiB;
constexpr size_t WS_END = 489 * MiB;

struct P {
    const float *x, *c, *ctx, *c_ctx, *w_ada, *b_ada, *g_norm1, *g_norm2, *w_in, *conv_w, *conv_b, *rg_wa, *rg_ba, *rg_wx, *rg_bx, *rg_lambda,
        *w_rnn_out, *g_q_lora, *w_uq, *g_kv_lora, *w_uk, *w_uv, *g_q_nope, *g_q_rope, *g_k_nope, *g_k_rope, *w_mla_out, *w_o, *w_router, *w_e_gate,
        *w_e_up, *w_e_down;
    float* out;
    unsigned char* ws;
};

DEVI unsigned f2bf(float f) { unsigned u = __float_as_uint(f); return (u + 0x7fffu + ((u >> 16) & 1u)) >> 16; }
typedef __bf16 bf16v2 __attribute__((ext_vector_type(2)));
typedef float f32x2 __attribute__((ext_vector_type(2)));
DEVI unsigned pk2(float lo, float hi) { const f32x2 v = {lo, hi}; return __builtin_bit_cast(unsigned, __builtin_convertvector(v, bf16v2)); }
DEVI float bflo(unsigned u) { return __uint_as_float(u << 16); }
DEVI float bfhi(unsigned u) { return __uint_as_float(u & 0xffff0000u); }
DEVI float bf2f(bf16_t h) { return __uint_as_float(((unsigned)h) << 16); }
DEVI float wave_sum(float v) {
#pragma unroll
    for (int o = 32; o > 0; o >>= 1) v += __shfl_xor(v, o);
    return v;
}
DEVI float sigm(float x) { return __builtin_amdgcn_rcpf(1.f + __builtin_amdgcn_exp2f(-1.4426950408889634f * x)); }
DEVI float gelu_tanh(float x) { const float u = 0.7978845608028654f * (x + 0.044715f * x * x * x); return x * sigm(2.f * u); }
DEVI void store4bf(bf16_t* o, f32x4 v) { u32x2 w; w.x = pk2(v.x, v.y); w.y = pk2(v.z, v.w); *(u32x2*)o = w; }
DEVI f32x4 load4bf(const bf16_t* o) { const u32x2 w = *(const u32x2*)o; return (f32x4){bflo(w.x), bfhi(w.x), bflo(w.y), bfhi(w.y)}; }
DEVI float dot8(u32x4 a, u32x4 b, float acc) {
    acc = fmaf(bflo(a.x), bflo(b.x), acc); acc = fmaf(bfhi(a.x), bfhi(b.x), acc);
    acc = fmaf(bflo(a.y), bflo(b.y), acc); acc = fmaf(bfhi(a.y), bfhi(b.y), acc);
    acc = fmaf(bflo(a.z), bflo(b.z), acc); acc = fmaf(bfhi(a.z), bfhi(b.z), acc);
    acc = fmaf(bflo(a.w), bflo(b.w), acc); acc = fmaf(bfhi(a.w), bfhi(b.w), acc);
    return acc;
}
constexpr int LDS_BYTES = 147456;
constexpr int MISC_OFF = LDS_BYTES - 512;
DEVI unsigned hw_slot_() { return (unsigned)__builtin_amdgcn_s_getreg((5 << 11) | 4) & 63u; }
DEVI int tid_() {
    extern __shared__ __attribute__((aligned(16))) unsigned char lds_dyn_[];
    int w = (int)((volatile __attribute__((address_space(3))) unsigned*)((__attribute__((address_space(3))) unsigned char*)lds_dyn_ + MISC_OFF))[32 + hw_slot_()];
    w = __builtin_amdgcn_readfirstlane(w);
    int t = w * 64 + (int)__builtin_amdgcn_mbcnt_hi(~0u, __builtin_amdgcn_mbcnt_lo(~0u, 0u));
    asm volatile("" : "+v"(t));
    return t;
}
#define LDS_WAIT() asm volatile("s_waitcnt lgkmcnt(0)" ::: "memory")

template <class RM>
DEVI void transpose_item(const float* W, int ldw, int K, bf16_t* WT, RM rm, float* scr, int k0, int n0, int lane, const float* kscale = nullptr) {
#pragma unroll 8
    for (int i = 0; i < 32; ++i) { const int kk = 2 * i + (lane >> 5); float v = W[(size_t)(k0 + kk) * ldw + n0 + (lane & 31)]; if (kscale) v *= kscale[k0 + kk]; scr[kk * 33 + (lane & 31)] = v; }
    LDS_WAIT();
    const int c = lane & 7;
#pragma unroll
    for (int j = 0; j < 4; ++j) {
        const int n = (lane >> 3) + 8 * j; const float* s = scr + (8 * c) * 33 + n;
        u32x4 o; o.x = pk2(s[0 * 33], s[1 * 33]); o.y = pk2(s[2 * 33], s[3 * 33]); o.z = pk2(s[4 * 33], s[5 * 33]); o.w = pk2(s[6 * 33], s[7 * 33]);
        *(u32x4*)(WT + (size_t)rm(n0 + n) * K + k0 + 8 * c) = o;
    }
    LDS_WAIT();
}
struct RmId { DEVI int operator()(int n) const { return n; } };
struct RmWin { DEVI int operator()(int n) const { return n < 2464 ? n : n + 96; } };
struct RmUq { DEVI int operator()(int n) const { const int head = n / 96, dd = n % 96; return dd < 64 ? (head >> 2) * 256 + 128 * (dd >> 5) + 32 * (head & 3) + (dd & 31) : 512 + 128 * (head >> 2) + 32 * (head & 3) + (dd - 64); } };
struct RmUk { DEVI int operator()(int n) const { const int head = n >> 6, d = n & 63; return (head >> 2) * 256 + 128 * (d >> 5) + 32 * (head & 3) + (d & 31); } };
struct RmGU { int up; DEVI int operator()(int n) const { return (n >> 4) * 32 + (n & 15) + up * 16; } };

DEVI void phase_prep(const P& p, int bid, int nblk, unsigned char* lds) {
    const int tid = tid_(), lane = tid & 63, wave = tid >> 6;
    float* mod = (float*)(p.ws + WS_MOD);
    if (bid < 192) {
        float* sc = (float*)lds; float* red = sc + 9 * 1024;
        for (int i = tid; i < 9 * 1024; i += NTHR) { const int r = i >> 10, k = i & 1023; const float v = r < 8 ? p.c[r * 1024 + k] : p.c_ctx[k]; sc[i] = v * sigm(v); }
        __syncthreads();
        for (int item = bid; item < 192; item += nblk) {
            const int n0 = item * 32, col = tid & 31, kg = tid >> 5;
            float acc[9];
#pragma unroll
            for (int r = 0; r < 9; ++r) acc[r] = 0.f;
            for (int kk = 0; kk < 64; ++kk) {
                const int k = kg * 64 + kk; const float w = p.w_ada[(size_t)k * 6144 + n0 + col];
#pragma unroll
                for (int r = 0; r < 9; ++r) acc[r] = fmaf(sc[r * 1024 + k], w, acc[r]);
            }
#pragma unroll
            for (int r = 0; r < 9; ++r) red[(kg * 9 + r) * 32 + col] = acc[r];
            __syncthreads();
            if (tid < 9 * 32) { const int r = tid >> 5, cc = tid & 31; float s = 0.f; for (int g = 0; g < 16; ++g) s += red[(g * 9 + r) * 32 + cc]; mod[r * 6144 + n0 + cc] = s + p.b_ada[n0 + cc]; }
            __syncthreads();
        }
    }
    __syncthreads();
    if (bid == nblk - 1) {
        float* rope = (float*)(p.ws + WS_ROPE); float* sp = (float*)(p.ws + WS_SP); float* smax = (float*)(p.ws + WS_SMAX);
        { const int pos = tid >> 3, j = tid & 7; const float inv = powf(10000.f, -(float)j / 8.f); const float ang = (float)pos * inv;
          const float n = rintf(ang * 0.15915494309189535f); float r = fmaf(-n, 6.2831854820251465f, ang); r = fmaf(-n, -1.7484555e-7f, r);
          rope[2 * tid] = __cosf(r); rope[2 * tid + 1] = __sinf(r); }
        for (int i = tid; i < 2048; i += NTHR) { const float lam = p.rg_lambda[i]; sp[i] = 8.f * log1pf(__expf(-lam)); }
        if (tid == 0) {
            float a = 0.f, b = 0.f, cc = 0.f, d = 0.f;
            for (int i = 0; i < 64; ++i) { a = fmaxf(a, fabsf(p.g_q_nope[i])); cc = fmaxf(cc, fabsf(p.g_k_nope[i])); }
            for (int i = 0; i < 32; ++i) { b = fmaxf(b, fabsf(p.g_q_rope[i])); d = fmaxf(d, fabsf(p.g_k_rope[i])); }
            smax[0] = (64.f * a * cc + 32.f * b * d) * QSCALE * 1.01f + 0.5f;
        }
    }
    { u32x4* z = (u32x4*)(p.ws + WS_WIN + (size_t)2464 * 1024 * 2); const u32x4 zero = {0u, 0u, 0u, 0u};
      for (int i = bid * NTHR + tid; i < 96 * 1024 * 2 / 16; i += nblk * NTHR) z[i] = zero; }
    { const u32x4 zero = {0u, 0u, 0u, 0u};
      for (int i = bid * NTHR + tid; i < 1024 * 16; i += nblk * NTHR) *(u32x4*)(p.ws + WS_WUK + (size_t)(i >> 4) * 512 + 256 + (i & 15) * 16) = zero; }
    float* scr = (float*)lds + wave * (64 * 33);
    const int gw = bid * 8 + wave, NGW = nblk * 8;
    constexpr int I_WIN = 16 * 141, I_RNN = 16 * 32, I_MLA = 8 * 32, I_WO = 16 * 32, I_RG = 32 * 8, I_UQ = 4 * 24, I_UK = 2 * 16, I_UV = 2 * 16;
    for (int it = gw; it < I_WIN + I_RNN + I_MLA + I_WO + I_RG + I_UQ + I_UK + I_UV; it += NGW) {
        int r = it;
        if (r < I_UQ) { transpose_item(p.w_uq, 768, 256, (bf16_t*)(p.ws + WS_WUQ), RmUq(), scr, 64 * (r / 24), 32 * (r % 24), lane, p.g_q_lora); continue; } r -= I_UQ;
        if (r < I_UK) { transpose_item(p.w_uk, 512, 256, (bf16_t*)(p.ws + WS_WUK), RmUk(), scr, 64 * (r / 16), 32 * (r % 16), lane, p.g_kv_lora); continue; } r -= I_UK;
        if (r < I_UV) { transpose_item(p.w_uv, 512, 256, (bf16_t*)(p.ws + WS_WUV), RmId(), scr, 64 * (r / 16), 32 * (r % 16), lane, p.g_kv_lora); continue; } r -= I_UV;
        if (r < I_RG) { const int mi = r >> 3, sub = r & 7; const float* src = ((mi >> 4) ? p.rg_wx : p.rg_wa) + (size_t)(mi & 15) * 16384;
            transpose_item(src, 128, 128, (bf16_t*)(p.ws + WS_WRG) + (size_t)mi * 16384, RmId(), scr, 64 * (sub >> 2), 32 * (sub & 3), lane); continue; } r -= I_RG;
        if (r < I_WIN) { transpose_item(p.w_in, 4512, 1024, (bf16_t*)(p.ws + WS_WIN), RmWin(), scr, 64 * (r / 141), 32 * (r % 141), lane); continue; } r -= I_WIN;
        if (r < I_RNN) { transpose_item(p.w_rnn_out, 1024, 1024, (bf16_t*)(p.ws + WS_WRNN), RmId(), scr, 64 * (r / 32), 32 * (r % 32), lane); continue; } r -= I_RNN;
        if (r < I_MLA) { transpose_item(p.w_mla_out, 1024, 512, (bf16_t*)(p.ws + WS_WMLA), RmId(), scr, 64 * (r / 32), 32 * (r % 32), lane); continue; } r -= I_MLA;
        transpose_item(p.w_o, 1024, 1024, (bf16_t*)(p.ws + WS_WO), RmId(), scr, 64 * (r / 32), 32 * (r % 32), lane);
    }
}

DEVI void phase_expert_convert(const P& p, int bid, int nblk, unsigned char* lds) {
    const int tid = tid_(), lane = tid & 63, wave = tid >> 6;
    float* scr = (float*)lds + wave * (64 * 33);
    const int gw = bid * 8 + wave, NGW = nblk * 8;
    for (int it = gw; it < 3 * 16 * 512; it += NGW) {
        const int which = it / 8192, r = it % 8192, e = r / 512, t = r % 512, k0 = 64 * (t / 32), n0 = 32 * (t % 32);
        if (which == 0) transpose_item(p.w_e_gate + (size_t)e * 1048576, 1024, 1024, (bf16_t*)(p.ws + WS_WGU) + (size_t)e * 2048 * 1024, RmGU{0}, scr, k0, n0, lane);
        else if (which == 1) transpose_item(p.w_e_up + (size_t)e * 1048576, 1024, 1024, (bf16_t*)(p.ws + WS_WGU) + (size_t)e * 2048 * 1024, RmGU{1}, scr, k0, n0, lane);
        else transpose_item(p.w_e_down + (size_t)e * 1048576, 1024, 1024, (bf16_t*)(p.ws + WS_WD) + (size_t)e * 1024 * 1024, RmId(), scr, k0, n0, lane);
    }
}

DEVI void phase_norm1(const P& p, int bid, int nblk) {
    const int tid = tid_(), lane = tid & 63, wave = tid >> 6;
    const float* mod = (const float*)(p.ws + WS_MOD);
    bf16_t* A1 = (bf16_t*)(p.ws + WS_A);
    for (int m = bid * 8 + wave; m < NROW; m += nblk * 8) {
        const float* src = m < NLAT ? p.x + (size_t)m * 1024 : p.ctx + (size_t)(m - NLAT) * 1024;
        const int mr = m < NLAT ? (m >> 12) : 8;
        const f32x4* xr = (const f32x4*)src + lane;
        f32x4 v[4]; float s = 0.f;
#pragma unroll
        for (int j = 0; j < 4; ++j) { v[j] = xr[64 * j]; s += v[j].x * v[j].x + v[j].y * v[j].y + v[j].z * v[j].z + v[j].w * v[j].w; }
        const float rstd = rsqrtf(wave_sum(s) * (1.f / 1024.f) + EPS);
        u32x2* o = (u32x2*)(A1 + (size_t)m * 1024) + lane;
#pragma unroll
        for (int j = 0; j < 4; ++j) {
            const int k = 4 * (lane + 64 * j);
            const f32x4 g = *(const f32x4*)(p.g_norm1 + k), sh = *(const f32x4*)(mod + mr * 6144 + k), sc = *(const f32x4*)(mod + mr * 6144 + 1024 + k);
            const f32x4 y = (v[j] * rstd * g) * (sc + 1.f) + sh;
            u32x2 w; w.x = pk2(y.x, y.y); w.y = pk2(y.z, y.w); o[64 * j] = w;
        }
    }
}

template <class G>
DEVI void gemm_naive(const G& g, int bid, int nblk) {
    const int tid = tid_();
    typename G::U U;
    for (int ui = 0; g.sched(ui, bid, nblk, U); ++ui) {
        const int K = g.K(U);
        const bf16_t* B = (const bf16_t*)g.bbase(U);
        for (int it = tid; it < 2048; it += NTHR) {
            const int q = it & 31, rg = it >> 5, c0 = (q >> 2) * 32 + (q & 3) * 4;
            float acc[4][8];
#pragma unroll
            for (int i = 0; i < 4; ++i)
#pragma unroll
                for (int j = 0; j < 8; ++j) acc[i][j] = 0.f;
            const char* ab = g.abase(U);
            const bf16_t* a0 = (const bf16_t*)(ab + g.arow_off(U, rg * 4 + 0)); const bf16_t* a1 = (const bf16_t*)(ab + g.arow_off(U, rg * 4 + 1));
            const bf16_t* a2 = (const bf16_t*)(ab + g.arow_off(U, rg * 4 + 2)); const bf16_t* a3 = (const bf16_t*)(ab + g.arow_off(U, rg * 4 + 3));
            for (int k = 0; k < K; k += 8) {
                const u32x4 x0 = *(const u32x4*)(a0 + k), x1 = *(const u32x4*)(a1 + k), x2 = *(const u32x4*)(a2 + k), x3 = *(const u32x4*)(a3 + k);
#pragma unroll
                for (int j = 0; j < 8; ++j) {
                    const int n = c0 + (j & 3) + (j >> 2) * 16;
                    const u32x4 bv = *(const u32x4*)(B + (size_t)n * K + k);
                    acc[0][j] = dot8(x0, bv, acc[0][j]); acc[1][j] = dot8(x1, bv, acc[1][j]); acc[2][j] = dot8(x2, bv, acc[2][j]); acc[3][j] = dot8(x3, bv, acc[3][j]);
                }
            }
#pragma unroll
            for (int i = 0; i < 4; ++i)
                g.epi(U, rg * 4 + i, c0, (f32x4){acc[i][0], acc[i][1], acc[i][2], acc[i][3]}, (f32x4){acc[i][4], acc[i][5], acc[i][6], acc[i][7]});
        }
    }
}

#define LAS __attribute__((address_space(3)))
typedef short bf16x8 __attribute__((ext_vector_type(8)));
typedef float f32x16 __attribute__((ext_vector_type(16)));
typedef short s16x4 __attribute__((ext_vector_type(4)));
namespace fg {
constexpr int HTB = 128 * 64 * 2;
DEVI int lds_byte(int r, int c) { const int st = (r >> 4) * 2 + (c >> 5), rr = r & 15, cc = c & 31, ob = rr * 64 + cc * 2; return st * 1024 + (ob ^ (((ob >> 9) & 1) << 5)); }
DEVI void stage_rc(int b, int& R, int& C) { const int st = b / 1024, sb = b % 1024, swz = sb ^ (((sb >> 9) & 1) << 5); R = (st >> 1) * 16 + swz / 64; C = (st & 1) * 32 + (swz % 64) / 2; }
}
template <class G>
DEVI void gemm_fast(const G& g, int bid, int nblk, LAS unsigned char* lds) {
    using namespace fg;
    const int tid = tid_(), wid = __builtin_amdgcn_readfirstlane(tid >> 6), lane = tid & 63, wr = wid >> 2, wc = wid & 3, fr = lane & 15, fq = lane >> 4;
    int R0, C0, R1, C1; stage_rc(tid * 16, R0, C0); stage_rc(tid * 16 + 8192, R1, C1);
    const unsigned ldsw = (unsigned)wid * 1024u;
    const int aoff = lds_byte(wr * 64 + fr, fq * 8), boff = lds_byte(wc * 32 + fr, fq * 8);
#define FG_SA(b, h) (((b) * 2 + (h)) * HTB)
#define FG_SB(b, h) ((4 + (b) * 2 + (h)) * HTB)
#define FG_GLDS(src, dstoff) __builtin_amdgcn_global_load_lds((const unsigned*)(src), (LAS unsigned*)(lds + (dstoff)), 16, 0, 0)
#define FG_STAGE_A(bufoff, h, kt) do { const char* _b = xA + (size_t)(kt) * 128 + (G::GATHER ? (size_t)0 : (size_t)(h) * hstepA); FG_GLDS(_b + oA[G::GATHER ? (h) : 0][0], (bufoff) + ldsw); FG_GLDS(_b + oA[G::GATHER ? (h) : 0][1], (bufoff) + ldsw + 8192); } while (0)
#define FG_STAGE_B(bufoff, h, kt) do { const char* _b = xB + (size_t)(h) * hstepB + (size_t)(kt) * 128; FG_GLDS(_b + oB[0], (bufoff) + ldsw); FG_GLDS(_b + oB[1], (bufoff) + ldsw + 8192); } while (0)
#define FG_LDA(dst, b, h) do { _Pragma("unroll") for (int m = 0; m < 4; ++m) _Pragma("unroll") for (int k = 0; k < 2; ++k) dst[m][k] = *(const LAS bf16x8*)(lds + FG_SA(b, h) + aoff + m * 2048 + k * 1024); } while (0)
#define FG_LDB(dst, b, h) do { _Pragma("unroll") for (int n = 0; n < 2; ++n) _Pragma("unroll") for (int k = 0; k < 2; ++k) dst[n][k] = *(const LAS bf16x8*)(lds + FG_SB(b, h) + boff + n * 2048 + k * 1024); } while (0)
#define FG_MMA(ai, bj, At, Bt) do { __builtin_amdgcn_s_setprio(1); _Pragma("unroll") for (int m = 0; m < 4; ++m) _Pragma("unroll") for (int n = 0; n < 2; ++n) _Pragma("unroll") for (int k = 0; k < 2; ++k) \
        acc[ai][bj][m][n] = __builtin_amdgcn_mfma_f32_16x16x32_bf16(Bt[n][k], At[m][k], acc[ai][bj][m][n], 0, 0, 0); __builtin_amdgcn_s_setprio(0); } while (0)
#define FG_WAIT_V(n) asm volatile("s_waitcnt vmcnt(" #n ")" ::: "memory")
#define FG_WAIT_L(n) asm volatile("s_waitcnt lgkmcnt(" #n ")" ::: "memory")
#define FG_BAR __builtin_amdgcn_s_barrier()
#define FG_SCHED __builtin_amdgcn_sched_barrier(0)
#define FG_SETCTX(U_) do { xA = g.abase(U_); xB = g.bbase(U_); const int _K = g.K(U_); \
        oA[0][0] = g.arow_off(U_, R0) + (unsigned)C0 * 2u; oA[0][1] = g.arow_off(U_, R1) + (unsigned)C1 * 2u; \
        if (G::GATHER) { oA[1][0] = g.arow_off(U_, 128 + R0) + (unsigned)C0 * 2u; oA[1][1] = g.arow_off(U_, 128 + R1) + (unsigned)C1 * 2u; } else hstepA = (size_t)128 * _K * 2; \
        oB[0] = (unsigned)(R0 * _K + C0) * 2u; oB[1] = (unsigned)(R1 * _K + C1) * 2u; hstepB = (size_t)128 * _K * 2; } while (0)
    typename G::U cur, nxt; int ui = 0;
    if (!g.sched(0, bid, nblk, cur)) return;
    f32x4 acc[2][2][4][2];
#pragma unroll
    for (int a = 0; a < 2; ++a)
#pragma unroll
        for (int b = 0; b < 2; ++b)
#pragma unroll
            for (int m = 0; m < 4; ++m)
#pragma unroll
                for (int n = 0; n < 2; ++n) acc[a][b][m][n] = (f32x4){0.f, 0.f, 0.f, 0.f};
    bf16x8 At[4][2], B0[2][2], B1[2][2];
    const char* xA; const char* xB; unsigned oA[2][2], oB[2]; size_t hstepB, hstepA = 0;
    FG_SETCTX(cur);
    int nt = g.K(cur) / 64;
    FG_STAGE_B(FG_SB(0, 0), 0, 0); FG_STAGE_A(FG_SA(0, 0), 0, 0); FG_STAGE_B(FG_SB(0, 1), 1, 0); FG_STAGE_A(FG_SA(0, 1), 1, 0);
    if (wr == 1) FG_BAR;
    FG_WAIT_V(4); FG_BAR;
    FG_STAGE_B(FG_SB(1, 0), 0, 1); FG_STAGE_A(FG_SA(1, 0), 0, 1); FG_STAGE_B(FG_SB(1, 1), 1, 1);
    FG_WAIT_V(6); FG_BAR;
    for (;;) {
        const bool has_next = g.sched(ui + 1, bid, nblk, nxt);
        for (int t = 0; t < nt; t += 2) {
            const bool last = (t == nt - 2);
            FG_LDB(B0, 0, 0); FG_SCHED; FG_LDA(At, 0, 0); FG_STAGE_A(FG_SA(1, 1), 1, t + 1);
            FG_WAIT_L(8); FG_BAR; FG_WAIT_L(0); FG_MMA(0, 0, At, B0); FG_BAR; FG_SCHED;
            int t2 = t + 2;
            if (last) { t2 = 0; if (has_next) FG_SETCTX(nxt); }
            FG_LDB(B1, 0, 1); FG_STAGE_B(FG_SB(0, 0), 0, t2);
            FG_BAR; FG_WAIT_L(0); FG_MMA(0, 1, At, B1); FG_BAR;
            FG_LDA(At, 0, 1); FG_STAGE_A(FG_SA(0, 0), 0, t2);
            FG_BAR; FG_WAIT_L(0); FG_MMA(1, 0, At, B0); FG_BAR; FG_SCHED;
            FG_STAGE_B(FG_SB(0, 1), 1, t2);
            FG_WAIT_V(6); FG_BAR; FG_MMA(1, 1, At, B1); FG_BAR;
            FG_LDB(B0, 1, 0); FG_SCHED; FG_LDA(At, 1, 0); FG_STAGE_A(FG_SA(0, 1), 1, t2);
            FG_WAIT_L(8); FG_BAR; FG_WAIT_L(0); FG_MMA(0, 0, At, B0); FG_BAR; FG_SCHED;
            FG_LDB(B1, 1, 1); FG_STAGE_B(FG_SB(1, 0), 0, t2 + 1);
            FG_BAR; FG_WAIT_L(0); FG_MMA(0, 1, At, B1); FG_BAR;
            FG_LDA(At, 1, 1); FG_STAGE_A(FG_SA(1, 0), 0, t2 + 1);
            FG_BAR; FG_WAIT_L(0); FG_MMA(1, 0, At, B0); FG_BAR; FG_SCHED;
            FG_STAGE_B(FG_SB(1, 1), 1, t2 + 1);
            FG_WAIT_V(6); FG_BAR; FG_MMA(1, 1, At, B1); FG_BAR;
        }
#pragma unroll
        for (int ai = 0; ai < 2; ++ai)
#pragma unroll
            for (int m = 0; m < 4; ++m)
                { int rr_ = 128 * ai + 64 * wr + 16 * m + fr, cb_ = 32 * wc + 4 * fq; asm volatile("" : "+v"(rr_), "+v"(cb_));
                  g.epi4(cur, rr_, cb_, acc[ai][0][m][0], acc[ai][0][m][1], acc[ai][1][m][0], acc[ai][1][m][1]); asm volatile("" ::: "memory"); }
        if (!has_next) break;
#pragma unroll
        for (int a = 0; a < 2; ++a)
#pragma unroll
            for (int b = 0; b < 2; ++b)
#pragma unroll
                for (int m = 0; m < 4; ++m)
#pragma unroll
                    for (int n = 0; n < 2; ++n) acc[a][b][m][n] = (f32x4){0.f, 0.f, 0.f, 0.f};
        cur = nxt; nt = g.K(cur) / 64; ++ui;
    }
    FG_WAIT_V(0);
    if (wr == 0) FG_BAR;
    FG_BAR;
#undef FG_SA
#undef FG_SB
#undef FG_GLDS
#undef FG_STAGE_A
#undef FG_STAGE_B
#undef FG_LDA
#undef FG_LDB
#undef FG_MMA
#undef FG_WAIT_V
#undef FG_WAIT_L
#undef FG_BAR
#undef FG_SCHED
#undef FG_SETCTX
}

struct G1 {
    static constexpr bool GATHER = false;
    const bf16_t* A; const bf16_t* Bt; bf16_t *zrnn, *zgelu, *zq, *zkvr, *g;
    struct U { int pm, pn; };
    DEVI bool sched(int i, int bid, int nblk, U& r) const {
        const int u = i * nblk + bid; if (u >= 128 * 18 + 8 * 5) return false;
        if (u < 2304) { r.pm = u / 18; r.pn = u % 18; } else { const int v = u - 2304, j = v % 5; r.pm = 128 + v / 5; r.pn = j < 4 ? j : 9; } return true; }
    DEVI int K(const U&) const { return 1024; }
    DEVI const char* abase(const U& u) const { return (const char*)(A + (size_t)u.pm * 256 * 1024); }
    DEVI unsigned arow_off(const U&, int r) const { return (unsigned)r * 2048u; }
    DEVI const char* bbase(const U& u) const { return (const char*)(Bt + (size_t)u.pn * 256 * 1024); }
    DEVI void epi4(const U& u, int r, int cb, f32x4 a, f32x4 b, f32x4 c, f32x4 d) const { epi(u, r, cb, a, b); epi(u, r, 128 + cb, c, d); }
    DEVI void epi(const U& u, int r, int c0, f32x4 v0, f32x4 v1) const {
        const size_t row = (size_t)u.pm * 256 + r;
        if (u.pn < 4) { bf16_t* o = zrnn + row * 1024 + u.pn * 256 + c0; store4bf(o, v0); store4bf(o + 16, v1); }
        else if (u.pn < 8) {
            bf16_t* o = zgelu + row * 1024 + (u.pn - 4) * 256 + c0;
            store4bf(o, (f32x4){gelu_tanh(v0.x), gelu_tanh(v0.y), gelu_tanh(v0.z), gelu_tanh(v0.w)});
            store4bf(o + 16, (f32x4){gelu_tanh(v1.x), gelu_tanh(v1.y), gelu_tanh(v1.z), gelu_tanh(v1.w)});
        } else if (u.pn == 8) { bf16_t* o = zq + row * 256 + c0; store4bf(o, v0); store4bf(o + 16, v1); }
        else if (u.pn == 9) { bf16_t* o = zkvr + row * 256 + c0; store4bf(o, v0); store4bf(o + 16, v1); }
        else {
            bf16_t* o = g + row * 2048 + (u.pn - 10) * 256 + c0;
            store4bf(o, (f32x4){sigm(v0.x), sigm(v0.y), sigm(v0.z), sigm(v0.w)});
            store4bf(o + 16, (f32x4){sigm(v1.x), sigm(v1.y), sigm(v1.z), sigm(v1.w)});
        }
    }
};

struct G2 {
    static constexpr bool GATHER = false;
    const bf16_t *rnn, *attn, *WrT, *WmT, *g; bf16_t* merged;
    struct U { int pm, pn, sub; };
    DEVI bool sched(int i, int bid, int nblk, U& r) const { const int u = (i >> 1) * nblk + bid; if (u >= 128 * 4) return false; r.pm = u >> 2; r.pn = u & 3; r.sub = i & 1; return true; }
    DEVI int K(const U& u) const { return u.sub ? 512 : 1024; }
    DEVI const char* abase(const U& u) const { return u.sub ? (const char*)(attn + (size_t)u.pm * 256 * 512) : (const char*)(rnn + (size_t)u.pm * 256 * 1024); }
    DEVI unsigned arow_off(const U& u, int r) const { return (unsigned)r * (u.sub ? 1024u : 2048u); }
    DEVI const char* bbase(const U& u) const { return u.sub ? (const char*)(WmT + (size_t)u.pn * 256 * 512) : (const char*)(WrT + (size_t)u.pn * 256 * 1024); }
    DEVI void epi4(const U& u, int r, int cb, f32x4 a, f32x4 b, f32x4 c, f32x4 d) const { epi(u, r, cb, a, b); epi(u, r, 128 + cb, c, d); }
    DEVI void epi(const U& u, int r, int c0, f32x4 v0, f32x4 v1) const {
        const size_t row = (size_t)u.pm * 256 + r; const int col = u.pn * 256 + c0;
        const bf16_t* gp = g + row * 2048 + u.sub * 1024 + col; bf16_t* o = merged + row * 1024 + col;
        f32x4 r0 = load4bf(gp) * v0, r1 = load4bf(gp + 16) * v1;
        if (u.sub) { r0 += load4bf(o); r1 += load4bf(o + 16); }
        store4bf(o, r0); store4bf(o + 16, r1);
    }
};

struct G3 {
    static constexpr bool GATHER = false;
    const bf16_t *A, *Bt; const float *x, *mod; float* out;
    struct U { int pm, pn; };
    DEVI bool sched(int i, int bid, int nblk, U& r) const { const int u = i * nblk + bid; if (u >= 128 * 4) return false; r.pm = u >> 2; r.pn = u & 3; return true; }
    DEVI int K(const U&) const { return 1024; }
    DEVI const char* abase(const U& u) const { return (const char*)(A + (size_t)u.pm * 256 * 1024); }
    DEVI unsigned arow_off(const U&, int r) const { return (unsigned)r * 2048u; }
    DEVI const char* bbase(const U& u) const { return (const char*)(Bt + (size_t)u.pn * 256 * 1024); }
    DEVI void epi4(const U& u, int r, int cb, f32x4 a, f32x4 b, f32x4 c, f32x4 d) const { epi(u, r, cb, a, b); epi(u, r, 128 + cb, c, d); }
    DEVI void epi(const U& u, int r, int c0, f32x4 v0, f32x4 v1) const {
        const size_t row = (size_t)u.pm * 256 + r; const int col = u.pn * 256 + c0; const int b = (int)(row >> 12);
        const float* mp = mod + b * 6144 + 2048 + col; const float* xp = x + row * 1024 + col; float* o = out + row * 1024 + col;
        *(f32x4*)o = *(const f32x4*)xp + *(const f32x4*)mp * v0;
        *(f32x4*)(o + 16) = *(const f32x4*)(xp + 16) + *(const f32x4*)(mp + 16) * v1;
    }
};

struct GM1 {
    static constexpr bool GATHER = true;
    const bf16_t *h, *Wgu; const int* idx; bf16_t* hid;
    struct U { int be, pm, pn; };
    DEVI bool sched(int i, int bid, int nblk, U& r) const { const int u = i * nblk + bid; if (u >= 128 * 16) return false; r.be = u >> 4; r.pm = (u >> 3) & 1; r.pn = u & 7; return true; }
    DEVI int K(const U&) const { return 1024; }
    DEVI const char* abase(const U& u) const { return (const char*)(h + (size_t)(u.be >> 4) * 4096 * 1024); }
    DEVI unsigned arow_off(const U& u, int r) const { return (unsigned)idx[u.be * 512 + u.pm * 256 + r] * 2048u; }
    DEVI const char* bbase(const U& u) const { return (const char*)(Wgu + ((size_t)(u.be & 15) * 2048 + u.pn * 256) * 1024); }
    DEVI void epi4(const U& u, int r, int cb, f32x4 a, f32x4 b, f32x4 c, f32x4 d) const { epi(u, r, cb, a, b); epi(u, r, 128 + cb, c, d); }
    DEVI void epi(const U& u, int r, int c0, f32x4 v0, f32x4 v1) const {
        const int hidx = u.pn * 128 + (c0 >> 5) * 16 + (c0 & 15);
        bf16_t* o = hid + ((size_t)u.be * 512 + u.pm * 256 + r) * 1024 + hidx;
        store4bf(o, (f32x4){v0.x * sigm(v0.x) * v1.x, v0.y * sigm(v0.y) * v1.y, v0.z * sigm(v0.z) * v1.z, v0.w * sigm(v0.w) * v1.w});
    }
};

struct GM2 {
    static constexpr bool GATHER = false;
    const bf16_t *hid, *Wd; const float* gate; bf16_t* Y;
    struct U { int be, pm, pn; };
    DEVI bool sched(int i, int bid, int nblk, U& r) const { const int u = i * nblk + bid; if (u >= 128 * 8) return false; r.be = u >> 3; r.pm = (u >> 2) & 1; r.pn = u & 3; return true; }
    DEVI int K(const U&) const { return 1024; }
    DEVI const char* abase(const U& u) const { return (const char*)(hid + ((size_t)u.be * 512 + u.pm * 256) * 1024); }
    DEVI unsigned arow_off(const U&, int r) const { return (unsigned)r * 2048u; }
    DEVI const char* bbase(const U& u) const { return (const char*)(Wd + ((size_t)(u.be & 15) * 1024 + u.pn * 256) * 1024); }
    DEVI void epi4(const U& u, int r, int cb, f32x4 a, f32x4 b, f32x4 c, f32x4 d) const { epi(u, r, cb, a, b); epi(u, r, 128 + cb, c, d); }
    DEVI void epi(const U& u, int r, int c0, f32x4 v0, f32x4 v1) const {
        const size_t row = (size_t)u.be * 512 + u.pm * 256 + r; const float gt = gate[row];
        bf16_t* o = Y + row * 1024 + u.pn * 256 + c0;
        store4bf(o, v0 * gt); store4bf(o + 16, v1 * gt);
    }
};

DEVI void phase_conv_naive(const P& p, int bid, int nblk) {
    const bf16_t* z = (const bf16_t*)(p.ws + WS_ZRNN); bf16_t* xr = (bf16_t*)(p.ws + WS_A);
    for (size_t i = (size_t)bid * NTHR + tid_(); i < (size_t)NROW * 256; i += (size_t)nblk * NTHR) {
        const int m = (int)(i >> 8), c4 = (int)(i & 255) * 4;
        int pos, len; if (m < NLAT) { pos = m & 4095; len = SEQ; } else { pos = (m - NLAT) & 255; len = CTXL; }
        f32x4 acc = *(const f32x4*)(p.conv_b + c4);
#pragma unroll
        for (int k = 0; k < 4; ++k) { const int q = pos - 2 + k; if (q >= 0 && q < len) acc += *(const f32x4*)(p.conv_w + k * 1024 + c4) * load4bf(z + (size_t)(m - 2 + k) * 1024 + c4); }
        store4bf(xr + (size_t)m * 1024 + c4, acc);
    }
}

template <int DIR>
DEVI void phase_scan_naive(const P& p, int bid, int nblk) {
    const bf16_t* xr = (const bf16_t*)(p.ws + WS_A); bf16_t* hf = (bf16_t*)(p.ws + WS_HF); bf16_t* gl = (bf16_t*)(p.ws + WS_GELU);
    const float* sp = (const float*)(p.ws + WS_SP);
    for (int id = bid * NTHR + tid_(); id < NB * 1024 * 4; id += nblk * NTHR) {
        const int half = id & 3, b = id >> 12, ch = (id >> 2) & 1023, blk = ch >> 7, j = ch & 127;
        const float* wa = p.rg_wa + ((size_t)(DIR * 8 + blk) * 128 + half * 32) * 128 + j; const float* wx = p.rg_wx + ((size_t)(DIR * 8 + blk) * 128 + half * 32) * 128 + j;
        unsigned w[32];
#pragma unroll
        for (int i = 0; i < 32; ++i) w[i] = pk2(wa[i * 128], wx[i * 128]);
        const float ba = p.rg_ba[DIR * 1024 + ch], bx = p.rg_bx[DIR * 1024 + ch], spv = sp[DIR * 1024 + ch];
        float h = 0.f;
        for (int step = 0; step < NKEY; ++step) {
            int m;
            if (step < CTXL) m = NLAT + b * CTXL + (DIR ? CTXL - 1 - step : step);
            else m = b * SEQ + (DIR ? SEQ - 1 - (step - CTXL) : (step - CTXL));
            const u32x4* xp = (const u32x4*)(xr + (size_t)m * 1024 + blk * 128 + half * 32);
            float ar = 0.f, ai = 0.f;
#pragma unroll
            for (int q = 0; q < 4; ++q) {
                const u32x4 v = xp[q];
                ar = fmaf(bflo(v.x), bflo(w[8 * q + 0]), ar); ai = fmaf(bflo(v.x), bfhi(w[8 * q + 0]), ai);
                ar = fmaf(bfhi(v.x), bflo(w[8 * q + 1]), ar); ai = fmaf(bfhi(v.x), bfhi(w[8 * q + 1]), ai);
                ar = fmaf(bflo(v.y), bflo(w[8 * q + 2]), ar); ai = fmaf(bflo(v.y), bfhi(w[8 * q + 2]), ai);
                ar = fmaf(bfhi(v.y), bflo(w[8 * q + 3]), ar); ai = fmaf(bfhi(v.y), bfhi(w[8 * q + 3]), ai);
                ar = fmaf(bflo(v.z), bflo(w[8 * q + 4]), ar); ai = fmaf(bflo(v.z), bfhi(w[8 * q + 4]), ai);
                ar = fmaf(bfhi(v.z), bflo(w[8 * q + 5]), ar); ai = fmaf(bfhi(v.z), bfhi(w[8 * q + 5]), ai);
                ar = fmaf(bflo(v.w), bflo(w[8 * q + 6]), ar); ai = fmaf(bflo(v.w), bfhi(w[8 * q + 6]), ai);
                ar = fmaf(bfhi(v.w), bflo(w[8 * q + 7]), ar); ai = fmaf(bfhi(v.w), bfhi(w[8 * q + 7]), ai);
            }
            ar += __shfl_xor(ar, 1); ai += __shfl_xor(ai, 1); ar = ar + __shfl_xor(ar, 2) + ba; ai = ai + __shfl_xor(ai, 2) + bx;
            const float xo = bf2f(xr[(size_t)m * 1024 + ch]);
            const float r = sigm(ar), ig = sigm(ai), la = -spv * r, a = __expf(la);
            const float bc = sqrtf(fmaxf(-expm1f(2.f * la), 0.f)) * ig * xo;
            h = fmaf(a, h, bc);
            if (step >= CTXL && half == 0) {
                if (DIR == 0) hf[(size_t)m * 1024 + ch] = (bf16_t)f2bf(h);
                else { const size_t o = (size_t)m * 1024 + ch; gl[o] = (bf16_t)f2bf((bf2f(hf[o]) + h) * bf2f(gl[o])); }
            }
        }
    }
}

DEVI float dot4(f32x4 a) { return a.x * a.x + a.y * a.y + a.z * a.z + a.w * a.w; }
struct GP4 {
    static constexpr bool GATHER = false;
    unsigned char* ws; const float *gqn, *gqr, *gkn;
    struct U { int type, pm, pn; };
    DEVI bool sched(int i, int bid, int nblk, U& r) const {
        const int u = i * nblk + bid;
        if (u < 384) { r.type = 0; r.pm = u / 3; r.pn = u % 3; return true; }
        if (u < 656) { const int v = u - 384; r.type = 1; r.pm = v >> 1; r.pn = v & 1; return true; }
        if (u < 928) { const int v = u - 656; r.type = 2; r.pm = v & 1; r.pn = v >> 1; return true; }
        return false; }
    DEVI int K(const U&) const { return 256; }
    DEVI const char* abase(const U& u) const { const size_t o = u.type == 0 ? WS_ZQ : (u.type == 1 ? WS_ZKVR : WS_WUV); return (const char*)ws + o + (size_t)u.pm * 256 * 512; }
    DEVI unsigned arow_off(const U&, int r) const { return (unsigned)r * 512u; }
    DEVI const char* bbase(const U& u) const { const size_t o = u.type == 0 ? WS_WUQ : (u.type == 1 ? WS_WUK : WS_ZKVR); return (const char*)ws + o + (size_t)u.pn * 256 * 512; }
    DEVI void epi4(const U& u, int r, int cb, f32x4 v00, f32x4 v01, f32x4 v10, f32x4 v11) const {
        const int wc = cb >> 5, f4 = cb & 31;
        const float* rq = (const float*)(ws + WS_RSTDQ); const float* rkv = (const float*)(ws + WS_RSTDKV); const float* rope = (const float*)(ws + WS_ROPE);
        bf16_t* Q = (bf16_t*)(ws + WS_A); bf16_t* Kb = (bf16_t*)(ws + WS_K); bf16_t* VT = (bf16_t*)(ws + WS_VT);
        if (u.type == 2) {
            const int dv = u.pm * 256 + r, head = dv >> 6, d = dv & 63;
            int b, key0; size_t m0;
            if (u.pn < 128) { b = u.pn >> 4; key0 = CTXL + (u.pn & 15) * 256; m0 = (size_t)u.pn * 256; } else { b = u.pn - 128; key0 = 0; m0 = (size_t)u.pn * 256; }
            bf16_t* vo = VT + ((size_t)(b * 8 + head) * 64 + d) * NKEY + key0 + cb; const float* rp = rkv + m0 + cb;
            store4bf(vo, v00 * *(const f32x4*)rp); store4bf(vo + 16, v01 * *(const f32x4*)(rp + 16));
            store4bf(vo + 128, v10 * *(const f32x4*)(rp + 128)); store4bf(vo + 144, v11 * *(const f32x4*)(rp + 144));
            return;
        }
        const size_t m = (size_t)u.pm * 256 + r;
        if (u.type == 1) {
            float ss = dot4(v00) + dot4(v01) + dot4(v10) + dot4(v11); ss += __shfl_xor(ss, 16); ss += __shfl_xor(ss, 32);
            const float rs = rkv[m], sc = rs * rsqrtf(rs * rs * ss * (1.f / 64.f) + EPS);
            int b, key; if (u.pm < 128) { b = u.pm >> 4; key = CTXL + (int)(m & 4095); } else { b = u.pm - 128; key = r; }
            bf16_t* ko = Kb + ((size_t)(b * 8 + u.pn * 4 + wc) * NKEY + key) * 96 + f4; const float* gp = gkn + f4;
            store4bf(ko, v00 * sc * *(const f32x4*)gp); store4bf(ko + 16, v01 * sc * *(const f32x4*)(gp + 16));
            store4bf(ko + 32, v10 * sc * *(const f32x4*)(gp + 32)); store4bf(ko + 48, v11 * sc * *(const f32x4*)(gp + 48));
            return;
        }
        const int b = (int)(m >> 12), t = (int)(m & 4095); const float rs = rq[m];
        if (u.pn < 2) {
            float ss = dot4(v00) + dot4(v01) + dot4(v10) + dot4(v11); ss += __shfl_xor(ss, 16); ss += __shfl_xor(ss, 32);
            const float sc = rs * rsqrtf(rs * rs * ss * (1.f / 64.f) + EPS) * QSCALE;
            bf16_t* qo = Q + ((size_t)(b * 8 + u.pn * 4 + wc) * SEQ + t) * 96 + f4; const float* gp = gqn + f4;
            store4bf(qo, v00 * sc * *(const f32x4*)gp); store4bf(qo + 16, v01 * sc * *(const f32x4*)(gp + 16));
            store4bf(qo + 32, v10 * sc * *(const f32x4*)(gp + 32)); store4bf(qo + 48, v11 * sc * *(const f32x4*)(gp + 48));
        } else {
            const int pos = f4 < 8 ? (t >> 6) : (t & 63);
            const float* rp = rope + (pos * 8 + (f4 & 7)) * 2;
            const f32x4 c0 = *(const f32x4*)rp, c1 = *(const f32x4*)(rp + 4);
            const f32x4 cs = {c0.x, c0.z, c1.x, c1.z}, sn = {c0.y, c0.w, c1.y, c1.w};
            const f32x4 g1 = *(const f32x4*)(gqr + f4), g2 = *(const f32x4*)(gqr + 16 + f4);
            float s0 = dot4(v00) + dot4(v01), s1 = dot4(v10) + dot4(v11);
            s0 += __shfl_xor(s0, 16); s0 += __shfl_xor(s0, 32); s1 += __shfl_xor(s1, 16); s1 += __shfl_xor(s1, 32);
            const float sc0 = rs * rsqrtf(rs * rs * s0 * (1.f / 32.f) + EPS) * QSCALE, sc1 = rs * rsqrtf(rs * rs * s1 * (1.f / 32.f) + EPS) * QSCALE;
            { const f32x4 y1 = v00 * sc0 * g1, y2 = v01 * sc0 * g2; bf16_t* qo = Q + ((size_t)(b * 8 + wc) * SEQ + t) * 96 + 64 + f4;
              store4bf(qo, y1 * cs - y2 * sn); store4bf(qo + 16, y1 * sn + y2 * cs); }
            { const f32x4 y1 = v10 * sc1 * g1, y2 = v11 * sc1 * g2; bf16_t* qo = Q + ((size_t)(b * 8 + 4 + wc) * SEQ + t) * 96 + 64 + f4;
              store4bf(qo, y1 * cs - y2 * sn); store4bf(qo + 16, y1 * sn + y2 * cs); }
        }
    }
};


constexpr int RNN_XB = 32 * 272;
constexpr int RNN_HOFF = 4 * RNN_XB + 2048;
DEVI void phase_rnn_carry(const P& p, int bid, int nblk) {
    float* S = (float*)(p.ws + WS_RNNSUM);
    for (int id = bid * NTHR + tid_(); id < NB * 2 * 1024; id += nblk * NTHR) {
        const int ch = id & 1023, dir = (id >> 10) & 1, b = id >> 11;
        float* sp = S + ((size_t)(b * 2 + dir) * 34) * 2048 + ch;
        float A[34], B[34];
#pragma unroll
        for (int c = 0; c < 34; ++c) { A[c] = sp[c * 2048]; B[c] = sp[c * 2048 + 1024]; }
        float h = 0.f;
        if (dir == 0) {
#pragma unroll
            for (int k = 0; k < 34; ++k) { sp[k * 2048 + 1024] = h; h = fmaf(A[k], h, B[k]); }
        } else {
#pragma unroll
            for (int k = 0; k < 34; ++k) { const int c = k < 2 ? 1 - k : 35 - k; sp[c * 2048 + 1024] = h; h = fmaf(A[c], h, B[c]); }
        }
    }
}

template <bool APPLY>
DEVI void phase_rnn(const P& p, int bid, int nblk, LAS unsigned char* lds) {
    const int tid = tid_(), wid = __builtin_amdgcn_readfirstlane(tid >> 6), lane = tid & 63, r = lane & 31, hh = lane >> 5;
    const int dir = wid >> 2, cg = wid & 3;
    const int n = bid & 7, bl = bid >> 3, nbl = (nblk - n + 7) >> 3;
    const bf16_t* z = (const bf16_t*)(p.ws + WS_ZRNN); float* S = (float*)(p.ws + WS_RNNSUM); bf16_t* gl = (bf16_t*)(p.ws + WS_GELU);
    const int ch = n * 128 + cg * 32 + r;
    bf16x8 wfa[8], wfx[8];
    { const bf16_t* wa = (const bf16_t*)(p.ws + WS_WRG) + ((size_t)((0 * 2 + dir) * 8 + n) * 128 + cg * 32 + r) * 128 + hh * 8;
      const bf16_t* wx = (const bf16_t*)(p.ws + WS_WRG) + ((size_t)((1 * 2 + dir) * 8 + n) * 128 + cg * 32 + r) * 128 + hh * 8;
#pragma unroll
      for (int ks = 0; ks < 8; ++ks) { wfa[ks] = *(const bf16x8*)(wa + ks * 16); wfx[ks] = *(const bf16x8*)(wx + ks * 16); } }
    const float ba = p.rg_ba[dir * 1024 + ch], bx = p.rg_bx[dir * 1024 + ch], sp2 = ((const float*)(p.ws + WS_SP))[dir * 1024 + ch] * 1.4426950408889634f;
    const int t8 = tid & 255, c4 = t8 & 31, rgp = t8 >> 5, cch = n * 128 + c4 * 4;
    const f32x4 cw0 = *(const f32x4*)(p.conv_w + cch), cw1 = *(const f32x4*)(p.conv_w + 1024 + cch), cw2 = *(const f32x4*)(p.conv_w + 2048 + cch), cw3 = *(const f32x4*)(p.conv_w + 3072 + cch);
    const f32x4 cb = *(const f32x4*)(p.conv_b + cch);
    const bool ownfirst = (dir == 0) ? (hh == 0) : (hh == 1);
    const int nitems = APPLY ? NB * 32 : NB * 34;
    for (int li = bl; li < nitems; li += nbl) {
        int b, c; if (APPLY) { b = li >> 5; c = 2 + (li & 31); } else { b = li / 34; c = li % 34; }
        int pos0, len; size_t m0;
        if (c < 2) { pos0 = c * 128; len = CTXL; m0 = (size_t)NLAT + b * CTXL + pos0; } else { pos0 = (c - 2) * 128; len = SEQ; m0 = (size_t)b * SEQ + pos0; }
        float* sp = S + ((size_t)((b * 2 + dir) * 34 + c)) * 2048 + ch;
        float h = APPLY ? sp[1024] : 0.f, Ap = 1.f;
        for (int s = 0; s < 4; ++s) {
            const int st = dir ? 3 - s : s;
            LAS unsigned char* xb = lds + (dir * 2 + (s & 1)) * RNN_XB;
            {
                const int row0 = st * 32 + rgp * 4;
                f32x4 zr[7];
#pragma unroll
                for (int i = 0; i < 7; ++i) { const int pos = pos0 + row0 - 2 + i; zr[i] = (f32x4){0.f, 0.f, 0.f, 0.f}; if (pos >= 0 && pos < len) zr[i] = load4bf(z + (m0 + row0 + i - 2) * 1024 + cch); }
#pragma unroll
                for (int o = 0; o < 4; ++o) { const f32x4 v = cb + cw0 * zr[o] + cw1 * zr[o + 1] + cw2 * zr[o + 2] + cw3 * zr[o + 3];
                    u32x2 w; w.x = pk2(v.x, v.y); w.y = pk2(v.z, v.w); *(LAS u32x2*)(xb + (rgp * 4 + o) * 272 + c4 * 8) = w; }
            }
            __syncthreads();
            f32x16 ar, ai;
#pragma unroll
            for (int i = 0; i < 16; ++i) { ar[i] = ba; ai[i] = bx; }
#pragma unroll
            for (int ks = 0; ks < 8; ++ks) {
                const bf16x8 af = *(const LAS bf16x8*)(xb + r * 272 + ks * 32 + hh * 16);
                ar = __builtin_amdgcn_mfma_f32_32x32x16_bf16(af, wfa[ks], ar, 0, 0, 0);
                ai = __builtin_amdgcn_mfma_f32_32x32x16_bf16(af, wfx[ks], ai, 0, 0, 0);
            }
            float a_[16], b_[16];
#pragma unroll
            for (int i = 0; i < 16; ++i) {
                const int row = (i & 3) + 8 * (i >> 2) + 4 * hh;
                const float xv = bf2f(*(const LAS bf16_t*)(xb + row * 272 + (cg * 32 + r) * 2));
                const float rr = sigm(ar[i]), ig = sigm(ai[i]);
                const float a = __builtin_amdgcn_exp2f(-sp2 * rr);
                a_[i] = a; b_[i] = __builtin_amdgcn_sqrtf(fmaxf(fmaf(-a, a, 1.f), 0.f)) * ig * xv;
            }
            float gA[4], gB[4], oA[4], oB[4];
#pragma unroll
            for (int q = 0; q < 4; ++q) {
                if (dir == 0) { float hb = b_[4 * q]; hb = fmaf(a_[4 * q + 1], hb, b_[4 * q + 1]); hb = fmaf(a_[4 * q + 2], hb, b_[4 * q + 2]); hb = fmaf(a_[4 * q + 3], hb, b_[4 * q + 3]); gB[q] = hb; }
                else { float hb = b_[4 * q + 3]; hb = fmaf(a_[4 * q + 2], hb, b_[4 * q + 2]); hb = fmaf(a_[4 * q + 1], hb, b_[4 * q + 1]); hb = fmaf(a_[4 * q], hb, b_[4 * q]); gB[q] = hb; }
                gA[q] = (a_[4 * q] * a_[4 * q + 1]) * (a_[4 * q + 2] * a_[4 * q + 3]);
                oA[q] = __shfl_xor(gA[q], 32); oB[q] = __shfl_xor(gB[q], 32);
            }
            float hin[4];
#define RNN_STEP(q) do { const float A1 = ownfirst ? gA[q] : oA[q], B1 = ownfirst ? gB[q] : oB[q], A2 = ownfirst ? oA[q] : gA[q], B2 = ownfirst ? oB[q] : gB[q]; \
                const float t1 = fmaf(A1, h, B1), t2 = fmaf(A2, t1, B2); hin[q] = ownfirst ? h : t1; h = t2; if (!APPLY) Ap *= gA[q] * oA[q]; } while (0)
            if (dir == 0) { RNN_STEP(0); RNN_STEP(1); RNN_STEP(2); RNN_STEP(3); } else { RNN_STEP(3); RNN_STEP(2); RNN_STEP(1); RNN_STEP(0); }
#undef RNN_STEP
            if (APPLY) {
                LAS bf16_t* ht = (LAS bf16_t*)(lds + RNN_HOFF + dir * 32768) + (st * 32 + 4 * hh) * 128 + cg * 32 + r;
#pragma unroll
                for (int q = 0; q < 4; ++q) {
                    float hv = hin[q];
                    if (dir == 0) {
#pragma unroll
                        for (int e = 0; e < 4; ++e) { hv = fmaf(a_[4 * q + e], hv, b_[4 * q + e]); ht[(8 * q + e) * 128] = (bf16_t)(pk2(hv, 0.f) & 0xffffu); }
                    } else {
#pragma unroll
                        for (int e = 3; e >= 0; --e) { hv = fmaf(a_[4 * q + e], hv, b_[4 * q + e]); ht[(8 * q + e) * 128] = (bf16_t)(pk2(hv, 0.f) & 0xffffu); }
                    }
                }
            }
        }
        if (APPLY) {
            __syncthreads();
            const int row = tid >> 2, cs = (tid & 3) * 32;
            const LAS unsigned char* hf = lds + RNN_HOFF + row * 256 + cs * 2; const LAS unsigned char* hb = hf + 32768;
            bf16_t* gp = gl + (m0 + row) * 1024 + n * 128 + cs;
#pragma unroll
            for (int j = 0; j < 4; ++j) {
                const u32x4 f = *(const LAS u32x4*)(hf + j * 16), bk = *(const LAS u32x4*)(hb + j * 16), g = *(const u32x4*)(gp + j * 8);
                u32x4 o;
                o.x = pk2((bflo(f.x) + bflo(bk.x)) * bflo(g.x), (bfhi(f.x) + bfhi(bk.x)) * bfhi(g.x));
                o.y = pk2((bflo(f.y) + bflo(bk.y)) * bflo(g.y), (bfhi(f.y) + bfhi(bk.y)) * bfhi(g.y));
                o.z = pk2((bflo(f.z) + bflo(bk.z)) * bflo(g.z), (bfhi(f.z) + bfhi(bk.z)) * bfhi(g.z));
                o.w = pk2((bflo(f.w) + bflo(bk.w)) * bflo(g.w), (bfhi(f.w) + bfhi(bk.w)) * bfhi(g.w));
                *(u32x4*)(gp + j * 8) = o;
            }
        } else if (hh == 0) { sp[0] = Ap; sp[1024] = h; }
    }
    __syncthreads();
}

DEVI void phase_mla_pre(const P& p, int bid, int nblk) {
    const int tid = tid_(), lane = tid & 63, wave = tid >> 6;
    const bf16_t* zq = (const bf16_t*)(p.ws + WS_ZQ); const bf16_t* zkvr = (const bf16_t*)(p.ws + WS_ZKVR);
    float* rq = (float*)(p.ws + WS_RSTDQ); float* rkv = (float*)(p.ws + WS_RSTDKV); bf16_t* Kb = (bf16_t*)(p.ws + WS_K);
    const float* rope = (const float*)(p.ws + WS_ROPE);
    for (int m = bid * 8 + wave; m < NROW; m += nblk * 8) {
        if (m < NLAT) { const f32x4 v = load4bf(zq + (size_t)m * 256 + 4 * lane); const float s = wave_sum(v.x * v.x + v.y * v.y + v.z * v.z + v.w * v.w); if (lane == 0) rq[m] = rsqrtf(s * (1.f / 256.f) + EPS); }
        const bf16_t* zr = zkvr + (size_t)m * 256;
        float s1 = 0.f; if (lane < 32) { const f32x4 v = load4bf(zr + 4 * lane); s1 = v.x * v.x + v.y * v.y + v.z * v.z + v.w * v.w; }
        s1 = wave_sum(s1); if (lane == 0) rkv[m] = rsqrtf(s1 * (1.f / 128.f) + EPS);
        float e = 0.f; if (lane < 32) { e = bf2f(zr[128 + lane]); }
        const float s2 = wave_sum(e * e); const float rkr = rsqrtf(s2 * (1.f / 32.f) + EPS);
        if (lane < 16) {
            const float y1 = bf2f(zr[128 + lane]) * rkr * p.g_k_rope[lane], y2 = bf2f(zr[128 + 16 + lane]) * rkr * p.g_k_rope[16 + lane];
            float cs = 1.f, sn = 0.f; int b, key;
            if (m < NLAT) { const int t = m & 4095; b = m >> 12; key = CTXL + t; const int pos = lane < 8 ? (t >> 6) : (t & 63); cs = rope[(pos * 8 + (lane & 7)) * 2]; sn = rope[(pos * 8 + (lane & 7)) * 2 + 1]; }
            else { b = (m - NLAT) >> 8; key = (m - NLAT) & 255; }
            const bf16_t o1 = (bf16_t)f2bf(y1 * cs - y2 * sn), o2 = (bf16_t)f2bf(y1 * sn + y2 * cs);
#pragma unroll
            for (int h = 0; h < 8; ++h) { bf16_t* kp = Kb + ((size_t)(b * 8 + h) * NKEY + key) * 96 + 64; kp[lane] = o1; kp[16 + lane] = o2; }
        }
    }
}

DEVI void phase_mla_q_naive(const P& p, int bid, int nblk) {
    const bf16_t* zq = (const bf16_t*)(p.ws + WS_ZQ); const float* rq = (const float*)(p.ws + WS_RSTDQ); bf16_t* Q = (bf16_t*)(p.ws + WS_A);
    const float* rope = (const float*)(p.ws + WS_ROPE);
    for (int id = bid * NTHR + tid_(); id < NLAT * 8; id += nblk * NTHR) {
        const int m = id >> 3, h = id & 7, b = m >> 12, t = m & 4095;
        float acc[96];
#pragma unroll
        for (int j = 0; j < 96; ++j) acc[j] = 0.f;
        const float rs = rq[m];
        for (int k = 0; k < 256; ++k) {
            const float c = bf2f(zq[(size_t)m * 256 + k]) * rs * p.g_q_lora[k];
            const f32x4* wp = (const f32x4*)(p.w_uq + (size_t)k * 768 + h * 96);
#pragma unroll
            for (int j = 0; j < 24; ++j) { const f32x4 w = wp[j]; acc[4 * j] = fmaf(c, w.x, acc[4 * j]); acc[4 * j + 1] = fmaf(c, w.y, acc[4 * j + 1]); acc[4 * j + 2] = fmaf(c, w.z, acc[4 * j + 2]); acc[4 * j + 3] = fmaf(c, w.w, acc[4 * j + 3]); }
        }
        float s = 0.f;
#pragma unroll
        for (int j = 0; j < 64; ++j) s = fmaf(acc[j], acc[j], s);
        const float r1 = rsqrtf(s * (1.f / 64.f) + EPS) * QSCALE;
        float s2 = 0.f;
#pragma unroll
        for (int j = 64; j < 96; ++j) s2 = fmaf(acc[j], acc[j], s2);
        const float r2 = rsqrtf(s2 * (1.f / 32.f) + EPS) * QSCALE;
        bf16_t* qo = Q + ((size_t)(b * 8 + h) * SEQ + t) * 96;
#pragma unroll
        for (int j = 0; j < 64; j += 2) *(unsigned*)(qo + j) = pk2(acc[j] * r1 * p.g_q_nope[j], acc[j + 1] * r1 * p.g_q_nope[j + 1]);
        float o[32];
#pragma unroll
        for (int i = 0; i < 16; ++i) {
            const int pos = i < 8 ? (t >> 6) : (t & 63); const float cs = rope[(pos * 8 + (i & 7)) * 2], sn = rope[(pos * 8 + (i & 7)) * 2 + 1];
            const float y1 = acc[64 + i] * r2 * p.g_q_rope[i], y2 = acc[80 + i] * r2 * p.g_q_rope[16 + i];
            o[i] = y1 * cs - y2 * sn; o[16 + i] = y1 * sn + y2 * cs;
        }
#pragma unroll
        for (int j = 0; j < 32; j += 2) *(unsigned*)(qo + 64 + j) = pk2(o[j], o[j + 1]);
    }
}

DEVI void phase_mla_kv_naive(const P& p, int bid, int nblk) {
    const bf16_t* zkvr = (const bf16_t*)(p.ws + WS_ZKVR); const float* rkv = (const float*)(p.ws + WS_RSTDKV);
    bf16_t* Kb = (bf16_t*)(p.ws + WS_K); bf16_t* VT = (bf16_t*)(p.ws + WS_VT);
    for (int id = bid * NTHR + tid_(); id < NROW * 8; id += nblk * NTHR) {
        const int m = id >> 3, h = id & 7;
        int b, key; if (m < NLAT) { b = m >> 12; key = CTXL + (m & 4095); } else { b = (m - NLAT) >> 8; key = (m - NLAT) & 255; }
        float ak[64], av[64];
#pragma unroll
        for (int j = 0; j < 64; ++j) { ak[j] = 0.f; av[j] = 0.f; }
        const float rs = rkv[m];
        for (int k = 0; k < 128; ++k) {
            const float c = bf2f(zkvr[(size_t)m * 256 + k]) * rs * p.g_kv_lora[k];
            const f32x4* wk = (const f32x4*)(p.w_uk + (size_t)k * 512 + h * 64); const f32x4* wv = (const f32x4*)(p.w_uv + (size_t)k * 512 + h * 64);
#pragma unroll
            for (int j = 0; j < 16; ++j) {
                const f32x4 a = wk[j], v = wv[j];
                ak[4 * j] = fmaf(c, a.x, ak[4 * j]); ak[4 * j + 1] = fmaf(c, a.y, ak[4 * j + 1]); ak[4 * j + 2] = fmaf(c, a.z, ak[4 * j + 2]); ak[4 * j + 3] = fmaf(c, a.w, ak[4 * j + 3]);
                av[4 * j] = fmaf(c, v.x, av[4 * j]); av[4 * j + 1] = fmaf(c, v.y, av[4 * j + 1]); av[4 * j + 2] = fmaf(c, v.z, av[4 * j + 2]); av[4 * j + 3] = fmaf(c, v.w, av[4 * j + 3]);
            }
        }
        float s = 0.f;
#pragma unroll
        for (int j = 0; j < 64; ++j) s = fmaf(ak[j], ak[j], s);
        const float r1 = rsqrtf(s * (1.f / 64.f) + EPS);
        bf16_t* ko = Kb + ((size_t)(b * 8 + h) * NKEY + key) * 96;
#pragma unroll
        for (int j = 0; j < 64; j += 2) *(unsigned*)(ko + j) = pk2(ak[j] * r1 * p.g_k_nope[j], ak[j + 1] * r1 * p.g_k_nope[j + 1]);
        bf16_t* vo = VT + ((size_t)(b * 8 + h) * 64) * NKEY + key;
#pragma unroll
        for (int j = 0; j < 64; ++j) vo[(size_t)j * NKEY] = (bf16_t)f2bf(av[j]);
    }
}

DEVI void phase_attn_naive(const P& p, int bid, int nblk) {
    const bf16_t* Q = (const bf16_t*)(p.ws + WS_A); const bf16_t* Kb = (const bf16_t*)(p.ws + WS_K); const bf16_t* VT = (const bf16_t*)(p.ws + WS_VT);
    bf16_t* O = (bf16_t*)(p.ws + WS_ATTN); const float shift = ((const float*)(p.ws + WS_SMAX))[0];
    for (int id = bid * NTHR + tid_(); id < NB * 8 * SEQ; id += nblk * NTHR) {
        const int bh = id >> 12, t = id & 4095;
        u32x4 qv[12];
        { const u32x4* qp = (const u32x4*)(Q + (size_t)id * 96);
#pragma unroll
          for (int j = 0; j < 12; ++j) qv[j] = qp[j]; }
        float o[64];
#pragma unroll
        for (int j = 0; j < 64; ++j) o[j] = 0.f;
        float l = 0.f;
        const bf16_t* kp = Kb + (size_t)bh * NKEY * 96; const bf16_t* vp = VT + (size_t)bh * 64 * NKEY;
        for (int k0 = 0; k0 < NKEY; k0 += 8) {
            float pr[8];
#pragma unroll
            for (int kk = 0; kk < 8; ++kk) {
                const u32x4* kr = (const u32x4*)(kp + (size_t)(k0 + kk) * 96); float s = 0.f;
#pragma unroll
                for (int j = 0; j < 12; ++j) s = dot8(qv[j], kr[j], s);
                pr[kk] = exp2f(s - shift); l += pr[kk];
            }
#pragma unroll
            for (int d = 0; d < 64; ++d) {
                const u32x4 v = *(const u32x4*)(vp + (size_t)d * NKEY + k0); float a = o[d];
                a = fmaf(pr[0], bflo(v.x), a); a = fmaf(pr[1], bfhi(v.x), a); a = fmaf(pr[2], bflo(v.y), a); a = fmaf(pr[3], bfhi(v.y), a);
                a = fmaf(pr[4], bflo(v.z), a); a = fmaf(pr[5], bfhi(v.z), a); a = fmaf(pr[6], bflo(v.w), a); a = fmaf(pr[7], bfhi(v.w), a);
                o[d] = a;
            }
        }
        const float inv = 1.f / l; const int b = bh >> 3, h = bh & 7;
        bf16_t* op = O + ((size_t)(b * SEQ + t)) * 512 + h * 64;
#pragma unroll
        for (int d = 0; d < 64; d += 2) *(unsigned*)(op + d) = pk2(o[d] * inv, o[d + 1] * inv);
    }
}

DEVI void phase_attn(const P& p, int bid, int nblk, LAS unsigned char* lds) {
    const int tid = tid_(), wid = __builtin_amdgcn_readfirstlane(tid >> 6), lane = tid & 63, r = lane & 31, hh = lane >> 5;
    const bf16_t* Q = (const bf16_t*)(p.ws + WS_A); const bf16_t* Kb = (const bf16_t*)(p.ws + WS_K); const bf16_t* VT = (const bf16_t*)(p.ws + WS_VT);
    bf16_t* O = (bf16_t*)(p.ws + WS_ATTN); const float nshift = -((const float*)(p.ws + WS_SMAX))[0];
    const int vcu = (nblk & 7) == 0 ? (bid & 7) * (nblk >> 3) + (bid >> 3) : bid;
    constexpr int KROW = 208, KBUF = 64 * KROW, VROW = 136, VBUF = 64 * VROW, BUFSZ = KBUF + VBUF, NT = NKEY / 64;
    const int kp0 = tid, kp1 = tid + 512;
    const unsigned kl0 = (unsigned)((kp0 / 12) * KROW + (kp0 % 12) * 16), kl1 = (unsigned)((kp1 / 12) * KROW + (kp1 % 12) * 16);
    const unsigned vgo = (unsigned)((tid >> 3) * (NKEY * 2) + (tid & 7) * 16), vl = (unsigned)(KBUF + (tid >> 3) * VROW + (tid & 7) * 16);
    const bool k2 = tid < 256;
    for (int u = vcu; u < NB * 8 * 16; u += nblk) {
        const int bh = u >> 4, qb = u & 15;
        bf16x8 qf[6];
        { const bf16_t* qp = Q + ((size_t)bh * SEQ + qb * 256 + wid * 32 + r) * 96 + hh * 8;
#pragma unroll
          for (int ks = 0; ks < 6; ++ks) qf[ks] = *(const bf16x8*)(qp + ks * 16); }
        f32x16 o0, o1;
#pragma unroll
        for (int i = 0; i < 16; ++i) { o0[i] = 0.f; o1[i] = 0.f; }
        float l = 0.f;
        const char* kg = (const char*)(Kb + (size_t)bh * NKEY * 96); const char* vg = (const char*)(VT + (size_t)bh * 64 * NKEY);
        u32x4 kr0, kr1 = {0u, 0u, 0u, 0u}, vr;
        kr0 = *(const u32x4*)(kg + kp0 * 16); if (k2) kr1 = *(const u32x4*)(kg + kp1 * 16); vr = *(const u32x4*)(vg + vgo);
        __syncthreads();
        *(LAS u32x4*)(lds + kl0) = kr0; if (k2) *(LAS u32x4*)(lds + kl1) = kr1; *(LAS u32x2*)(lds + vl) = (u32x2){vr.x, vr.y}; *(LAS u32x2*)(lds + vl + 8) = (u32x2){vr.z, vr.w};
        __syncthreads();
        for (int j = 0; j < NT; ++j) {
            LAS unsigned char* buf = lds + (j & 1) * BUFSZ;
            if (j + 1 < NT) {
                const char* kt = kg + (size_t)(j + 1) * (64 * 192);
                kr0 = *(const u32x4*)(kt + kp0 * 16); if (k2) kr1 = *(const u32x4*)(kt + kp1 * 16); vr = *(const u32x4*)(vg + vgo + (size_t)(j + 1) * 128);
            }
#pragma unroll
            for (int sub = 0; sub < 2; ++sub) {
                f32x16 sacc;
#pragma unroll
                for (int i = 0; i < 16; ++i) sacc[i] = nshift;
#pragma unroll
                for (int ks = 0; ks < 6; ++ks) {
                    const bf16x8 kf = *(const LAS bf16x8*)(buf + (sub * 32 + r) * KROW + ks * 32 + hh * 16);
                    sacc = __builtin_amdgcn_mfma_f32_32x32x16_bf16(kf, qf[ks], sacc, 0, 0, 0);
                }
                float pr[16];
#pragma unroll
                for (int i = 0; i < 16; ++i) { pr[i] = __builtin_amdgcn_exp2f(sacc[i]); l += pr[i]; }
                u32x4 pb0, pb1;
                pb0.x = pk2(pr[0], pr[1]); pb0.y = pk2(pr[2], pr[3]); pb0.z = pk2(pr[4], pr[5]); pb0.w = pk2(pr[6], pr[7]);
                pb1.x = pk2(pr[8], pr[9]); pb1.y = pk2(pr[10], pr[11]); pb1.z = pk2(pr[12], pr[13]); pb1.w = pk2(pr[14], pr[15]);
                const bf16x8 pf0 = __builtin_bit_cast(bf16x8, pb0), pf1 = __builtin_bit_cast(bf16x8, pb1);
                const LAS unsigned char* vb = buf + KBUF + r * VROW + (sub * 32 + 4 * hh) * 2;
                {
                    const s16x4 a0 = *(const LAS s16x4*)(vb), a1 = *(const LAS s16x4*)(vb + 16), b0 = *(const LAS s16x4*)(vb + 32), b1 = *(const LAS s16x4*)(vb + 48);
                    const bf16x8 v0 = {a0[0], a0[1], a0[2], a0[3], a1[0], a1[1], a1[2], a1[3]}, v1 = {b0[0], b0[1], b0[2], b0[3], b1[0], b1[1], b1[2], b1[3]};
                    o0 = __builtin_amdgcn_mfma_f32_32x32x16_bf16(v0, pf0, o0, 0, 0, 0);
                    o0 = __builtin_amdgcn_mfma_f32_32x32x16_bf16(v1, pf1, o0, 0, 0, 0);
                }
                {
                    const LAS unsigned char* vc = vb + 32 * VROW;
                    const s16x4 a0 = *(const LAS s16x4*)(vc), a1 = *(const LAS s16x4*)(vc + 16), b0 = *(const LAS s16x4*)(vc + 32), b1 = *(const LAS s16x4*)(vc + 48);
                    const bf16x8 v0 = {a0[0], a0[1], a0[2], a0[3], a1[0], a1[1], a1[2], a1[3]}, v1 = {b0[0], b0[1], b0[2], b0[3], b1[0], b1[1], b1[2], b1[3]};
                    o1 = __builtin_amdgcn_mfma_f32_32x32x16_bf16(v0, pf0, o1, 0, 0, 0);
                    o1 = __builtin_amdgcn_mfma_f32_32x32x16_bf16(v1, pf1, o1, 0, 0, 0);
                }
            }
            if (j + 1 < NT) {
                LAS unsigned char* nb = lds + ((j + 1) & 1) * BUFSZ;
                *(LAS u32x4*)(nb + kl0) = kr0; if (k2) *(LAS u32x4*)(nb + kl1) = kr1; *(LAS u32x2*)(nb + vl) = (u32x2){vr.x, vr.y}; *(LAS u32x2*)(nb + vl + 8) = (u32x2){vr.z, vr.w};
            }
            __syncthreads();
        }
        const float inv = 1.f / (l + __shfl_xor(l, 32));
        const int b = bh >> 3, h = bh & 7;
        bf16_t* op = O + ((size_t)(b * SEQ + qb * 256 + wid * 32 + r)) * 512 + h * 64 + 4 * hh;
#pragma unroll
        for (int g = 0; g < 4; ++g) {
            u32x2 w0, w1;
            w0.x = pk2(o0[4 * g] * inv, o0[4 * g + 1] * inv); w0.y = pk2(o0[4 * g + 2] * inv, o0[4 * g + 3] * inv);
            w1.x = pk2(o1[4 * g] * inv, o1[4 * g + 1] * inv); w1.y = pk2(o1[4 * g + 2] * inv, o1[4 * g + 3] * inv);
            *(u32x2*)(op + 8 * g) = w0; *(u32x2*)(op + 32 + 8 * g) = w1;
        }
    }
}

DEVI void phase_norm2_router(const P& p, int bid, int nblk, unsigned char* lds) {
    const int tid = tid_(), lane = tid & 63, wave = tid >> 6;
    float* wrT = (float*)lds;
    for (int i = tid; i < 16384; i += NTHR) { const int k = i >> 4, e = i & 15; wrT[e * 1024 + k] = p.w_router[i]; }
    __syncthreads();
    const float* mod = (const float*)(p.ws + WS_MOD); bf16_t* hb = (bf16_t*)(p.ws + WS_A); float* aff = (float*)(p.ws + WS_AFF);
    for (int m = bid * 8 + wave; m < NLAT; m += nblk * 8) {
        const int b = m >> 12, t = m & 4095;
        const f32x4* xr = (const f32x4*)(p.out + (size_t)m * 1024) + lane;
        f32x4 v[4]; float s = 0.f;
#pragma unroll
        for (int j = 0; j < 4; ++j) { v[j] = xr[64 * j]; s += v[j].x * v[j].x + v[j].y * v[j].y + v[j].z * v[j].z + v[j].w * v[j].w; }
        const float rstd = rsqrtf(wave_sum(s) * (1.f / 1024.f) + EPS);
        u32x2* o = (u32x2*)(hb + (size_t)m * 1024) + lane;
#pragma unroll
        for (int j = 0; j < 4; ++j) {
            const int k = 4 * (lane + 64 * j);
            const f32x4 g = *(const f32x4*)(p.g_norm2 + k), sh = *(const f32x4*)(mod + b * 6144 + 3072 + k), sc = *(const f32x4*)(mod + b * 6144 + 4096 + k);
            v[j] = (v[j] * rstd * g) * (sc + 1.f) + sh;
            u32x2 w; w.x = pk2(v[j].x, v[j].y); w.y = pk2(v[j].z, v[j].w); o[64 * j] = w;
        }
        float lg[16];
#pragma unroll
        for (int e = 0; e < 16; ++e) {
            float a = 0.f;
#pragma unroll
            for (int j = 0; j < 4; ++j) { const f32x4 w = *(const f32x4*)(wrT + e * 1024 + 4 * (lane + 64 * j)); a += v[j].x * w.x + v[j].y * w.y + v[j].z * w.z + v[j].w * w.w; }
            lg[e] = wave_sum(a);
            asm volatile("" ::: "memory");
        }
        float mx = lg[0];
#pragma unroll
        for (int e = 1; e < 16; ++e) mx = fmaxf(mx, lg[e]);
        float den = 0.f;
#pragma unroll
        for (int e = 0; e < 16; ++e) { lg[e] = expf(lg[e] - mx); den += lg[e]; }
        const float inv = 1.f / den;
        float mine = 0.f;
#pragma unroll
        for (int e = 0; e < 16; ++e) mine = (lane == e) ? lg[e] * inv : mine;
        if (lane < 16) aff[((size_t)(b * 16 + lane)) * 4096 + t] = mine;
    }
}

DEVI void phase_topk(const P& p, int bid, int nblk, unsigned char* lds) {
    const int tid = tid_(), lane = tid & 63, wave = tid >> 6;
    unsigned* hist = (unsigned*)lds; unsigned* sh = hist + 256;
    const float* aff = (const float*)(p.ws + WS_AFF); int* idx = (int*)(p.ws + WS_IDX); float* gate = (float*)(p.ws + WS_GATE); int* slot_of = (int*)(p.ws + WS_SLOT);
    for (int item = bid; item < NB * NE; item += nblk) {
        const float* a = aff + (size_t)item * 4096 + tid * 8;
        unsigned u[8];
        { const u32x4 t0 = *(const u32x4*)a, t1 = *(const u32x4*)(a + 4); u[0] = t0.x; u[1] = t0.y; u[2] = t0.z; u[3] = t0.w; u[4] = t1.x; u[5] = t1.y; u[6] = t1.z; u[7] = t1.w; }
        unsigned prefix = 0u, mask = 0u, need = CAP;
        for (int pass = 0; pass < 4; ++pass) {
            const int shift = 24 - 8 * pass;
            if (tid < 256) hist[tid] = 0u;
            __syncthreads();
#pragma unroll
            for (int j = 0; j < 8; ++j) if ((u[j] & mask) == prefix) atomicAdd(&hist[(u[j] >> shift) & 255u], 1u);
            __syncthreads();
            if (tid == 0) { unsigned cum = 0u; int bsel = 255; for (; bsel > 0; --bsel) { const unsigned hc = hist[bsel]; if (cum + hc >= need) break; cum += hc; } sh[0] = (unsigned)bsel; sh[1] = need - cum; }
            __syncthreads();
            prefix |= sh[0] << shift; mask |= 255u << shift; need = sh[1];
            __syncthreads();
        }
        const unsigned T = prefix;
        unsigned cg = 0u, ce = 0u;
#pragma unroll
        for (int j = 0; j < 8; ++j) { cg += (u[j] > T) ? 1u : 0u; ce += (u[j] == T) ? 1u : 0u; }
        const unsigned packed = cg | (ce << 16);
        unsigned incl = packed;
#pragma unroll
        for (int o = 1; o < 64; o <<= 1) { const unsigned n = __shfl_up(incl, o); if (lane >= o) incl += n; }
        if (lane == 63) sh[8 + wave] = incl;
        __syncthreads();
        unsigned woff = 0u;
        for (int w = 0; w < wave; ++w) woff += sh[8 + w];
        const unsigned excl = incl - packed + woff;
        unsigned gb = excl & 0xffffu, eb = excl >> 16;
#pragma unroll
        for (int j = 0; j < 8; ++j) {
            const int i = tid * 8 + j; const bool gt = u[j] > T, eq = u[j] == T;
            int slot = -1;
            if (gt) slot = (int)(gb + (eb < need ? eb : need));
            else if (eq && eb < need) slot = (int)(gb + eb);
            if (slot >= 0) { idx[item * CAP + slot] = i; gate[item * CAP + slot] = __uint_as_float(u[j]); }
            slot_of[(size_t)item * 4096 + i] = slot;
            gb += gt ? 1u : 0u; eb += eq ? 1u : 0u;
        }
        __syncthreads();
    }
}

DEVI void phase_combine(const P& p, int bid, int nblk) {
    const int tid = tid_(), lane = tid & 63, wave = tid >> 6;
    const float* mod = (const float*)(p.ws + WS_MOD); const int* slot_of = (const int*)(p.ws + WS_SLOT); const bf16_t* Y = (const bf16_t*)(p.ws + WS_Y);
    for (int m = bid * 8 + wave; m < NLAT; m += nblk * 8) {
        const int b = m >> 12, t = m & 4095;
        f32x4 acc[4];
#pragma unroll
        for (int j = 0; j < 4; ++j) acc[j] = (f32x4){0.f, 0.f, 0.f, 0.f};
        for (int e = 0; e < NE; ++e) {
            const int s = slot_of[((size_t)(b * 16 + e)) * 4096 + t];
            if (s >= 0) {
                const u32x2* yp = (const u32x2*)(Y + ((size_t)(b * 16 + e) * CAP + s) * 1024) + lane;
#pragma unroll
                for (int j = 0; j < 4; ++j) { const u32x2 w = yp[64 * j]; acc[j] += (f32x4){bflo(w.x), bfhi(w.x), bflo(w.y), bfhi(w.y)}; }
            }
        }
        f32x4* op = (f32x4*)(p.out + (size_t)m * 1024) + lane;
#pragma unroll
        for (int j = 0; j < 4; ++j) { const f32x4 md = *(const f32x4*)(mod + b * 6144 + 5120 + 4 * (lane + 64 * j)); op[64 * j] = op[64 * j] + md * acc[j]; }
    }
}

template <int PH>
DEVI void run_phase(const P& p, int bid, int nblk, unsigned char* lds) {
    if (PH == 0) phase_prep(p, bid, nblk, lds);
    if (PH == 1) phase_norm1(p, bid, nblk);
    if (PH == 2) { G1 g{(const bf16_t*)(p.ws + WS_A), (const bf16_t*)(p.ws + WS_WIN), (bf16_t*)(p.ws + WS_ZRNN), (bf16_t*)(p.ws + WS_GELU), (bf16_t*)(p.ws + WS_ZQ), (bf16_t*)(p.ws + WS_ZKVR), (bf16_t*)(p.ws + WS_G)}; gemm_fast(g, bid, nblk, (LAS unsigned char*)lds); }
    if (PH == 3) phase_rnn<false>(p, bid, nblk, (LAS unsigned char*)lds);
    if (PH == 4) phase_rnn_carry(p, bid, nblk);
    if (PH == 5) phase_rnn<true>(p, bid, nblk, (LAS unsigned char*)lds);
    if (PH == 6) phase_mla_pre(p, bid, nblk);
    if (PH == 7) { GP4 g{p.ws, p.g_q_nope, p.g_q_rope, p.g_k_nope};
        gemm_fast(g, bid, nblk, (LAS unsigned char*)lds); }
    if (PH == 8) phase_attn(p, bid, nblk, (LAS unsigned char*)lds);
    if (PH == 9) phase_expert_convert(p, bid, nblk, lds);
    if (PH == 10) { G2 g{(const bf16_t*)(p.ws + WS_GELU), (const bf16_t*)(p.ws + WS_ATTN), (const bf16_t*)(p.ws + WS_WRNN), (const bf16_t*)(p.ws + WS_WMLA), (const bf16_t*)(p.ws + WS_G), (bf16_t*)(p.ws + WS_A)}; gemm_fast(g, bid, nblk, (LAS unsigned char*)lds); }
    if (PH == 11) { G3 g{(const bf16_t*)(p.ws + WS_A), (const bf16_t*)(p.ws + WS_WO), p.x, (const float*)(p.ws + WS_MOD), p.out}; gemm_fast(g, bid, nblk, (LAS unsigned char*)lds); }
    if (PH == 12) phase_norm2_router(p, bid, nblk, lds);
    if (PH == 13) phase_topk(p, bid, nblk, lds);
    if (PH == 14) { GM1 g{(const bf16_t*)(p.ws + WS_A), (const bf16_t*)(p.ws + WS_WGU), (const int*)(p.ws + WS_IDX), (bf16_t*)(p.ws + WS_HID)}; gemm_fast(g, bid, nblk, (LAS unsigned char*)lds); }
    if (PH == 15) { GM2 g{(const bf16_t*)(p.ws + WS_HID), (const bf16_t*)(p.ws + WS_WD), (const float*)(p.ws + WS_GATE), (bf16_t*)(p.ws + WS_Y)}; gemm_fast(g, bid, nblk, (LAS unsigned char*)lds); }
    if (PH == 16) phase_combine(p, bid, nblk);
}

#define XB_TMO      128
#define XB_XCNT(j)  (256  + 64 * (j))
#define XB_XSUB(j)  (1280 + 64 * (j))
#define XB_XGEN(j)  (2304 + 64 * (j))
#define XB_TOP      3328
#define XB_TOPGEN   3392
#define XCD_BAR_WORDS 3456
#define XB_SPIN_CAP (1u << 20)
DEVI unsigned xb_ld(unsigned* p)              { return __hip_atomic_load(p, __ATOMIC_RELAXED, __HIP_MEMORY_SCOPE_AGENT); }
DEVI unsigned xb_add(unsigned* p, unsigned v) { return __hip_atomic_fetch_add(p, v, __ATOMIC_RELAXED, __HIP_MEMORY_SCOPE_AGENT); }
DEVI unsigned xb_xcc_id() { return (unsigned)__builtin_amdgcn_s_getreg((3 << 11) | 20) & 0xFu; }
#define XB_SPIN(cond, bar) do { unsigned _sp = 0; while (cond) { __builtin_amdgcn_s_sleep(1); \
    if ((++_sp & 255u) == 0u) { if (xb_ld(&(bar)[XB_TMO])) break; if (_sp > XB_SPIN_CAP) { atomicAdd(&(bar)[XB_TMO], 1u); break; } } } } while (0)
struct XcdBarrier { unsigned* bar; unsigned x; volatile LAS unsigned* st; };
DEVI XcdBarrier xcd_barrier_post(unsigned* bar, volatile LAS unsigned* st) {
    XcdBarrier b; b.bar = bar; b.x = xb_xcc_id(); b.st = st;
    if (threadIdx.x == 0) (void)xb_add(&bar[XB_XCNT(b.x)], 1u);
    return b;
}
DEVI void xcd_barrier_complete(unsigned* bar, unsigned x, unsigned& nloc, unsigned& nx) {
    const unsigned G = gridDim.x * gridDim.y * gridDim.z;
    unsigned sum, cnt, mine, sp = 0u;
    for (;;) {
        sum = 0u; cnt = 0u; mine = 0u;
#pragma unroll
        for (unsigned j = 0; j < 16; ++j) { const unsigned c = xb_ld(&bar[XB_XCNT(j)]); sum += c; cnt += (c > 0u) ? 1u : 0u; mine = (j == x) ? c : mine; }
        if (sum == G) break;
        __builtin_amdgcn_s_sleep(1);
        if ((++sp & 255u) == 0u) { if (xb_ld(&bar[XB_TMO])) break; if (sp > XB_SPIN_CAP) { atomicAdd(&bar[XB_TMO], 1u); break; } }
    }
    nloc = mine > 0u ? mine : 1u; nx = cnt > 0u ? cnt : 1u;
}
DEVI void xcd_barrier(const XcdBarrier& b) {
    asm volatile("s_waitcnt vmcnt(0)" ::: "memory");
    __syncthreads();
    if (threadIdx.x == 0) {
        unsigned* bar = b.bar;
        __builtin_amdgcn_s_waitcnt(0);
        unsigned nloc = b.st[0], nx = b.st[1];
        if (nloc == 0u) { xcd_barrier_complete(bar, b.x, nloc, nx); b.st[0] = nloc; b.st[1] = nx; }
        const unsigned old = xb_add(&bar[XB_XSUB(b.x)], 1u);
        const unsigned gen = old / nloc;
        if (old + 1u == (gen + 1u) * nloc) {
            __builtin_amdgcn_fence(__ATOMIC_RELEASE, "agent");
            asm volatile("s_waitcnt vmcnt(0)" ::: "memory");
            const unsigned og = xb_add(&bar[XB_TOP], 1u);
            const unsigned tg = og / nx;
            if (og + 1u == (tg + 1u) * nx) xb_add(&bar[XB_TOPGEN], 1u);
            else XB_SPIN(xb_ld(&bar[XB_TOPGEN]) == tg, bar);
            __builtin_amdgcn_fence(__ATOMIC_ACQUIRE, "agent");
            xb_add(&bar[XB_XGEN(b.x)], 1u);
            asm volatile("s_waitcnt vmcnt(0)" ::: "memory");
        } else {
            XB_SPIN(xb_ld(&bar[XB_XGEN(b.x)]) == gen, bar);
            __builtin_amdgcn_fence(__ATOMIC_ACQUIRE, "agent");
            asm volatile("s_waitcnt vmcnt(0)" ::: "memory");
        }
    }
    __syncthreads();
}

constexpr int CW_BAR = 4096;

__global__ void __launch_bounds__(NTHR, 2) mega_fwd(P p) {
    extern __shared__ __attribute__((aligned(16))) unsigned char lds[];
    const int bid = (int)blockIdx.x, nblk = (int)gridDim.x;
    volatile LAS unsigned* MISC = (volatile LAS unsigned*)((LAS unsigned char*)lds + MISC_OFF);
    if (threadIdx.x < 32) MISC[threadIdx.x] = 0u;
    if ((threadIdx.x & 63) == 0) MISC[32 + hw_slot_()] = threadIdx.x >> 6;
    __syncthreads();
    XcdBarrier bar = xcd_barrier_post((unsigned*)(p.ws + WS_CTL) + CW_BAR, MISC + 8);
#define SEAM() do { xcd_barrier(bar); asm volatile("" : "+s"(p.ws)); } while (0)
    run_phase<0>(p, bid, nblk, lds); SEAM();
    run_phase<1>(p, bid, nblk, lds); SEAM();
    run_phase<2>(p, bid, nblk, lds); SEAM();
    run_phase<3>(p, bid, nblk, lds); SEAM();
    run_phase<4>(p, bid, nblk, lds); SEAM();
    run_phase<5>(p, bid, nblk, lds); SEAM();
    run_phase<6>(p, bid, nblk, lds); SEAM();
    run_phase<7>(p, bid, nblk, lds); SEAM();
    run_phase<8>(p, bid, nblk, lds); SEAM();
    run_phase<9>(p, bid, nblk, lds); SEAM();
    run_phase<10>(p, bid, nblk, lds); SEAM();
    run_phase<11>(p, bid, nblk, lds); SEAM();
    run_phase<12>(p, bid, nblk, lds); SEAM();
    run_phase<13>(p, bid, nblk, lds); SEAM();
    run_phase<14>(p, bid, nblk, lds); SEAM();
    run_phase<15>(p, bid, nblk, lds); SEAM();
    run_phase<16>(p, bid, nblk, lds);
#undef SEAM
}

extern "C" void kernel_launch(void* const* d_in, const int* in_sizes, int n_in, void* d_out, int out_size, void* d_ws, size_t ws_size, hipStream_t stream) {
    static int grid = 0;
    if (grid == 0) {
        if (n_in != 32 || ws_size < WS_END) { fprintf(stderr, "kernel_launch: unexpected n_in %d / ws_size %zu\n", n_in, ws_size); grid = -1; return; }
        int dev = 0, cus = 0, per_cu = 0;
        if (hipGetDevice(&dev) != hipSuccess || hipDeviceGetAttribute(&cus, hipDeviceAttributeMultiprocessorCount, dev) != hipSuccess) { grid = -1; return; }
        if (hipFuncSetAttribute((const void*)mega_fwd, hipFuncAttributeMaxDynamicSharedMemorySize, LDS_BYTES) != hipSuccess) { fprintf(stderr, "kernel_launch: hipFuncSetAttribute failed\n"); grid = -1; return; }
        if (hipOccupancyMaxActiveBlocksPerMultiprocessor(&per_cu, (const void*)mega_fwd, NTHR, LDS_BYTES) != hipSuccess || per_cu < 1) { fprintf(stderr, "kernel_launch: occupancy query says %d\n", per_cu); }
        (void)hipGetLastError();
        grid = cus;
    }
    if (grid < 0) return;
    P p{};
    const float** fp = (const float**)&p;
    for (int i = 0; i < 32; ++i) fp[i] = (const float*)d_in[i];
    p.out = (float*)d_out; p.ws = (unsigned char*)d_ws;
    (void)hipMemsetAsync((char*)d_ws + WS_CTL, 0, 1 * MiB, stream);
    hipLaunchKernelGGL(mega_fwd, dim3(grid), dim3(NTHR), LDS_BYTES, stream, p);
}
```

```cpp
#include <hip/hip_runtime.h>
#include <stdint.h>
#include <stdio.h>

#define DEVI __device__ __forceinline__
typedef unsigned short bf16_t;
typedef float f32x4 __attribute__((ext_vector_type(4)));
typedef unsigned u32x4 __attribute__((ext_vector_type(4)));
typedef unsigned u32x2 __attribute__((ext_vector_type(2)));

constexpr int NTHR = 512;
constexpr int DM = 1024, NB = 8, SEQ = 4096, CTXL = 256;
constexpr int NLAT = NB * SEQ, NCTX = NB * CTXL, NROW = NLAT + NCTX, NKEY = SEQ + CTXL;
constexpr int NE = 16, CAP = 512;
constexpr float EPS = 1e-6f;
constexpr float QSCALE = 0.10206207261596575f * 1.4426950408889634f;

constexpr size_t MiB = 1u << 20;
constexpr size_t WS_CTL = 0;
constexpr size_t WS_MOD = 1 * MiB;
constexpr size_t WS_ROPE = WS_MOD + 256 * 1024;
constexpr size_t WS_SP = WS_ROPE + 4096;
constexpr size_t WS_SMAX = WS_SP + 8192;
constexpr size_t WS_RSTDQ = 1 * MiB + 512 * 1024;
constexpr size_t WS_RSTDKV = WS_RSTDQ + 128 * 1024;
constexpr size_t WS_WIN = 2 * MiB;
constexpr size_t WS_WRNN = 11 * MiB;
constexpr size_t WS_WMLA = 13 * MiB;
constexpr size_t WS_WO = 14 * MiB;
constexpr size_t WS_WUQ = 16 * MiB;
constexpr size_t WS_WUK = WS_WUQ + 384 * 1024;
constexpr size_t WS_WUV = WS_WUK + 256 * 1024;
constexpr size_t WS_WRG = 17 * MiB;
constexpr size_t WS_RNNSUM = 18 * MiB;
constexpr size_t WS_WIN8 = 27 * MiB;
constexpr size_t WS_A18 = 393 * MiB;
constexpr size_t WS_AFF = 27 * MiB;
constexpr size_t WS_IDX = 29 * MiB;
constexpr size_t WS_GATE = WS_IDX + 256 * 1024;
constexpr size_t WS_SLOT = WS_GATE + 256 * 1024;
constexpr size_t WS_A = 32 * MiB;
constexpr size_t WS_ZRNN = 100 * MiB;
constexpr size_t WS_GELU = 168 * MiB;
constexpr size_t WS_ZQ = 232 * MiB;
constexpr size_t WS_ZKVR = 248 * MiB;
constexpr size_t WS_ATTN = 232 * MiB;
constexpr size_t WS_G = 265 * MiB;
constexpr size_t WS_K = 393 * MiB;
constexpr size_t WS_VT = 444 * MiB;
constexpr size_t WS_HID = 265 * MiB;
constexpr size_t WS_Y = 100 * MiB;
constexpr int E_EARLY = 15;
constexpr size_t WS_WGU_LO = 496 * MiB;
constexpr size_t WS_WGU_MID = 96 * MiB;
constexpr size_t WS_WGU_WIN = 2 * MiB;
constexpr size_t WS_WGU_GAP = 478 * MiB;
DEVI size_t wgu_off(int e) { return e < 8 ? WS_WGU_LO + (size_t)e * 2048 * 1024 : e < 10 ? WS_WGU_MID + (size_t)(e - 8) * 2048 * 1024 : e < 14 ? WS_WGU_WIN + (size_t)(e - 10) * 2048 * 1024
                                    : e == 14 ? WS_WGU_GAP : (393 * MiB) + (size_t)e * 2048 * 1024; }
constexpr size_t WS_WGU = 393 * MiB;
constexpr size_t WS_WD = 480 * MiB;
constexpr size_t WS_HF = 393 * MiB;
constexpr size_t WS_END = 512 * MiB;

struct P {
    const float *x, *c, *ctx, *c_ctx, *w_ada, *b_ada, *g_norm1, *g_norm2, *w_in, *conv_w, *conv_b, *rg_wa, *rg_ba, *rg_wx, *rg_bx, *rg_lambda,
        *w_rnn_out, *g_q_lora, *w_uq, *g_kv_lora, *w_uk, *w_uv, *g_q_nope, *g_q_rope, *g_k_nope, *g_k_rope, *w_mla_out, *w_o, *w_router, *w_e_gate,
        *w_e_up, *w_e_down;
    float* out;
    unsigned char* ws;
};

DEVI unsigned f2bf(float f) { unsigned u = __float_as_uint(f); return (u + 0x7fffu + ((u >> 16) & 1u)) >> 16; }
typedef __bf16 bf16v2 __attribute__((ext_vector_type(2)));
typedef float f32x2 __attribute__((ext_vector_type(2)));
DEVI unsigned pk2(float lo, float hi) { const f32x2 v = {lo, hi}; return __builtin_bit_cast(unsigned, __builtin_convertvector(v, bf16v2)); }
DEVI float bflo(unsigned u) { return __uint_as_float(u << 16); }
DEVI float bfhi(unsigned u) { return __uint_as_float(u & 0xffff0000u); }
DEVI float bf2f(bf16_t h) { return __uint_as_float(((unsigned)h) << 16); }
template <int M> DEVI float swz_xor(float x) { return __int_as_float(__builtin_amdgcn_ds_swizzle(__float_as_int(x), (M << 10) | 0x1f)); }
typedef unsigned u32x2v __attribute__((ext_vector_type(2)));
DEVI float xor32_sum(float x) { const u32x2v r = __builtin_amdgcn_permlane32_swap(__float_as_uint(x), __float_as_uint(x), false, false); return __uint_as_float(r[0]) + __uint_as_float(r[1]); }
DEVI float xor32_get(float x, int hi) { const u32x2v r = __builtin_amdgcn_permlane32_swap(__float_as_uint(x), __float_as_uint(x), false, false); return __uint_as_float(hi ? r[0] : r[1]); }
DEVI float xor32_max(float x) { const u32x2v r = __builtin_amdgcn_permlane32_swap(__float_as_uint(x), __float_as_uint(x), false, false); return fmaxf(__uint_as_float(r[0]), __uint_as_float(r[1])); }
DEVI float wave_max(float v) { v = fmaxf(v, swz_xor<1>(v)); v = fmaxf(v, swz_xor<2>(v)); v = fmaxf(v, swz_xor<4>(v)); v = fmaxf(v, swz_xor<8>(v)); v = fmaxf(v, swz_xor<16>(v)); return xor32_max(v); }
DEVI float wave_sum(float v) { v += swz_xor<1>(v); v += swz_xor<2>(v); v += swz_xor<4>(v); v += swz_xor<8>(v); v += swz_xor<16>(v); return xor32_sum(v); }
DEVI float sigm(float x) { return __builtin_amdgcn_rcpf(1.f + __builtin_amdgcn_exp2f(-1.4426950408889634f * x)); }
DEVI float gelu_tanh(float x) { const float u = 0.7978845608028654f * (x + 0.044715f * x * x * x); return x * sigm(2.f * u); }
#define GAS __attribute__((address_space(1)))
template <class T> DEVI T* uptr(T* p) { const unsigned long long v = (unsigned long long)p; const unsigned lo = __builtin_amdgcn_readfirstlane((unsigned)v), hi = __builtin_amdgcn_readfirstlane((unsigned)(v >> 32)); return (T*)(((unsigned long long)hi << 32) | lo); }
DEVI u32x4 gld16(const void* p) { return *(const GAS u32x4*)p; }
DEVI u32x2 gld8(const void* p) { return *(const GAS u32x2*)p; }
DEVI f32x4 gldf4(const void* p) { return *(const GAS f32x4*)p; }
DEVI float gldf(const void* p) { return *(const GAS float*)p; }
DEVI void gst16(void* p, u32x4 v) { *(GAS u32x4*)p = v; }
DEVI void gst8(void* p, u32x2 v) { *(GAS u32x2*)p = v; }
DEVI void gstf4(void* p, f32x4 v) { *(GAS f32x4*)p = v; }
DEVI void store4bf(bf16_t* o, f32x4 v) { u32x2 w; w.x = pk2(v.x, v.y); w.y = pk2(v.z, v.w); gst8(o, w); }
DEVI f32x4 load4bf(const bf16_t* o) { const u32x2 w = gld8(o); return (f32x4){bflo(w.x), bfhi(w.x), bflo(w.y), bfhi(w.y)}; }
DEVI float dot8(u32x4 a, u32x4 b, float acc) {
    acc = fmaf(bflo(a.x), bflo(b.x), acc); acc = fmaf(bfhi(a.x), bfhi(b.x), acc);
    acc = fmaf(bflo(a.y), bflo(b.y), acc); acc = fmaf(bfhi(a.y), bfhi(b.y), acc);
    acc = fmaf(bflo(a.z), bflo(b.z), acc); acc = fmaf(bfhi(a.z), bfhi(b.z), acc);
    acc = fmaf(bflo(a.w), bflo(b.w), acc); acc = fmaf(bfhi(a.w), bfhi(b.w), acc);
    return acc;
}
constexpr int LDS_BYTES = 147456;
constexpr int MISC_OFF = LDS_BYTES - 512;
DEVI unsigned hw_slot_() { return (unsigned)__builtin_amdgcn_s_getreg((5 << 11) | 4) & 63u; }
DEVI int tid_() {
    extern __shared__ __attribute__((aligned(16))) unsigned char lds_dyn_[];
    int w = (int)((volatile __attribute__((address_space(3))) unsigned*)((__attribute__((address_space(3))) unsigned char*)lds_dyn_ + MISC_OFF))[32 + hw_slot_()];
    w = __builtin_amdgcn_readfirstlane(w);
    int l; asm volatile("v_mbcnt_lo_u32_b32 %0, -1, 0\n\tv_mbcnt_hi_u32_b32 %0, -1, %0" : "=v"(l));
    int t = w * 64 + l;
    asm volatile("" : "+v"(t));
    return t;
}
#define LDS_WAIT() asm volatile("s_waitcnt lgkmcnt(0)" ::: "memory")
constexpr float W8_SCALE = 64.f; constexpr int W8_MXS = 0x79797979;
DEVI unsigned pk4f8(f32x4 v) { unsigned w = __builtin_amdgcn_cvt_pk_fp8_f32(v.x, v.y, 0u, false); return __builtin_amdgcn_cvt_pk_fp8_f32(v.z, v.w, w, true); }

template <class RM>
DEVI void transpose_item(const float* W, int ldw, int K, bf16_t* WT, RM rm, float* scr, int k0, int n0, int lane, const float* kscale = nullptr, float mul = 1.f) {
#pragma unroll 8
    for (int i = 0; i < 8; ++i) { const int kk = 8 * i + (lane >> 3), c4 = (lane & 7) * 4;
        f32x4 v = gldf4(W + (size_t)(k0 + kk) * ldw + n0 + c4); if (kscale) v = v * kscale[k0 + kk]; v = v * mul;
        float* d = scr + kk * 33 + c4; d[0] = v.x; d[1] = v.y; d[2] = v.z; d[3] = v.w; }
    LDS_WAIT();
    const int c = lane & 7;
#pragma unroll
    for (int j = 0; j < 4; ++j) {
        const int n = (lane >> 3) + 8 * j; const float* s = scr + (8 * c) * 33 + n;
        u32x4 o; o.x = pk2(s[0 * 33], s[1 * 33]); o.y = pk2(s[2 * 33], s[3 * 33]); o.z = pk2(s[4 * 33], s[5 * 33]); o.w = pk2(s[6 * 33], s[7 * 33]);
        *(u32x4*)(WT + (size_t)rm(n0 + n) * K + k0 + 8 * c) = o;
    }
    LDS_WAIT();
}
struct RmId { DEVI int operator()(int n) const { return n; } };
DEVI int perm_slot(int n) { const int x = n & 31; return (n & ~31) + 16 * ((x >> 2) & 1) + 4 * (x >> 3) + (x & 3); }
struct RmPerm { DEVI int operator()(int n) const { return perm_slot(n); } };
struct RmWin { DEVI int operator()(int n) const { return perm_slot(n < 2464 ? n : n + 96); } };
struct RmUq { DEVI int operator()(int n) const { const int head = n / 96, dd = n % 96; return dd < 64 ? (head >> 2) * 256 + 128 * (dd >> 5) + 32 * (head & 3) + (dd & 31) : 512 + 128 * (head >> 2) + 32 * (head & 3) + (dd - 64); } };
struct RmUk { DEVI int operator()(int n) const { const int head = n >> 6, d = n & 63; return (head >> 2) * 256 + 128 * (d >> 5) + 32 * (head & 3) + (d & 31); } };
struct RmGU { int up; DEVI int operator()(int n) const { const int hl = n & 127, wc = hl >> 5, fq = (hl >> 3) & 3, bj = (hl >> 2) & 1, j = hl & 3; return (n >> 7) * 256 + 128 * bj + 32 * wc + 16 * up + 4 * fq + j; } };

template <class RM>
DEVI void transpose_item8(const float* W, int ldw, int K, unsigned char* WT, RM rm, float* scr, int k0, int n0, int lane) {
#pragma unroll 8
    for (int i = 0; i < 8; ++i) { const int kk = 8 * i + (lane >> 3), c4 = (lane & 7) * 4;
        const f32x4 v = gldf4(W + (size_t)(k0 + kk) * ldw + n0 + c4) * W8_SCALE;
        float* d = scr + kk * 33 + c4; d[0] = v.x; d[1] = v.y; d[2] = v.z; d[3] = v.w; }
    LDS_WAIT();
    const int c = lane & 7;
#pragma unroll
    for (int j = 0; j < 4; ++j) {
        const int n = (lane >> 3) + 8 * j; const float* sp = scr + (8 * c) * 33 + n;
        u32x2 o; o.x = pk4f8((f32x4){sp[0 * 33], sp[1 * 33], sp[2 * 33], sp[3 * 33]}); o.y = pk4f8((f32x4){sp[4 * 33], sp[5 * 33], sp[6 * 33], sp[7 * 33]});
        gst8(WT + (size_t)rm(n0 + n) * K + k0 + 8 * c, o);
    }
    LDS_WAIT();
}
DEVI void phase_prep(const P& p, int bid, int nblk, unsigned char* lds) {
    const int tid = tid_(), lane = tid & 63, wave = tid >> 6;
    float* mod = (float*)(p.ws + WS_MOD);
    if (bid < 192) {
        float* sc = (float*)lds; float* red = sc + 9 * 1024;
        for (int i = tid; i < 9 * 1024; i += NTHR) { const int r = i >> 10, k = i & 1023; const float v = r < 8 ? p.c[r * 1024 + k] : p.c_ctx[k]; sc[i] = v * sigm(v); }
        __syncthreads();
        for (int item = bid; item < 192; item += nblk) {
            const int n0 = item * 32, col = tid & 31, kg = tid >> 5;
            float acc[9];
#pragma unroll
            for (int r = 0; r < 9; ++r) acc[r] = 0.f;
            for (int kk = 0; kk < 64; kk += 16) {
                float w[16];
#pragma unroll
                for (int q = 0; q < 16; ++q) w[q] = gldf(p.w_ada + (size_t)(kg * 64 + kk + q) * 6144 + n0 + col);
#pragma unroll
                for (int q = 0; q < 16; ++q) {
                    const int k = kg * 64 + kk + q;
#pragma unroll
                    for (int r = 0; r < 9; ++r) acc[r] = fmaf(sc[r * 1024 + k], w[q], acc[r]);
                }
            }
#pragma unroll
            for (int r = 0; r < 9; ++r) red[(kg * 9 + r) * 32 + col] = acc[r];
            __syncthreads();
            if (tid < 9 * 32) { const int r = tid >> 5, cc = tid & 31; float s = 0.f; for (int g = 0; g < 16; ++g) s += red[(g * 9 + r) * 32 + cc]; mod[r * 6144 + n0 + cc] = s + p.b_ada[n0 + cc]; }
            __syncthreads();
        }
    }
    __syncthreads();
    if (bid == nblk - 1) {
        float* rope = (float*)(p.ws + WS_ROPE); float* sp = (float*)(p.ws + WS_SP); float* smax = (float*)(p.ws + WS_SMAX);
        { const int pos = tid >> 3, j = tid & 7; const float inv = powf(10000.f, -(float)j / 8.f); const float ang = (float)pos * inv;
          const float n = rintf(ang * 0.15915494309189535f); float r = fmaf(-n, 6.2831854820251465f, ang); r = fmaf(-n, -1.7484555e-7f, r);
          rope[2 * tid] = __cosf(r); rope[2 * tid + 1] = __sinf(r); }
        for (int i = tid; i < 2048; i += NTHR) { const float lam = p.rg_lambda[i]; sp[i] = 8.f * log1pf(__expf(-lam)); }
        if (tid == 0) {
            float a = 0.f, b = 0.f, cc = 0.f, d = 0.f;
            for (int i = 0; i < 64; ++i) { a = fmaxf(a, fabsf(p.g_q_nope[i])); cc = fmaxf(cc, fabsf(p.g_k_nope[i])); }
            for (int i = 0; i < 32; ++i) { b = fmaxf(b, fabsf(p.g_q_rope[i])); d = fmaxf(d, fabsf(p.g_k_rope[i])); }
            smax[0] = (64.f * a * cc + 32.f * b * d) * QSCALE * 1.01f + 0.5f;
        }
    }
    { u32x4* z = (u32x4*)(p.ws + WS_WIN + (size_t)2464 * 1024 * 2); const u32x4 zero = {0u, 0u, 0u, 0u};
      for (int i = bid * NTHR + tid; i < 96 * 1024 * 2 / 16; i += nblk * NTHR) z[i] = zero; }
    { const u32x4 zero = {0u, 0u, 0u, 0u};
      for (int i = bid * NTHR + tid; i < 1024 * 16; i += nblk * NTHR) *(u32x4*)(p.ws + WS_WUK + (size_t)(i >> 4) * 512 + 256 + (i & 15) * 16) = zero; }
    float* scr = (float*)lds + wave * (64 * 33);
    const int gw = bid * 8 + wave, NGW = nblk * 8;
    constexpr int I_WIN8 = 16 * 64;
    for (int it = gw; it < I_WIN8; it += NGW)
        transpose_item8(p.w_in + 2464, 4512, 1024, p.ws + WS_WIN8, RmPerm(), scr, 64 * (it / 64), 32 * (it % 64), lane);
    constexpr int I_WIN = 16 * 141, I_RNN = 16 * 32, I_MLA = 8 * 32, I_WO = 16 * 32, I_RG = 32 * 8, I_UQ = 4 * 24, I_UK = 2 * 16, I_UV = 2 * 16;
    for (int it = gw; it < I_WIN + I_RNN + I_MLA + I_WO + I_RG + I_UQ + I_UK + I_UV; it += NGW) {
        int r = it;
        if (r < I_UQ) { transpose_item(p.w_uq, 768, 256, (bf16_t*)(p.ws + WS_WUQ), RmUq(), scr, 64 * (r / 24), 32 * (r % 24), lane, p.g_q_lora); continue; } r -= I_UQ;
        if (r < I_UK) { transpose_item(p.w_uk, 512, 256, (bf16_t*)(p.ws + WS_WUK), RmUk(), scr, 64 * (r / 16), 32 * (r % 16), lane, p.g_kv_lora); continue; } r -= I_UK;
        if (r < I_UV) { transpose_item(p.w_uv, 512, 256, (bf16_t*)(p.ws + WS_WUV), RmId(), scr, 64 * (r / 16), 32 * (r % 16), lane, p.g_kv_lora); continue; } r -= I_UV;
        if (r < I_RG) { const int mi = r >> 3, sub = r & 7; const float* src = ((mi >> 4) ? p.rg_wx : p.rg_wa) + (size_t)(mi & 15) * 16384;
            transpose_item(src, 128, 128, (bf16_t*)(p.ws + WS_WRG) + (size_t)mi * 16384, RmId(), scr, 64 * (sub >> 2), 32 * (sub & 3), lane, nullptr, -1.4426950408889634f); continue; } r -= I_RG;
        if (r < I_WIN) { transpose_item(p.w_in, 4512, 1024, (bf16_t*)(p.ws + WS_WIN), RmWin(), scr, 64 * (r / 141), 32 * (r % 141), lane); continue; } r -= I_WIN;
        if (r < I_RNN) { transpose_item(p.w_rnn_out, 1024, 1024, (bf16_t*)(p.ws + WS_WRNN), RmPerm(), scr, 64 * (r / 32), 32 * (r % 32), lane); continue; } r -= I_RNN;
        if (r < I_MLA) { transpose_item(p.w_mla_out, 1024, 512, (bf16_t*)(p.ws + WS_WMLA), RmPerm(), scr, 64 * (r / 32), 32 * (r % 32), lane); continue; } r -= I_MLA;
        transpose_item(p.w_o, 1024, 1024, (bf16_t*)(p.ws + WS_WO), RmPerm(), scr, 64 * (r / 32), 32 * (r % 32), lane);
    }
}

DEVI void phase_expert_convert(const P& p, int part, int b0, int bid, int nblk, unsigned char* lds, int e0 = 0, int e1 = 16) {
    const int tid = tid_(), lane = tid & 63, wave = tid >> 6;
    float* scr = (float*)lds + wave * (64 * 33);
    const int gw = (bid - b0) * 8 + wave, NGW = (nblk - b0) * 8;
    if (bid < b0) return;
    if (part == 0) {
        const int ne = e1 - e0;
        for (int it = gw; it < 2 * ne * 512; it += NGW) {
            const int which = it / (ne * 512), r = it % (ne * 512), e = e0 + r / 512, t = r % 512, k0 = 64 * (t / 32), n0 = 32 * (t % 32);
            if (which == 0) transpose_item8(p.w_e_gate + (size_t)e * 1048576, 1024, 1024, p.ws + wgu_off(e), RmGU{0}, scr, k0, n0, lane);
            else transpose_item8(p.w_e_up + (size_t)e * 1048576, 1024, 1024, p.ws + wgu_off(e), RmGU{1}, scr, k0, n0, lane);
        }
    } else {
        for (int it = gw; it < 16 * 512; it += NGW) {
            const int e = it / 512, t = it % 512, k0 = 64 * (t / 32), n0 = 32 * (t % 32);
            transpose_item8(p.w_e_down + (size_t)e * 1048576, 1024, 1024, p.ws + WS_WD + (size_t)e * 1024 * 1024, RmPerm(), scr, k0, n0, lane);
        }
    }
}

DEVI void phase_norm1(const P& p, int bid, int nblk) {
    const int tid = tid_(), lane = tid & 63, wave = tid >> 6;
    const float* mod = (const float*)(p.ws + WS_MOD);
    bf16_t* A1 = (bf16_t*)(p.ws + WS_A);
    const int NGW = nblk * 8, per = (NROW + NGW - 1) / NGW, m0 = (bid * 8 + wave) * per, m1 = (m0 + per < NROW) ? m0 + per : NROW;
    if (m0 >= m1) return;
#define N1_SRC(m_) ((m_) < NLAT ? p.x + (size_t)(m_) * 1024 : p.ctx + (size_t)((m_) - NLAT) * 1024)
    f32x4 vn[4];
#pragma unroll
    for (int j = 0; j < 4; ++j) vn[j] = gldf4(N1_SRC(m0) + 4 * (lane + 64 * j));
    int mrc = -1; f32x4 gs[4], sh[4];
    for (int m = m0; m < m1; ++m) {
        f32x4 v[4];
#pragma unroll
        for (int j = 0; j < 4; ++j) v[j] = vn[j];
        if (m + 1 < m1) {
#pragma unroll
            for (int j = 0; j < 4; ++j) vn[j] = gldf4(N1_SRC(m + 1) + 4 * (lane + 64 * j));
        }
        const int mr = m < NLAT ? (m >> 12) : 8;
        if (mr != mrc) { mrc = mr;
#pragma unroll
            for (int j = 0; j < 4; ++j) { const int k = 4 * (lane + 64 * j); gs[j] = gldf4(p.g_norm1 + k) * (gldf4(mod + mr * 6144 + 1024 + k) + 1.f); sh[j] = gldf4(mod + mr * 6144 + k); } }
        float s = 0.f;
#pragma unroll
        for (int j = 0; j < 4; ++j) s += v[j].x * v[j].x + v[j].y * v[j].y + v[j].z * v[j].z + v[j].w * v[j].w;
        const float rstd = rsqrtf(wave_sum(s) * (1.f / 1024.f) + EPS);
        bf16_t* o = A1 + (size_t)m * 1024 + 4 * lane; unsigned char* o8 = p.ws + WS_A18 + (size_t)m * 1024 + 4 * lane;
#pragma unroll
        for (int j = 0; j < 4; ++j) { const f32x4 y = v[j] * rstd * gs[j] + sh[j]; store4bf(o + 256 * j, y); if (m < NLAT) *(GAS unsigned*)(o8 + 256 * j) = pk4f8(y); }
    }
#undef N1_SRC
}

#define LAS __attribute__((address_space(3)))
typedef short bf16x8 __attribute__((ext_vector_type(8)));
typedef int i32x8 __attribute__((ext_vector_type(8)));
typedef int i32x4 __attribute__((ext_vector_type(4)));
typedef float f32x16 __attribute__((ext_vector_type(16)));
typedef short s16x4 __attribute__((ext_vector_type(4)));
namespace fg {
constexpr int HTB = 128 * 64 * 2;
DEVI int lds_byte(int r, int c) { const int st = (r >> 4) * 2 + (c >> 5), rr = r & 15, cc = c & 31, ob = rr * 64 + cc * 2; return st * 1024 + (ob ^ (((ob >> 9) & 1) << 5)); }
DEVI void stage_rc(int b, int& R, int& C) { const int st = b / 1024, sb = b % 1024, swz = sb ^ (((sb >> 9) & 1) << 5); R = (st >> 1) * 16 + swz / 64; C = (st & 1) * 32 + (swz % 64) / 2; }
}
template <class G>
DEVI void gemm_fast(const G& g, int bid, int nblk, LAS unsigned char* lds) {
    using namespace fg;
    const int tid = tid_(), wid = __builtin_amdgcn_readfirstlane(tid >> 6), lane = tid & 63, wr = wid >> 2, wc = wid & 3, fr = lane & 15, fq = lane >> 4;
    int R0, C0, R1, C1; stage_rc(tid * 16, R0, C0); stage_rc(tid * 16 + 8192, R1, C1);
    const unsigned ldsw = (unsigned)wid * 1024u;
    const int aoff = lds_byte(wr * 64 + fr, fq * 8), boff = lds_byte(wc * 32 + fr, fq * 8);
#define FG_SA(b, h) (((b) * 2 + (h)) * HTB)
#define FG_SB(b, h) ((4 + (b) * 2 + (h)) * HTB)
#define FG_GLDS(src, dstoff) __builtin_amdgcn_global_load_lds((const unsigned*)(src), (LAS unsigned*)(lds + (dstoff)), 16, 0, 0)
#define FG_STAGE_A(bufoff, h, kt) do { const char* _b = xA + (size_t)(kt) * 128 + (G::GATHER ? (size_t)0 : (size_t)(h) * hstepA); FG_GLDS(_b + oA[G::GATHER ? (h) : 0][0], (bufoff) + ldsw); FG_GLDS(_b + oA[G::GATHER ? (h) : 0][1], (bufoff) + ldsw + 8192); } while (0)
#define FG_STAGE_B(bufoff, h, kt) do { const char* _b = xB + (size_t)(h) * hstepB + (size_t)(kt) * 128; FG_GLDS(_b + oB[0], (bufoff) + ldsw); FG_GLDS(_b + oB[1], (bufoff) + ldsw + 8192); } while (0)
#define FG_LDA(dst, b, h) do { _Pragma("unroll") for (int m = 0; m < 4; ++m) { if constexpr (G::FP8) { \
        const i32x4 lo_ = *(const LAS i32x4*)(lds + FG_SA(b, h) + aoff + m * 2048), hi_ = *(const LAS i32x4*)(lds + FG_SA(b, h) + aoff + m * 2048 + 1024); dst##8[m] = __builtin_shufflevector(lo_, hi_, 0, 1, 2, 3, 4, 5, 6, 7); } \
        else { _Pragma("unroll") for (int k = 0; k < 2; ++k) dst[m][k] = *(const LAS bf16x8*)(lds + FG_SA(b, h) + aoff + m * 2048 + k * 1024); } } } while (0)
#define FG_LDB(dst, b, h) do { _Pragma("unroll") for (int n = 0; n < 2; ++n) { if constexpr (G::FP8) { \
        const i32x4 lo_ = *(const LAS i32x4*)(lds + FG_SB(b, h) + boff + n * 2048), hi_ = *(const LAS i32x4*)(lds + FG_SB(b, h) + boff + n * 2048 + 1024); dst##8[n] = __builtin_shufflevector(lo_, hi_, 0, 1, 2, 3, 4, 5, 6, 7); } \
        else { _Pragma("unroll") for (int k = 0; k < 2; ++k) dst[n][k] = *(const LAS bf16x8*)(lds + FG_SB(b, h) + boff + n * 2048 + k * 1024); } } } while (0)
#define FG_MMA(ai, bj, At, Bt) do { __builtin_amdgcn_s_setprio(1); _Pragma("unroll") for (int m = 0; m < 4; ++m) _Pragma("unroll") for (int n = 0; n < 2; ++n) { \
        if constexpr (G::FP8) {   \
            acc[ai][bj][m][n] = __builtin_amdgcn_mfma_scale_f32_16x16x128_f8f6f4(Bt##8[n], At##8[m], acc[ai][bj][m][n], 0, 0, 0, G::SCALE_W, 0, 0x7F7F7F7F); \
        } else { _Pragma("unroll") for (int k = 0; k < 2; ++k) acc[ai][bj][m][n] = __builtin_amdgcn_mfma_f32_16x16x32_bf16(Bt[n][k], At[m][k], acc[ai][bj][m][n], 0, 0, 0); } } \
        if constexpr (G::FP8) asm volatile("" : "+v"(acc[ai][bj][0][0]), "+v"(acc[ai][bj][0][1]), "+v"(acc[ai][bj][1][0]), "+v"(acc[ai][bj][1][1]), "+v"(acc[ai][bj][2][0]), "+v"(acc[ai][bj][2][1]), "+v"(acc[ai][bj][3][0]), "+v"(acc[ai][bj][3][1]));     \
        __builtin_amdgcn_s_setprio(0); } while (0)
#define FG_WAIT_V(n) asm volatile("s_waitcnt vmcnt(" #n ")" ::: "memory")
#define FG_WAIT_L(n) asm volatile("s_waitcnt lgkmcnt(" #n ")" ::: "memory")
#define FG_BAR __builtin_amdgcn_s_barrier()
#define FG_SCHED __builtin_amdgcn_sched_barrier(0)
#define FG_SCHED8 do { if constexpr (G::FP8) __builtin_amdgcn_sched_barrier(0); } while (0)
#define FG_SETCTX(U_) do { xA = g.abase(U_); xB = g.bbase(U_); const int _K = g.K(U_); \
        oA[0][0] = g.arow_off(U_, R0) + (unsigned)C0 * 2u; oA[0][1] = g.arow_off(U_, R1) + (unsigned)C1 * 2u; \
        if (G::GATHER) { oA[1][0] = g.arow_off(U_, 128 + R0) + (unsigned)C0 * 2u; oA[1][1] = g.arow_off(U_, 128 + R1) + (unsigned)C1 * 2u; } else hstepA = (size_t)128 * _K * 2; \
        oB[0] = (unsigned)(R0 * _K + C0) * 2u; oB[1] = (unsigned)(R1 * _K + C1) * 2u; hstepB = (size_t)128 * _K * 2; } while (0)
    typename G::U cur, nxt; int ui = 0;
    if (!g.sched(0, bid, nblk, cur)) return;
    f32x4 acc[2][2][4][2];
#pragma unroll
    for (int a = 0; a < 2; ++a)
#pragma unroll
        for (int b = 0; b < 2; ++b)
#pragma unroll
            for (int m = 0; m < 4; ++m)
#pragma unroll
                for (int n = 0; n < 2; ++n) acc[a][b][m][n] = (f32x4){0.f, 0.f, 0.f, 0.f};
    bf16x8 At[4][2], B0[2][2], B1[2][2]; i32x8 At8[4], B08[2], B18[2];
    const char* xA; const char* xB; unsigned oA[2][2], oB[2]; size_t hstepB, hstepA = 0;
    FG_SETCTX(cur);
    int nt = g.K(cur) / 64;
    FG_STAGE_B(FG_SB(0, 0), 0, 0); FG_STAGE_A(FG_SA(0, 0), 0, 0); FG_STAGE_B(FG_SB(0, 1), 1, 0); FG_STAGE_A(FG_SA(0, 1), 1, 0);
    if (wr == 1) FG_BAR;
    FG_WAIT_V(4); FG_BAR;
    FG_STAGE_B(FG_SB(1, 0), 0, 1); FG_STAGE_A(FG_SA(1, 0), 0, 1); FG_STAGE_B(FG_SB(1, 1), 1, 1);
    FG_WAIT_V(6); FG_BAR;
    for (;;) {
        const bool has_next = g.sched(ui + 1, bid, nblk, nxt);
        unsigned oAn[2][2] = {{0u, 0u}, {0u, 0u}};
        if constexpr (G::GATHER) { if (has_next) { oAn[0][0] = g.arow_off(nxt, R0) + (unsigned)C0 * 2u; oAn[0][1] = g.arow_off(nxt, R1) + (unsigned)C1 * 2u; oAn[1][0] = g.arow_off(nxt, 128 + R0) + (unsigned)C0 * 2u; oAn[1][1] = g.arow_off(nxt, 128 + R1) + (unsigned)C1 * 2u; } }
        for (int t = 0; t < nt; t += 2) {
            const bool last = (t == nt - 2);
            FG_LDB(B0, 0, 0); FG_SCHED; FG_LDA(At, 0, 0); FG_STAGE_A(FG_SA(1, 1), 1, t + 1);
            FG_WAIT_L(8); FG_BAR; FG_WAIT_L(0); FG_SCHED8; FG_MMA(0, 0, At, B0); FG_BAR; FG_SCHED;
            int t2 = t + 2;
            if (last) { t2 = 0; if (has_next) { if constexpr (G::GATHER) { xA = g.abase(nxt); xB = g.bbase(nxt); const int _K = g.K(nxt); oA[0][0] = oAn[0][0]; oA[0][1] = oAn[0][1]; oA[1][0] = oAn[1][0]; oA[1][1] = oAn[1][1];
                        oB[0] = (unsigned)(R0 * _K + C0) * 2u; oB[1] = (unsigned)(R1 * _K + C1) * 2u; hstepB = (size_t)128 * _K * 2; } else { FG_SETCTX(nxt); } } }
            FG_LDB(B1, 0, 1); FG_STAGE_B(FG_SB(0, 0), 0, t2);
            FG_BAR; FG_WAIT_L(0); FG_SCHED8; FG_MMA(0, 1, At, B1); FG_BAR; FG_SCHED8;
            FG_LDA(At, 0, 1); FG_STAGE_A(FG_SA(0, 0), 0, t2);
            FG_BAR; FG_WAIT_L(0); FG_SCHED8; FG_MMA(1, 0, At, B0); FG_BAR; FG_SCHED;
            FG_STAGE_B(FG_SB(0, 1), 1, t2);
            FG_WAIT_V(6); FG_BAR; FG_SCHED8; FG_MMA(1, 1, At, B1); FG_BAR; FG_SCHED8;
            FG_LDB(B0, 1, 0); FG_SCHED; FG_LDA(At, 1, 0); FG_STAGE_A(FG_SA(0, 1), 1, t2);
            FG_WAIT_L(8); FG_BAR; FG_WAIT_L(0); FG_SCHED8; FG_MMA(0, 0, At, B0); FG_BAR; FG_SCHED;
            FG_LDB(B1, 1, 1); FG_STAGE_B(FG_SB(1, 0), 0, t2 + 1);
            FG_BAR; FG_WAIT_L(0); FG_SCHED8; FG_MMA(0, 1, At, B1); FG_BAR; FG_SCHED8;
            FG_LDA(At, 1, 1); FG_STAGE_A(FG_SA(1, 0), 0, t2 + 1);
            FG_BAR; FG_WAIT_L(0); FG_SCHED8; FG_MMA(1, 0, At, B0); FG_BAR; FG_SCHED;
            FG_STAGE_B(FG_SB(1, 1), 1, t2 + 1);
            FG_WAIT_V(6); FG_BAR; FG_SCHED8; FG_MMA(1, 1, At, B1); FG_BAR; FG_SCHED8;
        }
        const int te_ = tid_();
        const int rbase_ = 64 * ((te_ >> 8) & 1) + (te_ & 15), cb_ = 32 * ((te_ >> 6) & 3) + 4 * ((te_ >> 4) & 3);
#pragma unroll
        for (int bt = 0; bt < 8 / G::EPI_FENCE; ++bt) {
            typename G::Pre pre[G::EPI_FENCE];
#pragma unroll
            for (int q = 0; q < G::EPI_FENCE; ++q) { const int rw = bt * G::EPI_FENCE + q, ai = rw >> 2, m = rw & 3; g.pre(cur, rbase_ + 128 * ai + 16 * m, cb_, pre[q]); }
#pragma unroll
            for (int q = 0; q < G::EPI_FENCE; ++q) { const int rw = bt * G::EPI_FENCE + q, ai = rw >> 2, m = rw & 3;
                g.epi4(cur, rbase_ + 128 * ai + 16 * m, cb_, acc[ai][0][m][0], acc[ai][0][m][1], acc[ai][1][m][0], acc[ai][1][m][1], pre[q]); }
            asm volatile("" ::: "memory");
        }
        if (!has_next) break;
#pragma unroll
        for (int a = 0; a < 2; ++a)
#pragma unroll
            for (int b = 0; b < 2; ++b)
#pragma unroll
                for (int m = 0; m < 4; ++m)
#pragma unroll
                    for (int n = 0; n < 2; ++n) acc[a][b][m][n] = (f32x4){0.f, 0.f, 0.f, 0.f};
        cur = nxt; nt = g.K(cur) / 64; ++ui;
    }
    FG_WAIT_V(0);
    if (wr == 0) FG_BAR;
    FG_BAR;
#undef FG_SA
#undef FG_SB
#undef FG_GLDS
#undef FG_STAGE_A
#undef FG_STAGE_B
#undef FG_LDA
#undef FG_LDB
#undef FG_MMA
#undef FG_WAIT_V
#undef FG_WAIT_L
#undef FG_BAR
#undef FG_SCHED
#undef FG_SCHED8
#undef FG_SETCTX
}

DEVI bool tile_order(int i, int bid, int nblk, int nM, int nN, int& pm, int& pn) {
    const int nwg = nM * nN; const long L = (long)i * nblk + bid; if (L >= nwg) return false;
    int wgid = (int)L; { const int q = nwg / 8, r = nwg % 8, xcd = wgid % 8, off = wgid / 8; wgid = (xcd < r ? xcd * (q + 1) : r * (q + 1) + (xcd - r) * q) + off; }
    const int nig = 8 * nN, gid = wgid / nig, fm = gid * 8, gsz = (nM - fm) < 8 ? (nM - fm) : 8;
    pm = fm + ((wgid % nig) % gsz); pn = (wgid % nig) / gsz; return true;
}
DEVI int xcd_contig(int i, int bid, int nblk, int nwg) {
    const long L = (long)i * nblk + bid; if (L >= nwg) return -1;
    return ((int)L % 8) * (nwg / 8) + (int)L / 8;
}
struct NoPre {};
DEVI int col8(int cb) { return (cb & ~31) + 2 * (cb & 31); }
DEVI void store8bf(bf16_t* o, f32x4 a, f32x4 b) { u32x4 w; w.x = pk2(a.x, a.y); w.y = pk2(a.z, a.w); w.z = pk2(b.x, b.y); w.w = pk2(b.z, b.w); gst16(o, w); }
DEVI void unpack8bf(u32x4 w, f32x4& a, f32x4& b) { a = (f32x4){bflo(w.x), bfhi(w.x), bflo(w.y), bfhi(w.y)}; b = (f32x4){bflo(w.z), bfhi(w.z), bflo(w.w), bfhi(w.w)}; }
DEVI f32x4 gelu4(f32x4 v) { return (f32x4){gelu_tanh(v.x), gelu_tanh(v.y), gelu_tanh(v.z), gelu_tanh(v.w)}; }
DEVI f32x4 sigm4(f32x4 v) { return (f32x4){sigm(v.x), sigm(v.y), sigm(v.z), sigm(v.w)}; }

struct G1 {
    static constexpr bool FP8 = false; static constexpr int SCALE_W = 0;
    static constexpr int EPI_FENCE = 8;
    static constexpr bool GATHER = false;
    const bf16_t* A; const bf16_t* Bt; bf16_t *zrnn, *zgelu, *zq, *zkvr, *g;
    struct U { int pm, pn; };
    DEVI bool sched(int i, int bid, int nblk, U& r) const {
        if (tile_order(i, bid, nblk, 128, 10, r.pm, r.pn)) return true;
        const int v = i * nblk + bid - 1280; if (v >= 40) return false;
        const int j = v % 5; r.pm = 128 + v / 5; r.pn = j < 4 ? j : 9; return true; }
    DEVI int K(const U&) const { return 1024; }
    DEVI const char* abase(const U& u) const { return (const char*)(A + (size_t)u.pm * 256 * 1024); }
    DEVI unsigned arow_off(const U&, int r) const { return (unsigned)r * 2048u; }
    DEVI const char* bbase(const U& u) const { return (const char*)(Bt + (size_t)u.pn * 256 * 1024); }
    typedef NoPre Pre;
    DEVI void pre(const U&, int, int, Pre&) const {}
    DEVI void epi4(const U& u, int r, int cb, f32x4 a, f32x4 b, f32x4 c, f32x4 d, const Pre&) const { const int c8 = col8(cb); epi8(u, r, c8, a, b); epi8(u, r, 128 + c8, c, d); }
    DEVI void epi8(const U& u, int r, int c, f32x4 v0, f32x4 v1) const {
        const size_t row = (size_t)u.pm * 256 + r;
        if (u.pn < 4) store8bf(zrnn + row * 1024 + u.pn * 256 + c, v0, v1);
        else if (u.pn < 8) store8bf(zgelu + row * 1024 + (u.pn - 4) * 256 + c, gelu4(v0), gelu4(v1));
        else if (u.pn == 8) store8bf(zq + row * 256 + c, v0, v1);
        else if (u.pn == 9) store8bf(zkvr + row * 256 + c, v0, v1);
        else store8bf(g + row * 2048 + (u.pn - 10) * 256 + c, sigm4(v0), sigm4(v1));
    }
};

struct G1g {
    static constexpr bool FP8 = true; static constexpr int SCALE_W = W8_MXS;
    static constexpr int EPI_FENCE = 8;
    static constexpr bool GATHER = false;
    const unsigned char *A8, *W8; bf16_t* g;
    struct U { int pm, pn; };
    DEVI bool sched(int i, int bid, int nblk, U& r) const { return tile_order(i, bid, nblk, 128, 8, r.pm, r.pn); }
    DEVI int K(const U&) const { return 512; }
    DEVI const char* abase(const U& u) const { return (const char*)(A8 + (size_t)u.pm * 256 * 1024); }
    DEVI unsigned arow_off(const U&, int r) const { return (unsigned)r * 1024u; }
    DEVI const char* bbase(const U& u) const { return (const char*)(W8 + (size_t)u.pn * 256 * 1024); }
    typedef NoPre Pre;
    DEVI void pre(const U&, int, int, Pre&) const {}
    DEVI void epi4(const U& u, int r, int cb, f32x4 a, f32x4 b, f32x4 c, f32x4 d, const Pre&) const {
        bf16_t* o = g + ((size_t)u.pm * 256 + r) * 2048 + u.pn * 256 + col8(cb);
        store8bf(o, sigm4(a), sigm4(b)); store8bf(o + 128, sigm4(c), sigm4(d));
    }
};

struct G2 {
    static constexpr bool FP8 = false; static constexpr int SCALE_W = 0;
    static constexpr int EPI_FENCE = 4;
    static constexpr bool GATHER = false;
    const bf16_t *rnn, *attn, *WrT, *WmT, *g; bf16_t* merged;
    struct U { int pm, pn, sub; };
    DEVI bool sched(int i, int bid, int nblk, U& r) const { r.sub = i & 1; return tile_order(i >> 1, bid, nblk, 128, 4, r.pm, r.pn); }
    DEVI int K(const U& u) const { return u.sub ? 512 : 1024; }
    DEVI const char* abase(const U& u) const { return u.sub ? (const char*)(attn + (size_t)u.pm * 256 * 512) : (const char*)(rnn + (size_t)u.pm * 256 * 1024); }
    DEVI unsigned arow_off(const U& u, int r) const { return (unsigned)r * (u.sub ? 1024u : 2048u); }
    DEVI const char* bbase(const U& u) const { return u.sub ? (const char*)(WmT + (size_t)u.pn * 256 * 512) : (const char*)(WrT + (size_t)u.pn * 256 * 1024); }
    struct Pre { u32x4 g[2], m[2]; };
    DEVI void pre(const U& u, int r, int cb, Pre& q) const {
        const size_t row = (size_t)u.pm * 256 + r; const int col = u.pn * 256 + col8(cb);
        q.g[0] = gld16(g + row * 2048 + u.sub * 1024 + col); q.g[1] = gld16(g + row * 2048 + u.sub * 1024 + col + 128);
        if (u.sub) { q.m[0] = gld16(merged + row * 1024 + col); q.m[1] = gld16(merged + row * 1024 + col + 128); }
    }
    DEVI void epi4(const U& u, int r, int cb, f32x4 a, f32x4 b, f32x4 c, f32x4 d, const Pre& q) const {
        const size_t row = (size_t)u.pm * 256 + r; const int col = u.pn * 256 + col8(cb);
        bf16_t* o = merged + row * 1024 + col;
        f32x4 g0, g1, h0, h1; unpack8bf(q.g[0], g0, g1); unpack8bf(q.g[1], h0, h1);
        f32x4 r0 = g0 * a, r1 = g1 * b, r2 = h0 * c, r3 = h1 * d;
        if (u.sub) { f32x4 p0, p1, p2, p3; unpack8bf(q.m[0], p0, p1); unpack8bf(q.m[1], p2, p3); r0 += p0; r1 += p1; r2 += p2; r3 += p3; }
        store8bf(o, r0, r1); store8bf(o + 128, r2, r3);
    }
};

struct G3 {
    static constexpr bool FP8 = false; static constexpr int SCALE_W = 0;
    static constexpr int EPI_FENCE = 4;
    static constexpr bool GATHER = false;
    const bf16_t *A, *Bt; const float *x, *mod; float* out;
    struct U { int pm, pn; };
    DEVI bool sched(int i, int bid, int nblk, U& r) const { return tile_order(i, bid, nblk, 128, 4, r.pm, r.pn); }
    DEVI int K(const U&) const { return 1024; }
    DEVI const char* abase(const U& u) const { return (const char*)(A + (size_t)u.pm * 256 * 1024); }
    DEVI unsigned arow_off(const U&, int r) const { return (unsigned)r * 2048u; }
    DEVI const char* bbase(const U& u) const { return (const char*)(Bt + (size_t)u.pn * 256 * 1024); }
    struct Pre { f32x4 x[4]; };
    DEVI void pre(const U& u, int r, int cb, Pre& q) const {
        const float* xp = x + ((size_t)u.pm * 256 + r) * 1024 + u.pn * 256 + col8(cb);
        q.x[0] = gldf4(xp); q.x[1] = gldf4(xp + 4); q.x[2] = gldf4(xp + 128); q.x[3] = gldf4(xp + 132);
    }
    DEVI void epi4(const U& u, int r, int cb, f32x4 a, f32x4 b, f32x4 c, f32x4 d, const Pre& q) const {
        const size_t row = (size_t)u.pm * 256 + r; const int col = u.pn * 256 + col8(cb);
        const float* mp = mod + (u.pm >> 4) * 6144 + 2048 + col; float* o = out + row * 1024 + col;
        gstf4(o, q.x[0] + gldf4(mp) * a); gstf4(o + 4, q.x[1] + gldf4(mp + 4) * b);
        gstf4(o + 128, q.x[2] + gldf4(mp + 128) * c); gstf4(o + 132, q.x[3] + gldf4(mp + 132) * d);
    }
};

struct GM1 {
    static constexpr int EPI_FENCE = 8;
    static constexpr bool GATHER = true;
    static constexpr bool FP8 = true; static constexpr int SCALE_W = W8_MXS;
    const unsigned char *h8, *Wgu8; const int* idx; unsigned char* hid8;
    struct U { int be, pm, pn; };
    DEVI bool sched(int i, int bid, int nblk, U& r) const { const int w = xcd_contig(i, bid, nblk, 128 * 16); if (w < 0) return false;
        const int pair = w >> 4, e = pair >> 3, b = pair & 7; r.be = b * 16 + e; r.pm = w & 1; r.pn = (w >> 1) & 7; return true; }
    DEVI int K(const U&) const { return 512; }
    DEVI const char* abase(const U& u) const { return (const char*)(h8 + (size_t)(u.be >> 4) * 4096 * 1024); }
    DEVI unsigned arow_off(const U& u, int r) const { return (unsigned)idx[u.be * 512 + u.pm * 256 + r] * 1024u; }
    DEVI const char* bbase(const U& u) const { return (const char*)(Wgu8 + wgu_off(u.be & 15) + (size_t)u.pn * 256 * 1024); }
    typedef NoPre Pre;
    DEVI void pre(const U&, int, int, Pre&) const {}
    DEVI void epi4(const U& u, int r, int cb, f32x4 g0, f32x4 u0, f32x4 g1, f32x4 u1, const Pre&) const {
        const int hidx = u.pn * 128 + (cb & ~31) + 2 * (cb & 31);
        u32x2 w; w.x = pk4f8(g0 * sigm4(g0) * u0); w.y = pk4f8(g1 * sigm4(g1) * u1);
        gst8(hid8 + ((size_t)u.be * 512 + u.pm * 256 + r) * 1024 + hidx, w);
    }
};

struct GM2 {
    static constexpr int EPI_FENCE = 8;
    static constexpr bool GATHER = false;
    static constexpr bool FP8 = true; static constexpr int SCALE_W = W8_MXS;
    const unsigned char *hid8, *Wd8; const float* gate; bf16_t* Y;
    struct U { int be, pm, pn; };
    DEVI bool sched(int i, int bid, int nblk, U& r) const { const int w = xcd_contig(i, bid, nblk, 128 * 8); if (w < 0) return false;
        const int pair = w >> 3, e = pair >> 3, b = pair & 7; r.be = b * 16 + e; r.pm = w & 1; r.pn = (w >> 1) & 3; return true; }
    DEVI int K(const U&) const { return 512; }
    DEVI const char* abase(const U& u) const { return (const char*)(hid8 + ((size_t)u.be * 512 + u.pm * 256) * 1024); }
    DEVI unsigned arow_off(const U&, int r) const { return (unsigned)r * 1024u; }
    DEVI const char* bbase(const U& u) const { return (const char*)(Wd8 + ((size_t)(u.be & 15) * 1024 + u.pn * 256) * 1024); }
    struct Pre { float gt; };
    DEVI void pre(const U& u, int r, int, Pre& q) const { q.gt = gldf(gate + (size_t)u.be * 512 + u.pm * 256 + r); }
    DEVI void epi4(const U& u, int r, int cb, f32x4 a, f32x4 b, f32x4 c, f32x4 d, const Pre& q) const {
        bf16_t* o = Y + ((size_t)u.be * 512 + u.pm * 256 + r) * 1024 + u.pn * 256 + col8(cb);
        store8bf(o, a * q.gt, b * q.gt); store8bf(o + 128, c * q.gt, d * q.gt);
    }
};

DEVI float dot4(f32x4 a) { return a.x * a.x + a.y * a.y + a.z * a.z + a.w * a.w; }
struct GP4 {
    static constexpr bool FP8 = false; static constexpr int SCALE_W = 0;
    static constexpr int EPI_FENCE = 4;
    static constexpr bool GATHER = false;
    unsigned char* ws; const LAS float* cst;
    struct U { int type, pm, pn; };
    DEVI bool sched(int i, int bid, int nblk, U& r) const {
        const int u = i * nblk + bid;
        if (u < 384) { r.type = 0; r.pm = u / 3; r.pn = u % 3; return true; }
        if (u < 656) { const int v = u - 384; r.type = 1; r.pm = v >> 1; r.pn = v & 1; return true; }
        if (u < 928) { const int v = u - 656; r.type = 2; r.pm = v & 1; r.pn = v >> 1; return true; }
        return false; }
    DEVI int K(const U&) const { return 256; }
    DEVI const char* abase(const U& u) const { const size_t o = u.type == 0 ? WS_ZQ : (u.type == 1 ? WS_ZKVR : WS_WUV); return (const char*)ws + o + (size_t)u.pm * 256 * 512; }
    DEVI unsigned arow_off(const U&, int r) const { return (unsigned)r * 512u; }
    DEVI const char* bbase(const U& u) const { const size_t o = u.type == 0 ? WS_WUQ : (u.type == 1 ? WS_WUK : WS_ZKVR); return (const char*)ws + o + (size_t)u.pn * 256 * 512; }
    typedef NoPre Pre;
    DEVI void pre(const U&, int, int, Pre&) const {}
    DEVI void epi4(const U& u, int r, int cb, f32x4 v00, f32x4 v01, f32x4 v10, f32x4 v11, const Pre&) const {
        const int wc = cb >> 5, f4 = cb & 31;
        const LAS float* gqn = cst; const LAS float* gkn = cst + 64; const LAS float* gqr = cst + 128; const LAS float* rope = cst + 160;
        bf16_t* Q = (bf16_t*)(ws + WS_A); bf16_t* Kb = (bf16_t*)(ws + WS_K); bf16_t* VT = (bf16_t*)(ws + WS_VT);
        if (u.type == 2) {
            const int dv = u.pm * 256 + r, head = dv >> 6, d = dv & 63;
            int b, key0; size_t m0;
            if (u.pn < 128) { b = u.pn >> 4; key0 = CTXL + (u.pn & 15) * 256; m0 = (size_t)u.pn * 256; } else { b = u.pn - 128; key0 = 0; m0 = (size_t)u.pn * 256; }
            const int cbp = (cb & ~12) | ((cb & 4) << 1) | ((cb & 8) >> 1);
            bf16_t* vo = VT + ((size_t)(b * 8 + head) * 64 + d) * NKEY + key0 + cbp; (void)m0;
            store4bf(vo, v00); store4bf(vo + 16, v01); store4bf(vo + 128, v10); store4bf(vo + 144, v11);
            return;
        }
        const size_t m = (size_t)u.pm * 256 + r;
        if (u.type == 1) {
            float ss = dot4(v00) + dot4(v01) + dot4(v10) + dot4(v11); ss += swz_xor<16>(ss); ss = xor32_sum(ss);
            const float sc = rsqrtf(ss * (1.f / 64.f) + EPS);
            int b, key; if (u.pm < 128) { b = u.pm >> 4; key = CTXL + (int)(m & 4095); } else { b = u.pm - 128; key = r; }
            bf16_t* ko = Kb + ((size_t)(b * 8 + u.pn * 4 + wc) * NKEY + key) * 96 + f4; const LAS float* gp = gkn + f4;
            store4bf(ko, v00 * sc * *(const LAS f32x4*)gp); store4bf(ko + 16, v01 * sc * *(const LAS f32x4*)(gp + 16));
            store4bf(ko + 32, v10 * sc * *(const LAS f32x4*)(gp + 32)); store4bf(ko + 48, v11 * sc * *(const LAS f32x4*)(gp + 48));
            return;
        }
        const int b = (int)(m >> 12), t = (int)(m & 4095);
        if (u.pn < 2) {
            float ss = dot4(v00) + dot4(v01) + dot4(v10) + dot4(v11); ss += swz_xor<16>(ss); ss = xor32_sum(ss);
            const float sc = rsqrtf(ss * (1.f / 64.f) + EPS) * QSCALE;
            bf16_t* qo = Q + ((size_t)(b * 8 + u.pn * 4 + wc) * SEQ + t) * 96 + f4; const LAS float* gp = gqn + f4;
            store4bf(qo, v00 * sc * *(const LAS f32x4*)gp); store4bf(qo + 16, v01 * sc * *(const LAS f32x4*)(gp + 16));
            store4bf(qo + 32, v10 * sc * *(const LAS f32x4*)(gp + 32)); store4bf(qo + 48, v11 * sc * *(const LAS f32x4*)(gp + 48));
        } else {
            const int pos = f4 < 8 ? (t >> 6) : (t & 63); const LAS float* rp = rope + (pos * 8 + (f4 & 7)) * 2;
            const f32x4 c0 = *(const LAS f32x4*)rp, c1 = *(const LAS f32x4*)(rp + 4);
            const f32x4 cs = {c0.x, c0.z, c1.x, c1.z}, sn = {c0.y, c0.w, c1.y, c1.w};
            const f32x4 g1 = *(const LAS f32x4*)(gqr + f4), g2 = *(const LAS f32x4*)(gqr + 16 + f4);
            float s0 = dot4(v00) + dot4(v01), s1 = dot4(v10) + dot4(v11);
            s0 += swz_xor<16>(s0); s0 = xor32_sum(s0); s1 += swz_xor<16>(s1); s1 = xor32_sum(s1);
            const float sc0 = rsqrtf(s0 * (1.f / 32.f) + EPS) * QSCALE, sc1 = rsqrtf(s1 * (1.f / 32.f) + EPS) * QSCALE;
            { const f32x4 y1 = v00 * sc0 * g1, y2 = v01 * sc0 * g2; bf16_t* qo = Q + ((size_t)(b * 8 + wc) * SEQ + t) * 96 + 64 + f4;
              store4bf(qo, y1 * cs - y2 * sn); store4bf(qo + 16, y1 * sn + y2 * cs); }
            { const f32x4 y1 = v10 * sc1 * g1, y2 = v11 * sc1 * g2; bf16_t* qo = Q + ((size_t)(b * 8 + 4 + wc) * SEQ + t) * 96 + 64 + f4;
              store4bf(qo, y1 * cs - y2 * sn); store4bf(qo + 16, y1 * sn + y2 * cs); }
        }
    }
};


constexpr int RNN_XB = 32 * 272;
constexpr int RNN_HOFF = 4 * RNN_XB + 2048;
DEVI void phase_rnn_carry(const P& p, int bid, int nblk) {
    float* S = (float*)(p.ws + WS_RNNSUM);
    for (int id = bid * NTHR + tid_(); id < NB * 2 * 1024; id += nblk * NTHR) {
        const int ch = id & 1023, dir = (id >> 10) & 1, b = id >> 11;
        float* sp = S + ((size_t)(b * 2 + dir) * 34) * 2048 + ch;
        float A[34], B[34];
#pragma unroll
        for (int c = 0; c < 34; ++c) { A[c] = sp[c * 2048]; B[c] = sp[c * 2048 + 1024]; }
        float h = 0.f;
        if (dir == 0) {
#pragma unroll
            for (int k = 0; k < 34; ++k) { sp[k * 2048 + 1024] = h; h = fmaf(A[k], h, B[k]); }
        } else {
#pragma unroll
            for (int k = 0; k < 34; ++k) { const int c = k < 2 ? 1 - k : 35 - k; sp[c * 2048 + 1024] = h; h = fmaf(A[c], h, B[c]); }
        }
    }
}

DEVI void convert_tail(const P& p, int qidx, int e0, int e1, LAS unsigned char* lds) {
    const int tid = tid_(), lane = tid & 63, wave = tid >> 6;
    unsigned* cq = (unsigned*)(p.ws + WS_CTL) + 8192 + qidx * 64;
    volatile LAS unsigned* qs = (volatile LAS unsigned*)(lds + MISC_OFF) + 24;
    float* scr = (float*)(unsigned char*)lds + wave * (64 * 33);
    const int ne = e1 - e0, nbi = 2 * ne * 512 / 8;
    for (;;) {
        __syncthreads();
        if (tid == 0) qs[0] = __hip_atomic_fetch_add(cq, 1u, __ATOMIC_RELAXED, __HIP_MEMORY_SCOPE_AGENT);
        __syncthreads();
        const int bi = (int)qs[0];
        if (bi >= nbi) break;
        const int it = bi * 8 + wave, which = it / (ne * 512), r = it % (ne * 512), e = e0 + r / 512, t = r % 512, k0 = 64 * (t / 32), n0 = 32 * (t % 32);
        if (which == 0) transpose_item8(p.w_e_gate + (size_t)e * 1048576, 1024, 1024, p.ws + wgu_off(e), RmGU{0}, scr, k0, n0, lane);
        else transpose_item8(p.w_e_up + (size_t)e * 1048576, 1024, 1024, p.ws + wgu_off(e), RmGU{1}, scr, k0, n0, lane);
    }
    __syncthreads();
}

template <bool APPLY>
DEVI void phase_rnn(const P& p, int bid, int nblk, LAS unsigned char* lds) {
    const int tid = tid_(), wid = __builtin_amdgcn_readfirstlane(tid >> 6), lane = tid & 63, r = lane & 31, hh = lane >> 5;
    const int dir = wid >> 2, cg = wid & 3;
    const int n = bid & 7, bl = bid >> 3, nbl = (nblk - n + 7) >> 3;
    const bf16_t* z = (const bf16_t*)(p.ws + WS_ZRNN); float* S = (float*)(p.ws + WS_RNNSUM); bf16_t* gl = (bf16_t*)(p.ws + WS_GELU);
    const int ch = n * 128 + cg * 32 + r;
    bf16x8 wfa[8], wfx[8];
    { const bf16_t* wa = (const bf16_t*)(p.ws + WS_WRG) + ((size_t)((0 * 2 + dir) * 8 + n) * 128 + cg * 32 + r) * 128 + hh * 8;
      const bf16_t* wx = (const bf16_t*)(p.ws + WS_WRG) + ((size_t)((1 * 2 + dir) * 8 + n) * 128 + cg * 32 + r) * 128 + hh * 8;
#pragma unroll
      for (int ks = 0; ks < 8; ++ks) { wfa[ks] = *(const bf16x8*)(wa + ks * 16); wfx[ks] = *(const bf16x8*)(wx + ks * 16); } }
    const float eba = __builtin_amdgcn_exp2f(-1.4426950408889634f * p.rg_ba[dir * 1024 + ch]), ebx = __builtin_amdgcn_exp2f(-1.4426950408889634f * p.rg_bx[dir * 1024 + ch]), sp2 = ((const float*)(p.ws + WS_SP))[dir * 1024 + ch] * 1.4426950408889634f;
    const int t8 = tid & 255, c4 = t8 & 31, rgp = t8 >> 5, cch = n * 128 + c4 * 4;
    const f32x4 cw0 = *(const f32x4*)(p.conv_w + cch), cw1 = *(const f32x4*)(p.conv_w + 1024 + cch), cw2 = *(const f32x4*)(p.conv_w + 2048 + cch), cw3 = *(const f32x4*)(p.conv_w + 3072 + cch);
    const f32x4 cb = *(const f32x4*)(p.conv_b + cch);
    const int nitems = APPLY ? NB * 32 : NB * 34;
#define RNN_COORDS(li_, b_, c_, pos0_, len_, m0_) do { if (APPLY) { b_ = (li_) >> 5; c_ = 2 + ((li_) & 31); } else { b_ = (li_) / 34; c_ = (li_) % 34; } \
        if (c_ < 2) { pos0_ = c_ * 128; len_ = CTXL; m0_ = (size_t)NLAT + b_ * CTXL + pos0_; } else { pos0_ = (c_ - 2) * 128; len_ = SEQ; m0_ = (size_t)b_ * SEQ + pos0_; } } while (0)
#define RNN_LOADZ(pos0_, len_, m0_, st_) do { const int row0_ = (st_) * 32 + rgp * 4; _Pragma("unroll") for (int i = 0; i < 7; ++i) { const int pos_ = pos0_ + row0_ - 2 + i; zp[i] = (u32x2){0u, 0u}; \
        if (pos_ >= 0 && pos_ < len_) zp[i] = *(const u32x2*)(z + (m0_ + row0_ + i - 2) * 1024 + cch); } } while (0)
    u32x2 zp[7]; float hnext = 0.f;
    (void)bl; (void)nbl;
    unsigned* qhead = (unsigned*)(p.ws + WS_CTL) + 8192 + ((APPLY ? 8 : 0) + n) * 64;
    volatile LAS unsigned* qs = (volatile LAS unsigned*)(lds + MISC_OFF) + 24;
    if (tid == 0) { qs[0] = __hip_atomic_fetch_add(qhead, 1u, __ATOMIC_RELAXED, __HIP_MEMORY_SCOPE_AGENT); qs[1] = __hip_atomic_fetch_add(qhead, 1u, __ATOMIC_RELAXED, __HIP_MEMORY_SCOPE_AGENT); }
    __syncthreads();
    int li = (int)qs[0], lin = (int)qs[1], par = 0;
    if (li < nitems) { int b, c, pos0, len; size_t m0; RNN_COORDS(li, b, c, pos0, len, m0); RNN_LOADZ(pos0, len, m0, (dir ? 3 : 0));
        if (APPLY) hnext = S[((size_t)((b * 2 + dir) * 34 + c)) * 2048 + ch + 1024]; }
    for (; li < nitems; ) {
        unsigned drawn = 0u; if (tid == 0) drawn = __hip_atomic_fetch_add(qhead, 1u, __ATOMIC_RELAXED, __HIP_MEMORY_SCOPE_AGENT);
        int b, c, pos0, len; size_t m0; RNN_COORDS(li, b, c, pos0, len, m0);
        float* sp = S + ((size_t)((b * 2 + dir) * 34 + c)) * 2048 + ch;
        float h = APPLY ? hnext : 0.f, Ap = 1.f;
        for (int s = 0; s < 4; ++s) {
            const int st = dir ? 3 - s : s;
            LAS unsigned char* xb = lds + (dir * 2 + (s & 1)) * RNN_XB;
            {
                f32x4 zr[7];
#pragma unroll
                for (int i = 0; i < 7; ++i) zr[i] = (f32x4){bflo(zp[i].x), bfhi(zp[i].x), bflo(zp[i].y), bfhi(zp[i].y)};
#pragma unroll
                for (int o = 0; o < 4; ++o) { const f32x4 v = cb + cw0 * zr[o] + cw1 * zr[o + 1] + cw2 * zr[o + 2] + cw3 * zr[o + 3];
                    u32x2 w; w.x = pk2(v.x, v.y); w.y = pk2(v.z, v.w); *(LAS u32x2*)(xb + (rgp * 4 + o) * 272 + c4 * 8) = w; }
                if (s < 3) { RNN_LOADZ(pos0, len, m0, (dir ? 2 - s : s + 1)); }
                else if (lin < nitems) { int nb_, nc_, npos0, nlen; size_t nm0; RNN_COORDS(lin, nb_, nc_, npos0, nlen, nm0); RNN_LOADZ(npos0, nlen, nm0, (dir ? 3 : 0));
                    if (APPLY) hnext = S[((size_t)((nb_ * 2 + dir) * 34 + nc_)) * 2048 + ch + 1024]; }
            }
            if (s == 1 && tid == 0) qs[2 + par] = drawn;
            __syncthreads();
            f32x16 ar, ai;
            {   const f32x16 z16 = {0.f, 0.f, 0.f, 0.f, 0.f, 0.f, 0.f, 0.f, 0.f, 0.f, 0.f, 0.f, 0.f, 0.f, 0.f, 0.f};
                const bf16x8 af0 = *(const LAS bf16x8*)(xb + r * 272 + hh * 16);
                ar = __builtin_amdgcn_mfma_f32_32x32x16_bf16(af0, wfa[0], z16, 0, 0, 0);
                ai = __builtin_amdgcn_mfma_f32_32x32x16_bf16(af0, wfx[0], z16, 0, 0, 0); }
#pragma unroll
            for (int ks = 1; ks < 8; ++ks) {
                const bf16x8 af = *(const LAS bf16x8*)(xb + r * 272 + ks * 32 + hh * 16);
                ar = __builtin_amdgcn_mfma_f32_32x32x16_bf16(af, wfa[ks], ar, 0, 0, 0);
                ai = __builtin_amdgcn_mfma_f32_32x32x16_bf16(af, wfx[ks], ai, 0, 0, 0);
            }
            float a_[16], b_[16];
#pragma unroll
            for (int i = 0; i < 16; ++i) {
                const int row = (i & 3) + 8 * (i >> 2) + 4 * hh;
                const float xv = bf2f(*(const LAS bf16_t*)(xb + row * 272 + (cg * 32 + r) * 2));
                const float rr = __builtin_amdgcn_rcpf(fmaf(__builtin_amdgcn_exp2f(ar[i]), eba, 1.f)), ig = __builtin_amdgcn_rcpf(fmaf(__builtin_amdgcn_exp2f(ai[i]), ebx, 1.f));
                const float a = __builtin_amdgcn_exp2f(-sp2 * rr);
                a_[i] = a; b_[i] = __builtin_amdgcn_sqrtf(fmaxf(fmaf(-a, a, 1.f), 0.f)) * (ig * xv);
            }
            float gA[4], gB[4], fA[4], fB[4], sA[4], sB[4];
#pragma unroll
            for (int q = 0; q < 4; ++q) {
                if (dir == 0) { float hb = b_[4 * q]; hb = fmaf(a_[4 * q + 1], hb, b_[4 * q + 1]); hb = fmaf(a_[4 * q + 2], hb, b_[4 * q + 2]); hb = fmaf(a_[4 * q + 3], hb, b_[4 * q + 3]); gB[q] = hb; }
                else { float hb = b_[4 * q + 3]; hb = fmaf(a_[4 * q + 2], hb, b_[4 * q + 2]); hb = fmaf(a_[4 * q + 1], hb, b_[4 * q + 1]); hb = fmaf(a_[4 * q], hb, b_[4 * q]); gB[q] = hb; }
                gA[q] = (a_[4 * q] * a_[4 * q + 1]) * (a_[4 * q + 2] * a_[4 * q + 3]);
                const u32x2v ra = __builtin_amdgcn_permlane32_swap(__float_as_uint(gA[q]), __float_as_uint(gA[q]), false, false), rb = __builtin_amdgcn_permlane32_swap(__float_as_uint(gB[q]), __float_as_uint(gB[q]), false, false);
                fA[q] = __uint_as_float(ra[0]); sA[q] = __uint_as_float(ra[1]); fB[q] = __uint_as_float(rb[0]); sB[q] = __uint_as_float(rb[1]);
            }
            float hin[4];
#define RNN_STEP(q) do { if (dir == 0) { const float t1 = fmaf(fA[q], h, fB[q]), t2 = fmaf(sA[q], t1, sB[q]); hin[q] = hh ? t1 : h; h = t2; } \
                else { const float t1 = fmaf(sA[q], h, sB[q]), t2 = fmaf(fA[q], t1, fB[q]); hin[q] = hh ? h : t1; h = t2; } \
                if (!APPLY) Ap *= fA[q] * sA[q]; } while (0)
            if (dir == 0) { RNN_STEP(0); RNN_STEP(1); RNN_STEP(2); RNN_STEP(3); } else { RNN_STEP(3); RNN_STEP(2); RNN_STEP(1); RNN_STEP(0); }
#undef RNN_STEP
            if (APPLY) {
                LAS bf16_t* ht = (LAS bf16_t*)(lds + RNN_HOFF + dir * 32768) + (st * 32 + 4 * hh) * 128 + cg * 32 + r;
#pragma unroll
                for (int q = 0; q < 4; ++q) {
                    float hv = hin[q];
                    if (dir == 0) {
#pragma unroll
                        for (int e = 0; e < 4; ++e) { hv = fmaf(a_[4 * q + e], hv, b_[4 * q + e]); ht[(8 * q + e) * 128] = (bf16_t)(pk2(hv, 0.f) & 0xffffu); }
                    } else {
#pragma unroll
                        for (int e = 3; e >= 0; --e) { hv = fmaf(a_[4 * q + e], hv, b_[4 * q + e]); ht[(8 * q + e) * 128] = (bf16_t)(pk2(hv, 0.f) & 0xffffu); }
                    }
                }
            }
        }
        if (APPLY) {
            __syncthreads();
            const int row = tid >> 2, cs = (tid & 3) * 32;
            const LAS unsigned char* hf = lds + RNN_HOFF + row * 256 + cs * 2; const LAS unsigned char* hb = hf + 32768;
            bf16_t* gp = gl + (m0 + row) * 1024 + n * 128 + cs;
#pragma unroll
            for (int j = 0; j < 4; ++j) {
                const u32x4 f = *(const LAS u32x4*)(hf + j * 16), bk = *(const LAS u32x4*)(hb + j * 16), g = *(const u32x4*)(gp + j * 8);
                u32x4 o;
                o.x = pk2((bflo(f.x) + bflo(bk.x)) * bflo(g.x), (bfhi(f.x) + bfhi(bk.x)) * bfhi(g.x));
                o.y = pk2((bflo(f.y) + bflo(bk.y)) * bflo(g.y), (bfhi(f.y) + bfhi(bk.y)) * bfhi(g.y));
                o.z = pk2((bflo(f.z) + bflo(bk.z)) * bflo(g.z), (bfhi(f.z) + bfhi(bk.z)) * bfhi(g.z));
                o.w = pk2((bflo(f.w) + bflo(bk.w)) * bflo(g.w), (bfhi(f.w) + bfhi(bk.w)) * bfhi(g.w));
                *(u32x4*)(gp + j * 8) = o;
            }
        } else if (hh == 0) { sp[0] = Ap; sp[1024] = h; }
        li = lin; lin = (int)qs[2 + par]; par ^= 1;
    }
#undef RNN_COORDS
#undef RNN_LOADZ
    __syncthreads();
    if (nblk == 256) convert_tail(p, 16 + (APPLY ? 1 : 0), APPLY ? 10 : 6, APPLY ? 14 : 10, lds);
}

DEVI void phase_mla_pre(const P& p, int bid, int nblk) {
    const int tid = tid_(), lane = tid & 63, wave = tid >> 6;
    const bf16_t* zq = (const bf16_t*)(p.ws + WS_ZQ); const bf16_t* zkvr = (const bf16_t*)(p.ws + WS_ZKVR);
    bf16_t* Kb = (bf16_t*)(p.ws + WS_K);
    const float* rope = (const float*)(p.ws + WS_ROPE);
    const int NGW = nblk * 8, per = (NROW + NGW - 1) / NGW, m0 = (bid * 8 + wave) * per, m1 = (m0 + per < NROW) ? m0 + per : NROW;
    if (m0 >= m1) return;
    const float gk1 = lane < 16 ? p.g_k_rope[lane] : 0.f, gk2 = lane < 16 ? p.g_k_rope[16 + lane] : 0.f;
    u32x2 qn = {0u, 0u}, kn = {0u, 0u}; unsigned en = 0u;
#define MP_LOAD(m_) do { if ((m_) < NLAT) qn = gld8(zq + (size_t)(m_) * 256 + 4 * lane); if (lane < 32) { kn = gld8(zkvr + (size_t)(m_) * 256 + 4 * lane); en = *(const GAS unsigned short*)(zkvr + (size_t)(m_) * 256 + 128 + lane); } } while (0)
    MP_LOAD(m0);
    for (int m = m0; m < m1; ++m) {
        const u32x2 qc = qn, kc = kn; const float e = lane < 32 ? __uint_as_float(en << 16) : 0.f;
        if (m + 1 < m1) MP_LOAD(m + 1);
        if (m < NLAT) { const f32x4 v = {bflo(qc.x), bfhi(qc.x), bflo(qc.y), bfhi(qc.y)}; const float s = wave_sum(v.x * v.x + v.y * v.y + v.z * v.z + v.w * v.w);
            store4bf((bf16_t*)zq + (size_t)m * 256 + 4 * lane, v * rsqrtf(s * (1.f / 256.f) + EPS)); }
        const f32x4 kv4 = {bflo(kc.x), bfhi(kc.x), bflo(kc.y), bfhi(kc.y)};
        float s1 = 0.f; if (lane < 32) s1 = kv4.x * kv4.x + kv4.y * kv4.y + kv4.z * kv4.z + kv4.w * kv4.w;
        s1 = wave_sum(s1); if (lane < 32) store4bf((bf16_t*)zkvr + (size_t)m * 256 + 4 * lane, kv4 * rsqrtf(s1 * (1.f / 128.f) + EPS));
        const float rkr = rsqrtf(wave_sum(e * e) * (1.f / 32.f) + EPS);
        const float e2 = swz_xor<16>(e);
        if (lane < 16) {
            const float y1 = e * rkr * gk1, y2 = e2 * rkr * gk2;
            float cs = 1.f, sn = 0.f; int b, key;
            if (m < NLAT) { const int t = m & 4095; b = m >> 12; key = CTXL + t; const int pos = lane < 8 ? (t >> 6) : (t & 63); cs = rope[(pos * 8 + (lane & 7)) * 2]; sn = rope[(pos * 8 + (lane & 7)) * 2 + 1]; }
            else { b = (m - NLAT) >> 8; key = (m - NLAT) & 255; }
            const bf16_t o1 = (bf16_t)(pk2(y1 * cs - y2 * sn, 0.f) & 0xffffu), o2 = (bf16_t)(pk2(y1 * sn + y2 * cs, 0.f) & 0xffffu);
#pragma unroll
            for (int h = 0; h < 8; ++h) { bf16_t* kp = Kb + ((size_t)(b * 8 + h) * NKEY + key) * 96 + 64; kp[lane] = o1; kp[16 + lane] = o2; }
        }
    }
#undef MP_LOAD
}

template <bool SHIFT>
DEVI void attn_body(const P& p, int bid, int nblk, LAS unsigned char* lds, const float nshift) {
    const int tid = tid_(), wid = __builtin_amdgcn_readfirstlane(tid >> 6), lane = tid & 63, r = lane & 31, hh = lane >> 5;
    const bf16_t* Q = (const bf16_t*)(p.ws + WS_A); const bf16_t* Kb = (const bf16_t*)(p.ws + WS_K); const bf16_t* VT = (const bf16_t*)(p.ws + WS_VT);
    bf16_t* O = (bf16_t*)(p.ws + WS_ATTN);
    const int vcu = (nblk & 7) == 0 ? (bid & 7) * (nblk >> 3) + (bid >> 3) : bid;
    constexpr int KROW = 208, KBUF = 64 * KROW, VROW = 144, VBUF = 64 * VROW, BUFSZ = KBUF + VBUF, NT = NKEY / 64;
    unsigned ofs0, ofs1, ofs2;
    { const int q = wid * 64 + lane, c = q % 13; ofs0 = (unsigned)((q / 13) * 192 + (c < 12 ? c : 11) * 16); }
    if (wid < 5) { const int q = (wid + 8) * 64 + lane, c = q % 13; ofs1 = (unsigned)((q / 13) * 192 + (c < 12 ? c : 11) * 16); }
    else { const int q = (wid - 5) * 64 + lane, c = q % 9; ofs1 = (unsigned)((q / 9) * (NKEY * 2) + (c < 8 ? c : 7) * 16); }
    { const int q = (wid + 3) * 64 + lane, c = q % 9; ofs2 = (unsigned)((q / 9) * (NKEY * 2) + (c < 8 ? c : 7) * 16); }
    const unsigned d0 = (unsigned)wid * 1024u, d1 = wid < 5 ? (unsigned)(wid + 8) * 1024u : (unsigned)(KBUF + (wid - 5) * 1024), d2 = (unsigned)(KBUF + (wid + 3) * 1024);
#define AT_GLDS(src, dstoff) __builtin_amdgcn_global_load_lds((const unsigned*)(src), (LAS unsigned*)(lds + (dstoff)), 16, 0, 0)
#define AT_DMA(kg_, vg_, j_, boff_) do { const char* kt_ = uptr((kg_) + (size_t)(j_) * (64 * 192)); const char* vt_ = uptr((vg_) + (size_t)(j_) * 128); \
        AT_GLDS(kt_ + ofs0, (boff_) + d0); AT_GLDS((wid < 5 ? kt_ : vt_) + ofs1, (boff_) + d1); if (wid < 6) AT_GLDS(vt_ + ofs2, (boff_) + d2); } while (0)
#define AT_LDK(boff_, sub_) do { _Pragma("unroll") for (int ks = 0; ks < 6; ++ks) kf[ks] = *(const LAS bf16x8*)(lds + (boff_) + ((sub_) * 32 + r) * KROW + ks * 32 + hh * 16); } while (0)
#define SH_(x_) (SHIFT ? (x_) + nshift : (x_))
#define AT_EXP8(S_, LV_, PV_, o_, ONE_) do { const float e0 = __builtin_amdgcn_exp2f(SH_(S_[o_])), e1 = __builtin_amdgcn_exp2f(SH_(S_[o_ + 1])), e2 = __builtin_amdgcn_exp2f(SH_(S_[o_ + 2])), e3 = __builtin_amdgcn_exp2f(SH_(S_[o_ + 3])), \
        e4 = __builtin_amdgcn_exp2f(SH_(S_[o_ + 4])), e5 = __builtin_amdgcn_exp2f(SH_(S_[o_ + 5])), e6 = __builtin_amdgcn_exp2f(SH_(S_[o_ + 6])), e7 = __builtin_amdgcn_exp2f(SH_(S_[o_ + 7])); \
        LV_ = __builtin_fmaf(e7, ONE_, __builtin_fmaf(e6, ONE_, __builtin_fmaf(e5, ONE_, __builtin_fmaf(e4, ONE_, __builtin_fmaf(e3, ONE_, __builtin_fmaf(e2, ONE_, __builtin_fmaf(e1, ONE_, __builtin_fmaf(e0, ONE_, LV_)))))))); \
        PV_.x = pk2(e0, e1); PV_.y = pk2(e2, e3); PV_.z = pk2(e4, e5); PV_.w = pk2(e6, e7); } while (0)
#define AT_STEP(CA_, CB_, NA_, NB_, PP_, PC_, VPREV_, KNEXT_) do { \
        const LAS unsigned char* vp_ = (VPREV_); \
        const bf16x8 va0 = *(const LAS bf16x8*)(vp_), va1 = *(const LAS bf16x8*)(vp_ + 32), vb0 = *(const LAS bf16x8*)(vp_ + 32 * VROW), vb1 = *(const LAS bf16x8*)(vp_ + 32 * VROW + 32); \
        NA_ = __builtin_amdgcn_mfma_f32_32x32x16_bf16(kf[0], qf[0][0], zinit, 0, 0, 0); NB_ = __builtin_amdgcn_mfma_f32_32x32x16_bf16(kf[0], qf[1][0], zinit, 0, 0, 0); \
        NA_ = __builtin_amdgcn_mfma_f32_32x32x16_bf16(kf[1], qf[0][1], NA_, 0, 0, 0); NB_ = __builtin_amdgcn_mfma_f32_32x32x16_bf16(kf[1], qf[1][1], NB_, 0, 0, 0); \
        NA_ = __builtin_amdgcn_mfma_f32_32x32x16_bf16(kf[2], qf[0][2], NA_, 0, 0, 0); NB_ = __builtin_amdgcn_mfma_f32_32x32x16_bf16(kf[2], qf[1][2], NB_, 0, 0, 0); \
        NA_ = __builtin_amdgcn_mfma_f32_32x32x16_bf16(kf[3], qf[0][3], NA_, 0, 0, 0); NB_ = __builtin_amdgcn_mfma_f32_32x32x16_bf16(kf[3], qf[1][3], NB_, 0, 0, 0); \
        NA_ = __builtin_amdgcn_mfma_f32_32x32x16_bf16(kf[4], qf[0][4], NA_, 0, 0, 0); NB_ = __builtin_amdgcn_mfma_f32_32x32x16_bf16(kf[4], qf[1][4], NB_, 0, 0, 0); \
        NA_ = __builtin_amdgcn_mfma_f32_32x32x16_bf16(kf[5], qf[0][5], NA_, 0, 0, 0); NB_ = __builtin_amdgcn_mfma_f32_32x32x16_bf16(kf[5], qf[1][5], NB_, 0, 0, 0); \
        { const LAS unsigned char* kn_ = (KNEXT_); _Pragma("unroll") for (int ks = 0; ks < 6; ++ks) kf[ks] = *(const LAS bf16x8*)(kn_ + ks * 32); }     \
        { const bf16x8 pfa0 = __builtin_bit_cast(bf16x8, PP_[0]), pfa1 = __builtin_bit_cast(bf16x8, PP_[1]), pfb0 = __builtin_bit_cast(bf16x8, PP_[2]), pfb1 = __builtin_bit_cast(bf16x8, PP_[3]); \
        o[0][0] = __builtin_amdgcn_mfma_f32_32x32x16_bf16(va0, pfa0, o[0][0], 0, 0, 0); \
        o[1][0] = __builtin_amdgcn_mfma_f32_32x32x16_bf16(va0, pfb0, o[1][0], 0, 0, 0); \
        o[0][0] = __builtin_amdgcn_mfma_f32_32x32x16_bf16(va1, pfa1, o[0][0], 0, 0, 0); \
        o[1][0] = __builtin_amdgcn_mfma_f32_32x32x16_bf16(va1, pfb1, o[1][0], 0, 0, 0); \
        o[0][1] = __builtin_amdgcn_mfma_f32_32x32x16_bf16(vb0, pfa0, o[0][1], 0, 0, 0); \
        o[1][1] = __builtin_amdgcn_mfma_f32_32x32x16_bf16(vb0, pfb0, o[1][1], 0, 0, 0); \
        o[0][1] = __builtin_amdgcn_mfma_f32_32x32x16_bf16(vb1, pfa1, o[0][1], 0, 0, 0); \
        o[1][1] = __builtin_amdgcn_mfma_f32_32x32x16_bf16(vb1, pfb1, o[1][1], 0, 0, 0); } \
        AT_EXP8(CA_, l0v, PC_[0], 0, 1.0f); AT_EXP8(CA_, l0v, PC_[1], 8, 1.0f); AT_EXP8(CB_, l1v, PC_[2], 0, one_); AT_EXP8(CB_, l1v, PC_[3], 8, one_); \
        _Pragma("unroll") for (int g_ = 0; g_ < 4; ++g_) {   \
            __builtin_amdgcn_sched_group_barrier(0x008, 1, 0); __builtin_amdgcn_sched_group_barrier(0x400, 2, 0); __builtin_amdgcn_sched_group_barrier(0x002, 2, 0); \
            __builtin_amdgcn_sched_group_barrier(0x008, 1, 0); __builtin_amdgcn_sched_group_barrier(0x400, 1, 0); __builtin_amdgcn_sched_group_barrier(0x002, 3, 0); \
            __builtin_amdgcn_sched_group_barrier(0x008, 1, 0); __builtin_amdgcn_sched_group_barrier(0x400, 2, 0); __builtin_amdgcn_sched_group_barrier(0x002, 2, 0); \
            __builtin_amdgcn_sched_group_barrier(0x008, 1, 0); __builtin_amdgcn_sched_group_barrier(0x400, 1, 0); __builtin_amdgcn_sched_group_barrier(0x002, 3, 0); \
            __builtin_amdgcn_sched_group_barrier(0x008, 1, 0); __builtin_amdgcn_sched_group_barrier(0x400, 2, 0); __builtin_amdgcn_sched_group_barrier(0x002, 2, 0); } \
        asm volatile("" : "+v"(PC_[0]), "+v"(PC_[1]), "+v"(PC_[2]), "+v"(PC_[3]), "+v"(l0v), "+v"(l1v));   \
        __builtin_amdgcn_sched_barrier(0); \
    } while (0)
    f32x16 zinit;
#pragma unroll
    for (int i = 0; i < 16; ++i) zinit[i] = 0.f;
    float one_ = 1.0f; asm volatile("" : "+v"(one_));
    unsigned prv = 3u * BUFSZ, cur = 0u, nxt = (unsigned)BUFSZ, nn = 2u * BUFSZ;
    bool primed = false;
    for (int u = vcu; u < NB * 8 * 8; u += nblk) {
        const int bh = u >> 3, qb = u & 7;
        const bool more = u + nblk < NB * 8 * 8; const int bhn = more ? (u + nblk) >> 3 : bh;
        bf16x8 qf[2][6];
#pragma unroll
        for (int qs = 0; qs < 2; ++qs) { const bf16_t* qp = uptr(Q + ((size_t)bh * SEQ + qb * 512 + wid * 64 + qs * 32) * 96) + (unsigned)(r * 96 + hh * 8);
#pragma unroll
          for (int ks = 0; ks < 6; ++ks) { const u32x4 t = gld16(qp + ks * 16); qf[qs][ks] = __builtin_bit_cast(bf16x8, t); } }
        f32x16 o[2][2];
#pragma unroll
        for (int qs = 0; qs < 2; ++qs)
#pragma unroll
            for (int d = 0; d < 2; ++d)
#pragma unroll
                for (int i = 0; i < 16; ++i) o[qs][d][i] = 0.f;
        float l0v = 0.f, l1v = 0.f;
        const char* kg = uptr((const char*)(Kb + (size_t)bh * NKEY * 96)); const char* vg = uptr((const char*)(VT + (size_t)bh * 64 * NKEY));
        const char* kgn = uptr((const char*)(Kb + (size_t)bhn * NKEY * 96)); const char* vgn = uptr((const char*)(VT + (size_t)bhn * 64 * NKEY));
        if (!primed) {
            __syncthreads();
            AT_DMA(kg, vg, 0, cur); AT_DMA(kg, vg, 1, nxt);
            asm volatile("s_waitcnt vmcnt(0)" ::: "memory");
            __syncthreads();
        }
        bf16x8 kf[6];
        f32x16 sa = zinit, sb = zinit, ta, tb;
        AT_LDK(cur, 0);
#pragma unroll
        for (int ks = 0; ks < 6; ++ks) { sa = __builtin_amdgcn_mfma_f32_32x32x16_bf16(kf[ks], qf[0][ks], sa, 0, 0, 0); sb = __builtin_amdgcn_mfma_f32_32x32x16_bf16(kf[ks], qf[1][ks], sb, 0, 0, 0); }
        AT_LDK(cur, 1);
        u32x4 p0[4], p1[4];
#pragma unroll
        for (int i = 0; i < 4; ++i) p1[i] = (u32x4){0u, 0u, 0u, 0u};
        const unsigned vlane = (unsigned)(KBUF + r * VROW + hh * 16), klane = (unsigned)(r * KROW + hh * 16);
#pragma unroll 1
        for (int j = 0; j < NT; ++j) {
            asm volatile("s_waitcnt vmcnt(0)" ::: "memory"); __syncthreads();
            if (j + 2 < NT) AT_DMA(kg, vg, j + 2, nn); else if (more) AT_DMA(kgn, vgn, j + 2 - NT, nn);
            AT_STEP(sa, sb, ta, tb, p1, p0, lds + (j == 0 ? cur : prv + 64u) + vlane, lds + nxt + klane);
            AT_STEP(ta, tb, sa, sb, p0, p1, lds + cur + vlane, lds + nxt + 32 * KROW + klane);
            const unsigned t_ = prv; prv = cur; cur = nxt; nxt = nn; nn = t_;
        }
        {
            const LAS unsigned char* vp_ = lds + prv + 64u + vlane;
            const bf16x8 va0 = *(const LAS bf16x8*)(vp_), va1 = *(const LAS bf16x8*)(vp_ + 32), vb0 = *(const LAS bf16x8*)(vp_ + 32 * VROW), vb1 = *(const LAS bf16x8*)(vp_ + 32 * VROW + 32);
            const bf16x8 pfa0 = __builtin_bit_cast(bf16x8, p1[0]), pfa1 = __builtin_bit_cast(bf16x8, p1[1]), pfb0 = __builtin_bit_cast(bf16x8, p1[2]), pfb1 = __builtin_bit_cast(bf16x8, p1[3]);
            o[0][0] = __builtin_amdgcn_mfma_f32_32x32x16_bf16(va0, pfa0, o[0][0], 0, 0, 0);
            o[1][0] = __builtin_amdgcn_mfma_f32_32x32x16_bf16(va0, pfb0, o[1][0], 0, 0, 0);
            o[0][0] = __builtin_amdgcn_mfma_f32_32x32x16_bf16(va1, pfa1, o[0][0], 0, 0, 0);
            o[1][0] = __builtin_amdgcn_mfma_f32_32x32x16_bf16(va1, pfb1, o[1][0], 0, 0, 0);
            o[0][1] = __builtin_amdgcn_mfma_f32_32x32x16_bf16(vb0, pfa0, o[0][1], 0, 0, 0);
            o[1][1] = __builtin_amdgcn_mfma_f32_32x32x16_bf16(vb0, pfb0, o[1][1], 0, 0, 0);
            o[0][1] = __builtin_amdgcn_mfma_f32_32x32x16_bf16(vb1, pfa1, o[0][1], 0, 0, 0);
            o[1][1] = __builtin_amdgcn_mfma_f32_32x32x16_bf16(vb1, pfb1, o[1][1], 0, 0, 0);
        }
        primed = more;
        const float l0 = l0v, l1 = l1v;
        const int b = bh >> 3, h = bh & 7;
#pragma unroll
        for (int qs = 0; qs < 2; ++qs) {
            const float inv = 1.f / xor32_sum(qs ? l1 : l0);
            bf16_t* op = uptr(O + ((size_t)(b * SEQ + qb * 512 + wid * 64 + qs * 32)) * 512 + h * 64) + (unsigned)(r * 512 + 4 * hh);
#pragma unroll
            for (int g = 0; g < 4; ++g) {
                store4bf(op + 8 * g, (f32x4){o[qs][0][4 * g], o[qs][0][4 * g + 1], o[qs][0][4 * g + 2], o[qs][0][4 * g + 3]} * inv);
                store4bf(op + 32 + 8 * g, (f32x4){o[qs][1][4 * g], o[qs][1][4 * g + 1], o[qs][1][4 * g + 2], o[qs][1][4 * g + 3]} * inv);
            }
        }
    }
#undef AT_STEP
#undef AT_EXP8
#undef SH_
#undef AT_LDK
#undef AT_DMA
#undef AT_GLDS
}

DEVI void phase_attn(const P& p, int bid, int nblk, LAS unsigned char* lds) {
    const float smax = ((const float*)(p.ws + WS_SMAX))[0];
    if (smax <= 64.f) attn_body<false>(p, bid, nblk, lds, 0.f); else attn_body<true>(p, bid, nblk, lds, -smax);
}

DEVI void phase_norm2_router(const P& p, int bid, int nblk, unsigned char* lds) {
    const int tid = tid_(), lane = tid & 63, wave = __builtin_amdgcn_readfirstlane(tid >> 6);
    float* wrT = (float*)lds;
    float* gsS = wrT + 16384;
    for (int i = tid; i < 16384; i += NTHR) { const int k = i >> 4, e = i & 15; wrT[e * 1024 + k] = p.w_router[i]; }
    const float* mod = (const float*)(p.ws + WS_MOD); bf16_t* hb = (bf16_t*)(p.ws + WS_A); float* aff = (float*)(p.ws + WS_AFF);
    for (int i = tid; i < NB * 1024; i += NTHR) { const int bb = i >> 10, k = i & 1023; gsS[i] = p.g_norm2[k] * (mod[bb * 6144 + 4096 + k] + 1.f); gsS[NB * 1024 + i] = mod[bb * 6144 + 3072 + k]; }
    __syncthreads();
    const int NGW = nblk * 8, per = (NLAT + NGW - 1) / NGW, m0 = (bid * 8 + wave) * per, m1 = (m0 + per < NLAT) ? m0 + per : NLAT;
    if (m0 >= m1) return;
    const bool b4 = (lane & 16) != 0, b3 = (lane & 8) != 0, b2 = (lane & 4) != 0;
    f32x4 na[4], nb[4];
#pragma unroll
    for (int j = 0; j < 4; ++j) { na[j] = gldf4(uptr(p.out + (size_t)m0 * 1024) + (unsigned)(4 * lane) + 256 * j); nb[j] = gldf4(uptr(p.out + (size_t)(m0 + 1 < m1 ? m0 + 1 : m0) * 1024) + (unsigned)(4 * lane) + 256 * j); }
    for (int m = m0; m < m1; m += 2) {
        const bool two = m + 1 < m1;
        const int ma = m, mb = two ? m + 1 : m;
        f32x4 va[4], vb[4];
#pragma unroll
        for (int j = 0; j < 4; ++j) { va[j] = na[j]; vb[j] = nb[j]; }
        if (m + 2 < m1) { const int pa = m + 2, pb = (m + 3 < m1) ? m + 3 : m + 2;
#pragma unroll
            for (int j = 0; j < 4; ++j) { na[j] = gldf4(uptr(p.out + (size_t)pa * 1024) + (unsigned)(4 * lane) + 256 * j); nb[j] = gldf4(uptr(p.out + (size_t)pb * 1024) + (unsigned)(4 * lane) + 256 * j); } }
        float sa = 0.f, sb = 0.f;
#pragma unroll
        for (int j = 0; j < 4; ++j) { sa += va[j].x * va[j].x + va[j].y * va[j].y + va[j].z * va[j].z + va[j].w * va[j].w; sb += vb[j].x * vb[j].x + vb[j].y * vb[j].y + vb[j].z * vb[j].z + vb[j].w * vb[j].w; }
        const float ra = rsqrtf(wave_sum(sa) * (1.f / 1024.f) + EPS), rb = rsqrtf(wave_sum(sb) * (1.f / 1024.f) + EPS);
        const float* gpa = gsS + (ma >> 12) * 1024; const float* gpb = gsS + (mb >> 12) * 1024;
        f32x2 vv[4][4];
#pragma unroll
        for (int j = 0; j < 4; ++j) { const int k = 4 * (lane + 64 * j);
            const f32x4 xa = va[j] * ra * *(const f32x4*)(gpa + k) + *(const f32x4*)(gpa + NB * 1024 + k), xb = vb[j] * rb * *(const f32x4*)(gpb + k) + *(const f32x4*)(gpb + NB * 1024 + k);
            *(GAS unsigned*)(uptr((unsigned char*)hb + (size_t)ma * 1024) + (unsigned)(4 * lane) + 256 * j) = pk4f8(xa);
            if (two) *(GAS unsigned*)(uptr((unsigned char*)hb + (size_t)mb * 1024) + (unsigned)(4 * lane) + 256 * j) = pk4f8(xb);
            vv[j][0] = (f32x2){xa.x, xb.x}; vv[j][1] = (f32x2){xa.y, xb.y}; vv[j][2] = (f32x2){xa.z, xb.z}; vv[j][3] = (f32x2){xa.w, xb.w}; }
        f32x2 lg[16];
        unsigned wo = (unsigned)lane * 16u; asm volatile("" : "+v"(wo));
        const unsigned char* wb = (const unsigned char*)wrT + wo;
#pragma unroll
        for (int e = 0; e < 16; ++e) {
            f32x2 acc = {0.f, 0.f};
#pragma unroll
            for (int j = 0; j < 4; ++j) { const f32x4 w = *(const f32x4*)(wb + e * 4096 + j * 1024);
                acc += vv[j][0] * (f32x2){w.x, w.x}; acc += vv[j][1] * (f32x2){w.y, w.y}; acc += vv[j][2] * (f32x2){w.z, w.z}; acc += vv[j][3] * (f32x2){w.w, w.w}; }
            lg[e] = acc;
        }
#pragma unroll
        for (int r = 0; r < 2; ++r) {
            float r8[8], r4[4], r2[2];
#pragma unroll
            for (int e = 0; e < 8; ++e) { const u32x2v q = __builtin_amdgcn_permlane32_swap(__float_as_uint(r ? lg[e].y : lg[e].x), __float_as_uint(r ? lg[e + 8].y : lg[e + 8].x), false, false); r8[e] = __uint_as_float(q[0]) + __uint_as_float(q[1]); }
#pragma unroll
            for (int e = 0; e < 4; ++e) r4[e] = (b4 ? r8[e + 4] : r8[e]) + swz_xor<16>(b4 ? r8[e] : r8[e + 4]);
#pragma unroll
            for (int e = 0; e < 2; ++e) r2[e] = (b3 ? r4[e + 2] : r4[e]) + swz_xor<8>(b3 ? r4[e] : r4[e + 2]);
            float lgt = (b2 ? r2[1] : r2[0]) + swz_xor<4>(b2 ? r2[0] : r2[1]);
            lgt += swz_xor<2>(lgt); lgt += swz_xor<1>(lgt);
            const float mx = wave_max(lgt), ex = expf(lgt - mx), den = wave_sum(ex) * 0.25f;
            const int mr = r ? mb : ma, b = mr >> 12, t = mr & 4095;
            if ((r == 0 || two) && (lane & 3) == 0) *(GAS float*)(uptr(aff + (size_t)b * 16 * 4096 + t) + (unsigned)(((lane >> 2) & 15) * 4096)) = ex / den;
        }
    }
}

DEVI void phase_topk(const P& p, int bid, int nblk, unsigned char* lds) {
    const int tid = tid_(), lane = tid & 63, wave = tid >> 6;
    unsigned* hist = (unsigned*)lds; unsigned* sh = hist + 256;
    const float* aff = (const float*)(p.ws + WS_AFF); int* idx = (int*)(p.ws + WS_IDX); float* gate = (float*)(p.ws + WS_GATE); int* slot_of = (int*)(p.ws + WS_SLOT);
    for (int item = bid; item < NB * NE; item += nblk) {
        const float* a = aff + (size_t)item * 4096 + tid * 8;
        unsigned u[8];
        { const u32x4 t0 = *(const u32x4*)a, t1 = *(const u32x4*)(a + 4); u[0] = t0.x; u[1] = t0.y; u[2] = t0.z; u[3] = t0.w; u[4] = t1.x; u[5] = t1.y; u[6] = t1.z; u[7] = t1.w; }
        unsigned prefix = 0u, mask = 0u, need = CAP;
        for (int pass = 0; pass < 4; ++pass) {
            const int shift = 24 - 8 * pass;
            if (tid < 256) hist[tid] = 0u;
            __syncthreads();
#pragma unroll
            for (int j = 0; j < 8; ++j) if ((u[j] & mask) == prefix) atomicAdd(&hist[(u[j] >> shift) & 255u], 1u);
            __syncthreads();
            if (wave == 0) {
                const unsigned c0 = hist[255 - 4 * lane], c1 = hist[254 - 4 * lane], c2 = hist[253 - 4 * lane], c3 = hist[252 - 4 * lane], T4 = c0 + c1 + c2 + c3;
                unsigned inc = T4;
#pragma unroll
                for (int o = 1; o < 64; o <<= 1) { const unsigned n = (unsigned)__builtin_amdgcn_ds_bpermute(((lane - o) & 63) << 2, (int)inc); if (lane >= o) inc += n; }
                const unsigned exc = inc - T4;
                if (exc < need && need <= inc) {
                    unsigned cum = exc; int sel = 255 - 4 * lane;
                    if (cum + c0 < need) { cum += c0; --sel; if (cum + c1 < need) { cum += c1; --sel; if (cum + c2 < need) { cum += c2; --sel; } } }
                    sh[0] = (unsigned)sel; sh[1] = need - cum;
                }
            }
            __syncthreads();
            prefix |= sh[0] << shift; mask |= 255u << shift; need = sh[1];
            __syncthreads();
        }
        const unsigned T = prefix;
        unsigned cg = 0u, ce = 0u;
#pragma unroll
        for (int j = 0; j < 8; ++j) { cg += (u[j] > T) ? 1u : 0u; ce += (u[j] == T) ? 1u : 0u; }
        const unsigned packed = cg | (ce << 16);
        unsigned incl = packed;
#pragma unroll
        for (int o = 1; o < 64; o <<= 1) { const unsigned n = (unsigned)__builtin_amdgcn_ds_bpermute(((lane - o) & 63) << 2, (int)incl); if (lane >= o) incl += n; }
        if (lane == 63) sh[8 + wave] = incl;
        __syncthreads();
        unsigned woff = 0u;
        for (int w = 0; w < wave; ++w) woff += sh[8 + w];
        const unsigned excl = incl - packed + woff;
        unsigned gb = excl & 0xffffu, eb = excl >> 16;
#pragma unroll
        for (int j = 0; j < 8; ++j) {
            const int i = tid * 8 + j; const bool gt = u[j] > T, eq = u[j] == T;
            int slot = -1;
            if (gt) slot = (int)(gb + (eb < need ? eb : need));
            else if (eq && eb < need) slot = (int)(gb + eb);
            if (slot >= 0) { idx[item * CAP + slot] = i; gate[item * CAP + slot] = __uint_as_float(u[j]); }
            slot_of[(size_t)item * 4096 + i] = slot;
            gb += gt ? 1u : 0u; eb += eq ? 1u : 0u;
        }
        __syncthreads();
    }
}

DEVI void phase_combine(const P& p, int bid, int nblk) {
    const int tid = tid_(), lane = tid & 63, wave = tid >> 6;
    const float* mod = (const float*)(p.ws + WS_MOD); const int* slot_of = (const int*)(p.ws + WS_SLOT); const bf16_t* Y = (const bf16_t*)(p.ws + WS_Y);
    const int NGW = nblk * 8, per = (NLAT + NGW - 1) / NGW, m0 = (bid * 8 + wave) * per, m1 = (m0 + per < NLAT) ? m0 + per : NLAT;
    if (m0 >= m1) return;
    int sln = -1; f32x4 xn[4];
#define CB_LOAD(m_) do { sln = -1; if (lane < NE) sln = *(const GAS int*)(slot_of + ((size_t)(((m_) >> 12) * 16 + lane)) * 4096 + ((m_) & 4095)); \
        _Pragma("unroll") for (int j = 0; j < 4; ++j) xn[j] = gldf4(p.out + (size_t)(m_) * 1024 + 4 * (lane + 64 * j)); } while (0)
    CB_LOAD(m0);
    int bc = -1; f32x4 md[4];
    for (int m = m0; m < m1; ++m) {
        const int b = m >> 12;
        const int sl = sln; f32x4 xv[4], acc[4];
#pragma unroll
        for (int j = 0; j < 4; ++j) { xv[j] = xn[j]; acc[j] = (f32x4){0.f, 0.f, 0.f, 0.f}; }
        if (m + 1 < m1) CB_LOAD(m + 1);
        if (b != bc) { bc = b;
#pragma unroll
            for (int j = 0; j < 4; ++j) md[j] = gldf4(mod + b * 6144 + 5120 + 4 * (lane + 64 * j)); }
        unsigned long long mask = __ballot(sl >= 0);
        while (mask) {
            int e[4]; float w[4];
#pragma unroll
            for (int q = 0; q < 4; ++q) {
                if (mask) { e[q] = __builtin_ctzll(mask); mask &= mask - 1; w[q] = 1.f; } else { e[q] = e[0]; w[q] = 0.f; }
            }
            u32x2 y[4][4];
#pragma unroll
            for (int q = 0; q < 4; ++q) {
                const int sq = __builtin_amdgcn_readlane(sl, e[q]);
                const bf16_t* yp = Y + ((size_t)(b * 16 + e[q]) * CAP + sq) * 1024 + 4 * lane;
#pragma unroll
                for (int j = 0; j < 4; ++j) y[q][j] = gld8(yp + 256 * j);
            }
#pragma unroll
            for (int q = 0; q < 4; ++q)
#pragma unroll
                for (int j = 0; j < 4; ++j) acc[j] += (f32x4){bflo(y[q][j].x), bfhi(y[q][j].x), bflo(y[q][j].y), bfhi(y[q][j].y)} * w[q];
        }
#pragma unroll
        for (int j = 0; j < 4; ++j) gstf4(p.out + (size_t)m * 1024 + 4 * (lane + 64 * j), xv[j] + md[j] * acc[j]);
    }
#undef CB_LOAD
}

template <int PH>
DEVI void run_phase(const P& p, int bid, int nblk, unsigned char* lds) {
    LAS unsigned char* l3 = (LAS unsigned char*)lds;
    if (PH == 0) { phase_prep(p, bid, nblk, lds);
        if (nblk == 256) { __syncthreads(); phase_expert_convert(p, 0, 192, bid, nblk, lds, 0, 1); } }
    if (PH == 1) phase_norm1(p, bid, nblk);
    if (PH == 2) { G1 g{(const bf16_t*)(p.ws + WS_A), (const bf16_t*)(p.ws + WS_WIN), (bf16_t*)(p.ws + WS_ZRNN), (bf16_t*)(p.ws + WS_GELU), (bf16_t*)(p.ws + WS_ZQ), (bf16_t*)(p.ws + WS_ZKVR), (bf16_t*)(p.ws + WS_G)}; gemm_fast(g, bid, nblk, l3);
        { G1g g8{p.ws + WS_A18, p.ws + WS_WIN8, (bf16_t*)(p.ws + WS_G)}; gemm_fast(g8, bid, nblk, l3); }
        __syncthreads(); phase_expert_convert(p, 1, (nblk == 256 ? 40 : 0), bid, nblk, lds); }
    if (PH == 3) { phase_mla_pre(p, bid, nblk); phase_rnn<false>(p, bid, nblk, l3); }
    if (PH == 4) { phase_rnn_carry(p, bid, nblk);
        LAS float* cst = (LAS float*)(l3 + 131072);
        { const int tid = tid_(); const float* rope = (const float*)(p.ws + WS_ROPE);
          for (int i = tid; i < 160 + 1024; i += NTHR) cst[i] = i < 64 ? p.g_q_nope[i] : i < 128 ? p.g_k_nope[i - 64] : i < 160 ? p.g_q_rope[i - 128] : rope[i - 160]; }
        __syncthreads();
        GP4 g{p.ws, cst}; gemm_fast(g, bid, nblk, l3);
        if (nblk == 256) { __syncthreads(); phase_expert_convert(p, 0, 160, bid, nblk, lds, 1, 3); } }
    if (PH == 5) { phase_attn(p, bid, nblk, l3); __syncthreads(); phase_rnn<true>(p, bid, nblk, l3); }
    if (PH == 6) { phase_expert_convert(p, 0, 0, bid, nblk, lds, nblk == 256 ? E_EARLY : 0, 16); __syncthreads();
        G2 g{(const bf16_t*)(p.ws + WS_GELU), (const bf16_t*)(p.ws + WS_ATTN), (const bf16_t*)(p.ws + WS_WRNN), (const bf16_t*)(p.ws + WS_WMLA), (const bf16_t*)(p.ws + WS_G), (bf16_t*)(p.ws + WS_A)}; gemm_fast(g, bid, nblk, l3); }
    if (PH == 7) { G3 g{(const bf16_t*)(p.ws + WS_A), (const bf16_t*)(p.ws + WS_WO), p.x, (const float*)(p.ws + WS_MOD), p.out}; gemm_fast(g, bid, nblk, l3); }
    if (PH == 8) phase_norm2_router(p, bid, nblk, lds);
    if (PH == 9) { phase_topk(p, bid, nblk, lds);
        if (nblk == 256) { __syncthreads(); phase_expert_convert(p, 0, 128, bid, nblk, lds, 3, 6); phase_expert_convert(p, 0, 128, bid, nblk, lds, 14, 15); } }
    if (PH == 10) { GM1 g{p.ws + WS_A, p.ws, (const int*)(p.ws + WS_IDX), p.ws + WS_HID}; gemm_fast(g, bid, nblk, l3); }
    if (PH == 11) { GM2 g{p.ws + WS_HID, p.ws + WS_WD, (const float*)(p.ws + WS_GATE), (bf16_t*)(p.ws + WS_Y)}; gemm_fast(g, bid, nblk, l3); }
    if (PH == 12) phase_combine(p, bid, nblk);
}

#define XB_TMO      128
#define XB_XCNT(j)  (256  + 64 * (j))
#define XB_XSUB(j)  (1280 + 64 * (j))
#define XB_XGEN(j)  (2304 + 64 * (j))
#define XB_TOP      3328
#define XB_TOPGEN   3392
#define XCD_BAR_WORDS 3456
#define XB_SPIN_CAP (1u << 20)
DEVI unsigned xb_ld(unsigned* p)              { return __hip_atomic_load(p, __ATOMIC_RELAXED, __HIP_MEMORY_SCOPE_AGENT); }
DEVI unsigned xb_add(unsigned* p, unsigned v) { return __hip_atomic_fetch_add(p, v, __ATOMIC_RELAXED, __HIP_MEMORY_SCOPE_AGENT); }
DEVI unsigned xb_xcc_id() { return (unsigned)__builtin_amdgcn_s_getreg((3 << 11) | 20) & 0xFu; }
#define XB_SPIN(cond, bar) do { unsigned _sp = 0; while (cond) { __builtin_amdgcn_s_sleep(1); \
    if ((++_sp & 255u) == 0u) { if (xb_ld(&(bar)[XB_TMO])) break; if (_sp > XB_SPIN_CAP) { atomicAdd(&(bar)[XB_TMO], 1u); break; } } } } while (0)
struct XcdBarrier { unsigned* bar; unsigned x; volatile LAS unsigned* st; };
DEVI XcdBarrier xcd_barrier_post(unsigned* bar, volatile LAS unsigned* st) {
    XcdBarrier b; b.bar = bar; b.x = xb_xcc_id(); b.st = st;
    if (threadIdx.x == 0) (void)xb_add(&bar[XB_XCNT(b.x)], 1u);
    return b;
}
DEVI void xcd_barrier_complete(unsigned* bar, unsigned x, unsigned& nloc, unsigned& nx) {
    const unsigned G = gridDim.x * gridDim.y * gridDim.z;
    unsigned sum, cnt, mine, sp = 0u;
    for (;;) {
        sum = 0u; cnt = 0u; mine = 0u;
#pragma unroll
        for (unsigned j = 0; j < 16; ++j) { const unsigned c = xb_ld(&bar[XB_XCNT(j)]); sum += c; cnt += (c > 0u) ? 1u : 0u; mine = (j == x) ? c : mine; }
        if (sum == G) break;
        __builtin_amdgcn_s_sleep(1);
        if ((++sp & 255u) == 0u) { if (xb_ld(&bar[XB_TMO])) break; if (sp > XB_SPIN_CAP) { atomicAdd(&bar[XB_TMO], 1u); break; } }
    }
    nloc = mine > 0u ? mine : 1u; nx = cnt > 0u ? cnt : 1u;
}
DEVI void xcd_barrier(const XcdBarrier& b) {
    asm volatile("s_waitcnt vmcnt(0)" ::: "memory");
    __syncthreads();
    if (threadIdx.x == 0) {
        unsigned* bar = b.bar;
        __builtin_amdgcn_s_waitcnt(0);
        unsigned nloc = b.st[0], nx = b.st[1];
        if (nloc == 0u) { xcd_barrier_complete(bar, b.x, nloc, nx); b.st[0] = nloc; b.st[1] = nx; }
        const unsigned old = xb_add(&bar[XB_XSUB(b.x)], 1u);
        const unsigned gen = old / nloc;
        if (old + 1u == (gen + 1u) * nloc) {
            __builtin_amdgcn_fence(__ATOMIC_RELEASE, "agent");
            asm volatile("s_waitcnt vmcnt(0)" ::: "memory");
            const unsigned og = xb_add(&bar[XB_TOP], 1u);
            const unsigned tg = og / nx;
            if (og + 1u == (tg + 1u) * nx) xb_add(&bar[XB_TOPGEN], 1u);
            else XB_SPIN(xb_ld(&bar[XB_TOPGEN]) == tg, bar);
            __builtin_amdgcn_fence(__ATOMIC_ACQUIRE, "agent");
            xb_add(&bar[XB_XGEN(b.x)], 1u);
            asm volatile("s_waitcnt vmcnt(0)" ::: "memory");
        } else {
            XB_SPIN(xb_ld(&bar[XB_XGEN(b.x)]) == gen, bar);
            __builtin_amdgcn_fence(__ATOMIC_ACQUIRE, "agent");
            asm volatile("s_waitcnt vmcnt(0)" ::: "memory");
        }
    }
    __syncthreads();
}

constexpr int CW_BAR = 4096;

constexpr unsigned PROBE_MASK = 0u;
__global__ void __launch_bounds__(NTHR, 2) mega_fwd(P p) {
    extern __shared__ __attribute__((aligned(16))) unsigned char lds[];
    const int bid = (int)blockIdx.x, nblk = (int)gridDim.x;
    volatile LAS unsigned* MISC = (volatile LAS unsigned*)((LAS unsigned char*)lds + MISC_OFF);
    if (threadIdx.x < 32) MISC[threadIdx.x] = 0u;
    if ((threadIdx.x & 63) == 0) MISC[32 + hw_slot_()] = threadIdx.x >> 6;
    __syncthreads();
    XcdBarrier bar = xcd_barrier_post((unsigned*)(p.ws + WS_CTL) + CW_BAR, MISC + 8);
    unsigned long long t_prev = 0ull;
    if (PROBE_MASK) t_prev = __builtin_amdgcn_s_memrealtime();
#define SEAM(k) do { xcd_barrier(bar); asm volatile("" : "+s"(p.ws)); \
    if (PROBE_MASK) { const unsigned long long t1_ = __builtin_amdgcn_s_memrealtime(); \
        if ((PROBE_MASK >> (k)) & 1u) { const unsigned long long d_ = t1_ - t_prev; while (__builtin_amdgcn_s_memrealtime() - t1_ < d_) __builtin_amdgcn_s_sleep(8); } \
        t_prev = __builtin_amdgcn_s_memrealtime(); } } while (0)
    run_phase<0>(p, bid, nblk, lds); SEAM(0);
    run_phase<1>(p, bid, nblk, lds); SEAM(1);
    run_phase<2>(p, bid, nblk, lds); SEAM(2);
    run_phase<3>(p, bid, nblk, lds); SEAM(3);
    run_phase<4>(p, bid, nblk, lds); SEAM(4);
    run_phase<5>(p, bid, nblk, lds); SEAM(5);
    run_phase<6>(p, bid, nblk, lds); SEAM(6);
    run_phase<7>(p, bid, nblk, lds); SEAM(7);
    run_phase<8>(p, bid, nblk, lds); SEAM(8);
    run_phase<9>(p, bid, nblk, lds); SEAM(9);
    run_phase<10>(p, bid, nblk, lds); SEAM(10);
    run_phase<11>(p, bid, nblk, lds); SEAM(11);
    run_phase<12>(p, bid, nblk, lds);
    if (PROBE_MASK) SEAM(12);
#undef SEAM
}

extern "C" void kernel_launch(void* const* d_in, const int* in_sizes, int n_in, void* d_out, int out_size, void* d_ws, size_t ws_size, hipStream_t stream) {
    static int grid = 0;
    if (grid == 0) {
        if (n_in != 32 || ws_size < WS_END) { fprintf(stderr, "kernel_launch: unexpected n_in %d / ws_size %zu\n", n_in, ws_size); grid = -1; return; }
        int dev = 0, cus = 0, per_cu = 0;
        if (hipGetDevice(&dev) != hipSuccess || hipDeviceGetAttribute(&cus, hipDeviceAttributeMultiprocessorCount, dev) != hipSuccess) { grid = -1; return; }
        if (hipFuncSetAttribute((const void*)mega_fwd, hipFuncAttributeMaxDynamicSharedMemorySize, LDS_BYTES) != hipSuccess) { fprintf(stderr, "kernel_launch: hipFuncSetAttribute failed\n"); grid = -1; return; }
        if (hipOccupancyMaxActiveBlocksPerMultiprocessor(&per_cu, (const void*)mega_fwd, NTHR, LDS_BYTES) != hipSuccess || per_cu < 1) { fprintf(stderr, "kernel_launch: occupancy query says %d\n", per_cu); }
        (void)hipGetLastError();
        grid = cus;
    }
    if (grid < 0) return;
    P p{};
    const float** fp = (const float**)&p;
    for (int i = 0; i < 32; ++i) fp[i] = (const float*)d_in[i];
    p.out = (float*)d_out; p.ws = (unsigned char*)d_ws;
    (void)hipMemsetAsync((char*)d_ws + WS_CTL, 0, 64 * 1024, stream);
    hipLaunchKernelGGL(mega_fwd, dim3(grid), dim3(NTHR), LDS_BYTES, stream, p);
}
```

```cpp
#include <hip/hip_runtime.h>
#include <stdint.h>
#include <stdio.h>

#define DEVI __device__ __forceinline__
typedef unsigned short bf16_t;
typedef float f32x4 __attribute__((ext_vector_type(4)));
typedef unsigned u32x4 __attribute__((ext_vector_type(4)));
typedef unsigned u32x2 __attribute__((ext_vector_type(2)));

constexpr int NTHR = 512;
constexpr int DM = 1024, NB = 8, SEQ = 4096, CTXL = 256;
constexpr int NLAT = NB * SEQ, NCTX = NB * CTXL, NROW = NLAT + NCTX, NKEY = SEQ + CTXL;
constexpr int NE = 16, CAP = 512;
constexpr float EPS = 1e-6f;
constexpr float QSCALE = 0.10206207261596575f * 1.4426950408889634f;

constexpr size_t MiB = 1u << 20;
constexpr size_t WS_CTL = 0;
constexpr size_t WS_MOD = 1 * MiB;
constexpr size_t WS_ROPE = WS_MOD + 256 * 1024;
constexpr size_t WS_SP = WS_ROPE + 4096;
constexpr size_t WS_SMAX = WS_SP + 8192;
constexpr size_t WS_RSTDQ = 1 * MiB + 512 * 1024;
constexpr size_t WS_RSTDKV = WS_RSTDQ + 128 * 1024;
constexpr size_t WS_WIN = 2 * MiB;
constexpr size_t WS_WRNN = 11 * MiB;
constexpr size_t WS_WMLA = 13 * MiB;
constexpr size_t WS_WO = 14 * MiB;
constexpr size_t WS_WUQ = 16 * MiB;
constexpr size_t WS_WUK = WS_WUQ + 384 * 1024;
constexpr size_t WS_WUV = WS_WUK + 256 * 1024;
constexpr size_t WS_WRG = 17 * MiB;
constexpr size_t WS_RNNSUM = 18 * MiB;
constexpr size_t WS_WIN8 = 27 * MiB;
constexpr size_t WS_A18 = 393 * MiB;
constexpr size_t WS_AFF = 27 * MiB;
constexpr size_t WS_IDX = 29 * MiB;
constexpr size_t WS_GATE = WS_IDX + 256 * 1024;
constexpr size_t WS_SLOT = WS_GATE + 256 * 1024;
constexpr size_t WS_A = 32 * MiB;
constexpr size_t WS_ZRNN = 100 * MiB;
constexpr size_t WS_GELU = 168 * MiB;
constexpr size_t WS_ZQ = 232 * MiB;
constexpr size_t WS_ZKVR = 248 * MiB;
constexpr size_t WS_ATTN = 232 * MiB;
constexpr size_t WS_G = 265 * MiB;
constexpr size_t WS_K = 393 * MiB;
constexpr size_t WS_VT = 444 * MiB;
constexpr size_t WS_HID = 265 * MiB;
constexpr size_t WS_Y = 100 * MiB;
constexpr int E_EARLY = 14;
constexpr size_t WS_WGU_LO = 496 * MiB;
constexpr size_t WS_WGU_MID = 96 * MiB;
constexpr size_t WS_WGU_WIN = 2 * MiB;
DEVI size_t wgu_off(int e) { return e < 8 ? WS_WGU_LO + (size_t)e * 2048 * 1024 : e < 10 ? WS_WGU_MID + (size_t)(e - 8) * 2048 * 1024 : e < E_EARLY ? WS_WGU_WIN + (size_t)(e - 10) * 2048 * 1024 : (393 * MiB) + (size_t)e * 2048 * 1024; }
constexpr size_t WS_WGU = 393 * MiB;
constexpr size_t WS_WD = 480 * MiB;
constexpr size_t WS_HF = 393 * MiB;
constexpr size_t WS_END = 512 * MiB;

struct P {
    const float *x, *c, *ctx, *c_ctx, *w_ada, *b_ada, *g_norm1, *g_norm2, *w_in, *conv_w, *conv_b, *rg_wa, *rg_ba, *rg_wx, *rg_bx, *rg_lambda,
        *w_rnn_out, *g_q_lora, *w_uq, *g_kv_lora, *w_uk, *w_uv, *g_q_nope, *g_q_rope, *g_k_nope, *g_k_rope, *w_mla_out, *w_o, *w_router, *w_e_gate,
        *w_e_up, *w_e_down;
    float* out;
    unsigned char* ws;
};

DEVI unsigned f2bf(float f) { unsigned u = __float_as_uint(f); return (u + 0x7fffu + ((u >> 16) & 1u)) >> 16; }
typedef __bf16 bf16v2 __attribute__((ext_vector_type(2)));
typedef float f32x2 __attribute__((ext_vector_type(2)));
DEVI unsigned pk2(float lo, float hi) { const f32x2 v = {lo, hi}; return __builtin_bit_cast(unsigned, __builtin_convertvector(v, bf16v2)); }
DEVI float bflo(unsigned u) { return __uint_as_float(u << 16); }
DEVI float bfhi(unsigned u) { return __uint_as_float(u & 0xffff0000u); }
DEVI float bf2f(bf16_t h) { return __uint_as_float(((unsigned)h) << 16); }
template <int M> DEVI float swz_xor(float x) { return __int_as_float(__builtin_amdgcn_ds_swizzle(__float_as_int(x), (M << 10) | 0x1f)); }
typedef unsigned u32x2v __attribute__((ext_vector_type(2)));
DEVI float xor32_sum(float x) { const u32x2v r = __builtin_amdgcn_permlane32_swap(__float_as_uint(x), __float_as_uint(x), false, false); return __uint_as_float(r[0]) + __uint_as_float(r[1]); }
DEVI float xor32_get(float x, int hi) { const u32x2v r = __builtin_amdgcn_permlane32_swap(__float_as_uint(x), __float_as_uint(x), false, false); return __uint_as_float(hi ? r[0] : r[1]); }
DEVI float xor32_max(float x) { const u32x2v r = __builtin_amdgcn_permlane32_swap(__float_as_uint(x), __float_as_uint(x), false, false); return fmaxf(__uint_as_float(r[0]), __uint_as_float(r[1])); }
DEVI float wave_max(float v) { v = fmaxf(v, swz_xor<1>(v)); v = fmaxf(v, swz_xor<2>(v)); v = fmaxf(v, swz_xor<4>(v)); v = fmaxf(v, swz_xor<8>(v)); v = fmaxf(v, swz_xor<16>(v)); return xor32_max(v); }
DEVI float wave_sum(float v) { v += swz_xor<1>(v); v += swz_xor<2>(v); v += swz_xor<4>(v); v += swz_xor<8>(v); v += swz_xor<16>(v); return xor32_sum(v); }
DEVI float sigm(float x) { return __builtin_amdgcn_rcpf(1.f + __builtin_amdgcn_exp2f(-1.4426950408889634f * x)); }
DEVI float gelu_tanh(float x) { const float u = 0.7978845608028654f * (x + 0.044715f * x * x * x); return x * sigm(2.f * u); }
#define GAS __attribute__((address_space(1)))
template <class T> DEVI T* uptr(T* p) { const unsigned long long v = (unsigned long long)p; const unsigned lo = __builtin_amdgcn_readfirstlane((unsigned)v), hi = __builtin_amdgcn_readfirstlane((unsigned)(v >> 32)); return (T*)(((unsigned long long)hi << 32) | lo); }
DEVI u32x4 gld16(const void* p) { return *(const GAS u32x4*)p; }
DEVI u32x2 gld8(const void* p) { return *(const GAS u32x2*)p; }
DEVI f32x4 gldf4(const void* p) { return *(const GAS f32x4*)p; }
DEVI float gldf(const void* p) { return *(const GAS float*)p; }
DEVI void gst16(void* p, u32x4 v) { *(GAS u32x4*)p = v; }
DEVI void gst8(void* p, u32x2 v) { *(GAS u32x2*)p = v; }
DEVI void gstf4(void* p, f32x4 v) { *(GAS f32x4*)p = v; }
DEVI void store4bf(bf16_t* o, f32x4 v) { u32x2 w; w.x = pk2(v.x, v.y); w.y = pk2(v.z, v.w); gst8(o, w); }
DEVI f32x4 load4bf(const bf16_t* o) { const u32x2 w = gld8(o); return (f32x4){bflo(w.x), bfhi(w.x), bflo(w.y), bfhi(w.y)}; }
DEVI float dot8(u32x4 a, u32x4 b, float acc) {
    acc = fmaf(bflo(a.x), bflo(b.x), acc); acc = fmaf(bfhi(a.x), bfhi(b.x), acc);
    acc = fmaf(bflo(a.y), bflo(b.y), acc); acc = fmaf(bfhi(a.y), bfhi(b.y), acc);
    acc = fmaf(bflo(a.z), bflo(b.z), acc); acc = fmaf(bfhi(a.z), bfhi(b.z), acc);
    acc = fmaf(bflo(a.w), bflo(b.w), acc); acc = fmaf(bfhi(a.w), bfhi(b.w), acc);
    return acc;
}
constexpr int LDS_BYTES = 147456;
constexpr int MISC_OFF = LDS_BYTES - 512;
DEVI unsigned hw_slot_() { return (unsigned)__builtin_amdgcn_s_getreg((5 << 11) | 4) & 63u; }
DEVI int tid_() {
    extern __shared__ __attribute__((aligned(16))) unsigned char lds_dyn_[];
    int w = (int)((volatile __attribute__((address_space(3))) unsigned*)((__attribute__((address_space(3))) unsigned char*)lds_dyn_ + MISC_OFF))[32 + hw_slot_()];
    w = __builtin_amdgcn_readfirstlane(w);
    int l; asm volatile("v_mbcnt_lo_u32_b32 %0, -1, 0\n\tv_mbcnt_hi_u32_b32 %0, -1, %0" : "=v"(l));
    int t = w * 64 + l;
    asm volatile("" : "+v"(t));
    return t;
}
#define LDS_WAIT() asm volatile("s_waitcnt lgkmcnt(0)" ::: "memory")
constexpr float W8_SCALE = 64.f; constexpr int W8_MXS = 0x79797979;
DEVI unsigned pk4f8(f32x4 v) { unsigned w = __builtin_amdgcn_cvt_pk_fp8_f32(v.x, v.y, 0u, false); return __builtin_amdgcn_cvt_pk_fp8_f32(v.z, v.w, w, true); }

template <class RM>
DEVI void transpose_item(const float* W, int ldw, int K, bf16_t* WT, RM rm, float* scr, int k0, int n0, int lane, const float* kscale = nullptr, float mul = 1.f) {
#pragma unroll 8
    for (int i = 0; i < 8; ++i) { const int kk = 8 * i + (lane >> 3), c4 = (lane & 7) * 4;
        f32x4 v = gldf4(W + (size_t)(k0 + kk) * ldw + n0 + c4); if (kscale) v = v * kscale[k0 + kk]; v = v * mul;
        float* d = scr + kk * 33 + c4; d[0] = v.x; d[1] = v.y; d[2] = v.z; d[3] = v.w; }
    LDS_WAIT();
    const int c = lane & 7;
#pragma unroll
    for (int j = 0; j < 4; ++j) {
        const int n = (lane >> 3) + 8 * j; const float* s = scr + (8 * c) * 33 + n;
        u32x4 o; o.x = pk2(s[0 * 33], s[1 * 33]); o.y = pk2(s[2 * 33], s[3 * 33]); o.z = pk2(s[4 * 33], s[5 * 33]); o.w = pk2(s[6 * 33], s[7 * 33]);
        *(u32x4*)(WT + (size_t)rm(n0 + n) * K + k0 + 8 * c) = o;
    }
    LDS_WAIT();
}
struct RmId { DEVI int operator()(int n) const { return n; } };
DEVI int perm_slot(int n) { const int x = n & 31; return (n & ~31) + 16 * ((x >> 2) & 1) + 4 * (x >> 3) + (x & 3); }
struct RmPerm { DEVI int operator()(int n) const { return perm_slot(n); } };
struct RmWin { DEVI int operator()(int n) const { return perm_slot(n < 2464 ? n : n + 96); } };
struct RmUq { DEVI int operator()(int n) const { const int head = n / 96, dd = n % 96; return dd < 64 ? (head >> 2) * 256 + 128 * (dd >> 5) + 32 * (head & 3) + (dd & 31) : 512 + 128 * (head >> 2) + 32 * (head & 3) + (dd - 64); } };
struct RmUk { DEVI int operator()(int n) const { const int head = n >> 6, d = n & 63; return (head >> 2) * 256 + 128 * (d >> 5) + 32 * (head & 3) + (d & 31); } };
struct RmGU { int up; DEVI int operator()(int n) const { const int hl = n & 127, wc = hl >> 5, fq = (hl >> 3) & 3, bj = (hl >> 2) & 1, j = hl & 3; return (n >> 7) * 256 + 128 * bj + 32 * wc + 16 * up + 4 * fq + j; } };

template <class RM>
DEVI void transpose_item8(const float* W, int ldw, int K, unsigned char* WT, RM rm, float* scr, int k0, int n0, int lane) {
#pragma unroll 8
    for (int i = 0; i < 8; ++i) { const int kk = 8 * i + (lane >> 3), c4 = (lane & 7) * 4;
        const f32x4 v = gldf4(W + (size_t)(k0 + kk) * ldw + n0 + c4) * W8_SCALE;
        float* d = scr + kk * 33 + c4; d[0] = v.x; d[1] = v.y; d[2] = v.z; d[3] = v.w; }
    LDS_WAIT();
    const int c = lane & 7;
#pragma unroll
    for (int j = 0; j < 4; ++j) {
        const int n = (lane >> 3) + 8 * j; const float* sp = scr + (8 * c) * 33 + n;
        u32x2 o; o.x = pk4f8((f32x4){sp[0 * 33], sp[1 * 33], sp[2 * 33], sp[3 * 33]}); o.y = pk4f8((f32x4){sp[4 * 33], sp[5 * 33], sp[6 * 33], sp[7 * 33]});
        gst8(WT + (size_t)rm(n0 + n) * K + k0 + 8 * c, o);
    }
    LDS_WAIT();
}
DEVI void phase_prep(const P& p, int bid, int nblk, unsigned char* lds) {
    const int tid = tid_(), lane = tid & 63, wave = tid >> 6;
    float* mod = (float*)(p.ws + WS_MOD);
    if (bid < 192) {
        float* sc = (float*)lds; float* red = sc + 9 * 1024;
        for (int i = tid; i < 9 * 1024; i += NTHR) { const int r = i >> 10, k = i & 1023; const float v = r < 8 ? p.c[r * 1024 + k] : p.c_ctx[k]; sc[i] = v * sigm(v); }
        __syncthreads();
        for (int item = bid; item < 192; item += nblk) {
            const int n0 = item * 32, c4 = (tid & 7) * 4, kg = tid >> 3;
            f32x4 acc[9];
#pragma unroll
            for (int r = 0; r < 9; ++r) acc[r] = (f32x4){0.f, 0.f, 0.f, 0.f};
            {   f32x4 w[16];
#pragma unroll
                for (int q = 0; q < 16; ++q) w[q] = gldf4(p.w_ada + (size_t)(kg * 16 + q) * 6144 + n0 + c4);
#pragma unroll
                for (int q = 0; q < 16; ++q) {
                    const int k = kg * 16 + q;
#pragma unroll
                    for (int r = 0; r < 9; ++r) acc[r] += w[q] * sc[r * 1024 + k];
                }
            }
#pragma unroll
            for (int r = 0; r < 9; ++r) *(f32x4*)(red + (kg * 9 + r) * 32 + c4) = acc[r];
            __syncthreads();
            if (tid < 9 * 32) { const int r = tid >> 5, cc = tid & 31; float s = 0.f; for (int g = 0; g < 64; ++g) s += red[(g * 9 + r) * 32 + cc]; mod[r * 6144 + n0 + cc] = s + p.b_ada[n0 + cc]; }
            __syncthreads();
        }
    }
    __syncthreads();
    if (bid == nblk - 1) {
        float* rope = (float*)(p.ws + WS_ROPE); float* sp = (float*)(p.ws + WS_SP); float* smax = (float*)(p.ws + WS_SMAX);
        { const int pos = tid >> 3, j = tid & 7; const float inv = powf(10000.f, -(float)j / 8.f); const float ang = (float)pos * inv;
          const float n = rintf(ang * 0.15915494309189535f); float r = fmaf(-n, 6.2831854820251465f, ang); r = fmaf(-n, -1.7484555e-7f, r);
          rope[2 * tid] = __cosf(r); rope[2 * tid + 1] = __sinf(r); }
        for (int i = tid; i < 2048; i += NTHR) { const float lam = p.rg_lambda[i]; sp[i] = 8.f * log1pf(__expf(-lam)); }
        if (tid == 0) {
            float a = 0.f, b = 0.f, cc = 0.f, d = 0.f;
            for (int i = 0; i < 64; ++i) { a = fmaxf(a, fabsf(p.g_q_nope[i])); cc = fmaxf(cc, fabsf(p.g_k_nope[i])); }
            for (int i = 0; i < 32; ++i) { b = fmaxf(b, fabsf(p.g_q_rope[i])); d = fmaxf(d, fabsf(p.g_k_rope[i])); }
            smax[0] = (64.f * a * cc + 32.f * b * d) * QSCALE * 1.01f + 0.5f;
        }
    }
    { u32x4* z = (u32x4*)(p.ws + WS_WIN + (size_t)2464 * 1024 * 2); const u32x4 zero = {0u, 0u, 0u, 0u};
      for (int i = bid * NTHR + tid; i < 96 * 1024 * 2 / 16; i += nblk * NTHR) z[i] = zero; }
    { const u32x4 zero = {0u, 0u, 0u, 0u};
      for (int i = bid * NTHR + tid; i < 1024 * 16; i += nblk * NTHR) *(u32x4*)(p.ws + WS_WUK + (size_t)(i >> 4) * 512 + 256 + (i & 15) * 16) = zero; }
    float* scr = (float*)lds + wave * (64 * 33);
    const int gw = bid * 8 + wave, NGW = nblk * 8;
    constexpr int I_WIN8 = 16 * 64;
    for (int it = gw; it < I_WIN8; it += NGW)
        transpose_item8(p.w_in + 2464, 4512, 1024, p.ws + WS_WIN8, RmPerm(), scr, 64 * (it / 64), 32 * (it % 64), lane);
    constexpr int I_WIN = 16 * 141, I_RNN = 16 * 32, I_MLA = 8 * 32, I_WO = 16 * 32, I_RG = 32 * 8, I_UQ = 4 * 24, I_UK = 2 * 16, I_UV = 2 * 16;
    for (int it = gw; it < I_WIN + I_RNN + I_MLA + I_WO + I_RG + I_UQ + I_UK + I_UV; it += NGW) {
        int r = it;
        if (r < I_UQ) { transpose_item(p.w_uq, 768, 256, (bf16_t*)(p.ws + WS_WUQ), RmUq(), scr, 64 * (r / 24), 32 * (r % 24), lane, p.g_q_lora); continue; } r -= I_UQ;
        if (r < I_UK) { transpose_item(p.w_uk, 512, 256, (bf16_t*)(p.ws + WS_WUK), RmUk(), scr, 64 * (r / 16), 32 * (r % 16), lane, p.g_kv_lora); continue; } r -= I_UK;
        if (r < I_UV) { transpose_item(p.w_uv, 512, 256, (bf16_t*)(p.ws + WS_WUV), RmId(), scr, 64 * (r / 16), 32 * (r % 16), lane, p.g_kv_lora); continue; } r -= I_UV;
        if (r < I_RG) { const int mi = r >> 3, sub = r & 7; const float* src = ((mi >> 4) ? p.rg_wx : p.rg_wa) + (size_t)(mi & 15) * 16384;
            transpose_item(src, 128, 128, (bf16_t*)(p.ws + WS_WRG) + (size_t)mi * 16384, RmId(), scr, 64 * (sub >> 2), 32 * (sub & 3), lane, nullptr, -1.4426950408889634f); continue; } r -= I_RG;
        if (r < I_WIN) { transpose_item(p.w_in, 4512, 1024, (bf16_t*)(p.ws + WS_WIN), RmWin(), scr, 64 * (r / 141), 32 * (r % 141), lane); continue; } r -= I_WIN;
        if (r < I_RNN) { transpose_item(p.w_rnn_out, 1024, 1024, (bf16_t*)(p.ws + WS_WRNN), RmPerm(), scr, 64 * (r / 32), 32 * (r % 32), lane); continue; } r -= I_RNN;
        if (r < I_MLA) { transpose_item(p.w_mla_out, 1024, 512, (bf16_t*)(p.ws + WS_WMLA), RmPerm(), scr, 64 * (r / 32), 32 * (r % 32), lane); continue; } r -= I_MLA;
        transpose_item(p.w_o, 1024, 1024, (bf16_t*)(p.ws + WS_WO), RmPerm(), scr, 64 * (r / 32), 32 * (r % 32), lane);
    }
}

DEVI void phase_expert_convert(const P& p, int part, int b0, int bid, int nblk, unsigned char* lds, int e0 = 0, int e1 = 16) {
    const int tid = tid_(), lane = tid & 63, wave = tid >> 6;
    float* scr = (float*)lds + wave * (64 * 33);
    const int gw = (bid - b0) * 8 + wave, NGW = (nblk - b0) * 8;
    if (bid < b0) return;
    if (part == 0) {
        const int ne = e1 - e0;
        for (int it = gw; it < 2 * ne * 512; it += NGW) {
            const int which = it / (ne * 512), r = it % (ne * 512), e = e0 + r / 512, t = r % 512, k0 = 64 * (t / 32), n0 = 32 * (t % 32);
            if (which == 0) transpose_item8(p.w_e_gate + (size_t)e * 1048576, 1024, 1024, p.ws + wgu_off(e), RmGU{0}, scr, k0, n0, lane);
            else transpose_item8(p.w_e_up + (size_t)e * 1048576, 1024, 1024, p.ws + wgu_off(e), RmGU{1}, scr, k0, n0, lane);
        }
    } else {
        for (int it = gw; it < 16 * 512; it += NGW) {
            const int e = it / 512, t = it % 512, k0 = 64 * (t / 32), n0 = 32 * (t % 32);
            transpose_item8(p.w_e_down + (size_t)e * 1048576, 1024, 1024, p.ws + WS_WD + (size_t)e * 1024 * 1024, RmPerm(), scr, k0, n0, lane);
        }
    }
}

DEVI void phase_norm1(const P& p, int bid, int nblk) {
    const int tid = tid_(), lane = tid & 63, wave = tid >> 6;
    const float* mod = (const float*)(p.ws + WS_MOD);
    bf16_t* A1 = (bf16_t*)(p.ws + WS_A);
    const int NGW = nblk * 8, per = (NROW + NGW - 1) / NGW, m0 = (bid * 8 + wave) * per, m1 = (m0 + per < NROW) ? m0 + per : NROW;
    if (m0 >= m1) return;
#define N1_SRC(m_) ((m_) < NLAT ? p.x + (size_t)(m_) * 1024 : p.ctx + (size_t)((m_) - NLAT) * 1024)
    f32x4 vn[4];
#pragma unroll
    for (int j = 0; j < 4; ++j) vn[j] = gldf4(N1_SRC(m0) + 4 * (lane + 64 * j));
    int mrc = -1; f32x4 gs[4], sh[4];
    for (int m = m0; m < m1; ++m) {
        f32x4 v[4];
#pragma unroll
        for (int j = 0; j < 4; ++j) v[j] = vn[j];
        if (m + 1 < m1) {
#pragma unroll
            for (int j = 0; j < 4; ++j) vn[j] = gldf4(N1_SRC(m + 1) + 4 * (lane + 64 * j));
        }
        const int mr = m < NLAT ? (m >> 12) : 8;
        if (mr != mrc) { mrc = mr;
#pragma unroll
            for (int j = 0; j < 4; ++j) { const int k = 4 * (lane + 64 * j); gs[j] = gldf4(p.g_norm1 + k) * (gldf4(mod + mr * 6144 + 1024 + k) + 1.f); sh[j] = gldf4(mod + mr * 6144 + k); } }
        float s = 0.f;
#pragma unroll
        for (int j = 0; j < 4; ++j) s += v[j].x * v[j].x + v[j].y * v[j].y + v[j].z * v[j].z + v[j].w * v[j].w;
        const float rstd = rsqrtf(wave_sum(s) * (1.f / 1024.f) + EPS);
        bf16_t* o = A1 + (size_t)m * 1024 + 4 * lane; unsigned char* o8 = p.ws + WS_A18 + (size_t)m * 1024 + 4 * lane;
#pragma unroll
        for (int j = 0; j < 4; ++j) { const f32x4 y = v[j] * rstd * gs[j] + sh[j]; store4bf(o + 256 * j, y); if (m < NLAT) *(GAS unsigned*)(o8 + 256 * j) = pk4f8(y); }
    }
#undef N1_SRC
}

#define LAS __attribute__((address_space(3)))
typedef short bf16x8 __attribute__((ext_vector_type(8)));
typedef int i32x8 __attribute__((ext_vector_type(8)));
typedef int i32x4 __attribute__((ext_vector_type(4)));
typedef float f32x16 __attribute__((ext_vector_type(16)));
typedef short s16x4 __attribute__((ext_vector_type(4)));
namespace fg {
constexpr int HTB = 128 * 64 * 2;
DEVI int lds_byte(int r, int c) { const int st = (r >> 4) * 2 + (c >> 5), rr = r & 15, cc = c & 31, ob = rr * 64 + cc * 2; return st * 1024 + (ob ^ (((ob >> 9) & 1) << 5)); }
DEVI void stage_rc(int b, int& R, int& C) { const int st = b / 1024, sb = b % 1024, swz = sb ^ (((sb >> 9) & 1) << 5); R = (st >> 1) * 16 + swz / 64; C = (st & 1) * 32 + (swz % 64) / 2; }
}
template <class G>
DEVI void gemm_fast(const G& g, int bid, int nblk, LAS unsigned char* lds) {
    using namespace fg;
    const int tid = tid_(), wid = __builtin_amdgcn_readfirstlane(tid >> 6), lane = tid & 63, wr = wid >> 2, wc = wid & 3, fr = lane & 15, fq = lane >> 4;
    int R0, C0, R1, C1; stage_rc(tid * 16, R0, C0); stage_rc(tid * 16 + 8192, R1, C1);
    const unsigned ldsw = (unsigned)wid * 1024u;
    const int aoff = lds_byte(wr * 64 + fr, fq * 8), boff = lds_byte(wc * 32 + fr, fq * 8);
#define FG_SA(b, h) (((b) * 2 + (h)) * HTB)
#define FG_SB(b, h) ((4 + (b) * 2 + (h)) * HTB)
#define FG_GLDS(src, dstoff) __builtin_amdgcn_global_load_lds((const unsigned*)(src), (LAS unsigned*)(lds + (dstoff)), 16, 0, 0)
#define FG_STAGE_A(bufoff, h, kt) do { const char* _b = xA + (size_t)(kt) * 128 + (G::GATHER ? (size_t)0 : (size_t)(h) * hstepA); FG_GLDS(_b + oA[G::GATHER ? (h) : 0][0], (bufoff) + ldsw); FG_GLDS(_b + oA[G::GATHER ? (h) : 0][1], (bufoff) + ldsw + 8192); } while (0)
#define FG_STAGE_B(bufoff, h, kt) do { const char* _b = xB + (size_t)(h) * hstepB + (size_t)(kt) * 128; FG_GLDS(_b + oB[0], (bufoff) + ldsw); FG_GLDS(_b + oB[1], (bufoff) + ldsw + 8192); } while (0)
#define FG_LDA(dst, b, h) do { _Pragma("unroll") for (int m = 0; m < 4; ++m) { if constexpr (G::FP8) { \
        const i32x4 lo_ = *(const LAS i32x4*)(lds + FG_SA(b, h) + aoff + m * 2048), hi_ = *(const LAS i32x4*)(lds + FG_SA(b, h) + aoff + m * 2048 + 1024); dst##8[m] = __builtin_shufflevector(lo_, hi_, 0, 1, 2, 3, 4, 5, 6, 7); } \
        else { _Pragma("unroll") for (int k = 0; k < 2; ++k) dst[m][k] = *(const LAS bf16x8*)(lds + FG_SA(b, h) + aoff + m * 2048 + k * 1024); } } } while (0)
#define FG_LDB(dst, b, h) do { _Pragma("unroll") for (int n = 0; n < 2; ++n) { if constexpr (G::FP8) { \
        const i32x4 lo_ = *(const LAS i32x4*)(lds + FG_SB(b, h) + boff + n * 2048), hi_ = *(const LAS i32x4*)(lds + FG_SB(b, h) + boff + n * 2048 + 1024); dst##8[n] = __builtin_shufflevector(lo_, hi_, 0, 1, 2, 3, 4, 5, 6, 7); } \
        else { _Pragma("unroll") for (int k = 0; k < 2; ++k) dst[n][k] = *(const LAS bf16x8*)(lds + FG_SB(b, h) + boff + n * 2048 + k * 1024); } } } while (0)
#define FG_MMA(ai, bj, At, Bt) do { __builtin_amdgcn_s_setprio(1); _Pragma("unroll") for (int m = 0; m < 4; ++m) _Pragma("unroll") for (int n = 0; n < 2; ++n) { \
        if constexpr (G::FP8) {   \
            acc[ai][bj][m][n] = __builtin_amdgcn_mfma_scale_f32_16x16x128_f8f6f4(Bt##8[n], At##8[m], acc[ai][bj][m][n], 0, 0, 0, G::SCALE_W, 0, 0x7F7F7F7F); \
        } else { _Pragma("unroll") for (int k = 0; k < 2; ++k) acc[ai][bj][m][n] = __builtin_amdgcn_mfma_f32_16x16x32_bf16(Bt[n][k], At[m][k], acc[ai][bj][m][n], 0, 0, 0); } } \
        if constexpr (G::FP8) asm volatile("" : "+v"(acc[ai][bj][0][0]), "+v"(acc[ai][bj][0][1]), "+v"(acc[ai][bj][1][0]), "+v"(acc[ai][bj][1][1]), "+v"(acc[ai][bj][2][0]), "+v"(acc[ai][bj][2][1]), "+v"(acc[ai][bj][3][0]), "+v"(acc[ai][bj][3][1]));     \
        __builtin_amdgcn_s_setprio(0); } while (0)
#define FG_WAIT_V(n) asm volatile("s_waitcnt vmcnt(" #n ")" ::: "memory")
#define FG_WAIT_L(n) asm volatile("s_waitcnt lgkmcnt(" #n ")" ::: "memory")
#define FG_BAR __builtin_amdgcn_s_barrier()
#define FG_SCHED __builtin_amdgcn_sched_barrier(0)
#define FG_SCHED8 do { if constexpr (G::FP8) __builtin_amdgcn_sched_barrier(0); } while (0)
#define FG_SETCTX(U_) do { xA = g.abase(U_); xB = g.bbase(U_); const int _K = g.K(U_); \
        oA[0][0] = g.arow_off(U_, R0) + (unsigned)C0 * 2u; oA[0][1] = g.arow_off(U_, R1) + (unsigned)C1 * 2u; \
        if (G::GATHER) { oA[1][0] = g.arow_off(U_, 128 + R0) + (unsigned)C0 * 2u; oA[1][1] = g.arow_off(U_, 128 + R1) + (unsigned)C1 * 2u; } else hstepA = (size_t)128 * _K * 2; \
        oB[0] = (unsigned)(R0 * _K + C0) * 2u; oB[1] = (unsigned)(R1 * _K + C1) * 2u; hstepB = (size_t)128 * _K * 2; } while (0)
    typename G::U cur, nxt; int ui = 0;
    if (!g.sched(0, bid, nblk, cur)) return;
    f32x4 acc[2][2][4][2];
#pragma unroll
    for (int a = 0; a < 2; ++a)
#pragma unroll
        for (int b = 0; b < 2; ++b)
#pragma unroll
            for (int m = 0; m < 4; ++m)
#pragma unroll
                for (int n = 0; n < 2; ++n) acc[a][b][m][n] = (f32x4){0.f, 0.f, 0.f, 0.f};
    bf16x8 At[4][2], B0[2][2], B1[2][2]; i32x8 At8[4], B08[2], B18[2];
    const char* xA; const char* xB; unsigned oA[2][2], oB[2]; size_t hstepB, hstepA = 0;
    FG_SETCTX(cur);
    int nt = g.K(cur) / 64;
    FG_STAGE_B(FG_SB(0, 0), 0, 0); FG_STAGE_A(FG_SA(0, 0), 0, 0); FG_STAGE_B(FG_SB(0, 1), 1, 0); FG_STAGE_A(FG_SA(0, 1), 1, 0);
    if (wr == 1) FG_BAR;
    FG_WAIT_V(4); FG_BAR;
    FG_STAGE_B(FG_SB(1, 0), 0, 1); FG_STAGE_A(FG_SA(1, 0), 0, 1); FG_STAGE_B(FG_SB(1, 1), 1, 1);
    FG_WAIT_V(6); FG_BAR;
    for (;;) {
        const bool has_next = g.sched(ui + 1, bid, nblk, nxt);
        unsigned oAn[2][2] = {{0u, 0u}, {0u, 0u}};
        if constexpr (G::GATHER) { if (has_next) { oAn[0][0] = g.arow_off(nxt, R0) + (unsigned)C0 * 2u; oAn[0][1] = g.arow_off(nxt, R1) + (unsigned)C1 * 2u; oAn[1][0] = g.arow_off(nxt, 128 + R0) + (unsigned)C0 * 2u; oAn[1][1] = g.arow_off(nxt, 128 + R1) + (unsigned)C1 * 2u; } }
        for (int t = 0; t < nt; t += 2) {
            const bool last = (t == nt - 2);
            FG_LDB(B0, 0, 0); FG_SCHED; FG_LDA(At, 0, 0); FG_STAGE_A(FG_SA(1, 1), 1, t + 1);
            FG_WAIT_L(8); FG_BAR; FG_WAIT_L(0); FG_SCHED8; FG_MMA(0, 0, At, B0); FG_BAR; FG_SCHED;
            int t2 = t + 2;
            if (last) { t2 = 0; if (has_next) { if constexpr (G::GATHER) { xA = g.abase(nxt); xB = g.bbase(nxt); const int _K = g.K(nxt); oA[0][0] = oAn[0][0]; oA[0][1] = oAn[0][1]; oA[1][0] = oAn[1][0]; oA[1][1] = oAn[1][1];
                        oB[0] = (unsigned)(R0 * _K + C0) * 2u; oB[1] = (unsigned)(R1 * _K + C1) * 2u; hstepB = (size_t)128 * _K * 2; } else { FG_SETCTX(nxt); } } }
            FG_LDB(B1, 0, 1); FG_STAGE_B(FG_SB(0, 0), 0, t2);
            FG_BAR; FG_WAIT_L(0); FG_SCHED8; FG_MMA(0, 1, At, B1); FG_BAR; FG_SCHED8;
            FG_LDA(At, 0, 1); FG_STAGE_A(FG_SA(0, 0), 0, t2);
            FG_BAR; FG_WAIT_L(0); FG_SCHED8; FG_MMA(1, 0, At, B0); FG_BAR; FG_SCHED;
            FG_STAGE_B(FG_SB(0, 1), 1, t2);
            FG_WAIT_V(6); FG_BAR; FG_SCHED8; FG_MMA(1, 1, At, B1); FG_BAR; FG_SCHED8;
            FG_LDB(B0, 1, 0); FG_SCHED; FG_LDA(At, 1, 0); FG_STAGE_A(FG_SA(0, 1), 1, t2);
            FG_WAIT_L(8); FG_BAR; FG_WAIT_L(0); FG_SCHED8; FG_MMA(0, 0, At, B0); FG_BAR; FG_SCHED;
            FG_LDB(B1, 1, 1); FG_STAGE_B(FG_SB(1, 0), 0, t2 + 1);
            FG_BAR; FG_WAIT_L(0); FG_SCHED8; FG_MMA(0, 1, At, B1); FG_BAR; FG_SCHED8;
            FG_LDA(At, 1, 1); FG_STAGE_A(FG_SA(1, 0), 0, t2 + 1);
            FG_BAR; FG_WAIT_L(0); FG_SCHED8; FG_MMA(1, 0, At, B0); FG_BAR; FG_SCHED;
            FG_STAGE_B(FG_SB(1, 1), 1, t2 + 1);
            FG_WAIT_V(6); FG_BAR; FG_SCHED8; FG_MMA(1, 1, At, B1); FG_BAR; FG_SCHED8;
        }
        const int te_ = tid_();
        const int rbase_ = 64 * ((te_ >> 8) & 1) + (te_ & 15), cb_ = 32 * ((te_ >> 6) & 3) + 4 * ((te_ >> 4) & 3);
#pragma unroll
        for (int bt = 0; bt < 8 / G::EPI_FENCE; ++bt) {
            typename G::Pre pre[G::EPI_FENCE];
#pragma unroll
            for (int q = 0; q < G::EPI_FENCE; ++q) { const int rw = bt * G::EPI_FENCE + q, ai = rw >> 2, m = rw & 3; g.pre(cur, rbase_ + 128 * ai + 16 * m, cb_, pre[q]); }
#pragma unroll
            for (int q = 0; q < G::EPI_FENCE; ++q) { const int rw = bt * G::EPI_FENCE + q, ai = rw >> 2, m = rw & 3;
                g.epi4(cur, rbase_ + 128 * ai + 16 * m, cb_, acc[ai][0][m][0], acc[ai][0][m][1], acc[ai][1][m][0], acc[ai][1][m][1], pre[q]); }
            asm volatile("" ::: "memory");
        }
        if (!has_next) break;
#pragma unroll
        for (int a = 0; a < 2; ++a)
#pragma unroll
            for (int b = 0; b < 2; ++b)
#pragma unroll
                for (int m = 0; m < 4; ++m)
#pragma unroll
                    for (int n = 0; n < 2; ++n) acc[a][b][m][n] = (f32x4){0.f, 0.f, 0.f, 0.f};
        cur = nxt; nt = g.K(cur) / 64; ++ui;
    }
    FG_WAIT_V(0);
    if (wr == 0) FG_BAR;
    FG_BAR;
#undef FG_SA
#undef FG_SB
#undef FG_GLDS
#undef FG_STAGE_A
#undef FG_STAGE_B
#undef FG_LDA
#undef FG_LDB
#undef FG_MMA
#undef FG_WAIT_V
#undef FG_WAIT_L
#undef FG_BAR
#undef FG_SCHED
#undef FG_SCHED8
#undef FG_SETCTX
}

DEVI bool tile_order(int i, int bid, int nblk, int nM, int nN, int& pm, int& pn) {
    const int nwg = nM * nN; const long L = (long)i * nblk + bid; if (L >= nwg) return false;
    int wgid = (int)L; { const int q = nwg / 8, r = nwg % 8, xcd = wgid % 8, off = wgid / 8; wgid = (xcd < r ? xcd * (q + 1) : r * (q + 1) + (xcd - r) * q) + off; }
    const int nig = 8 * nN, gid = wgid / nig, fm = gid * 8, gsz = (nM - fm) < 8 ? (nM - fm) : 8;
    pm = fm + ((wgid % nig) % gsz); pn = (wgid % nig) / gsz; return true;
}
DEVI int xcd_contig(int i, int bid, int nblk, int nwg) {
    const long L = (long)i * nblk + bid; if (L >= nwg) return -1;
    return ((int)L % 8) * (nwg / 8) + (int)L / 8;
}
struct NoPre {};
DEVI int col8(int cb) { return (cb & ~31) + 2 * (cb & 31); }
DEVI void store8bf(bf16_t* o, f32x4 a, f32x4 b) { u32x4 w; w.x = pk2(a.x, a.y); w.y = pk2(a.z, a.w); w.z = pk2(b.x, b.y); w.w = pk2(b.z, b.w); gst16(o, w); }
DEVI void unpack8bf(u32x4 w, f32x4& a, f32x4& b) { a = (f32x4){bflo(w.x), bfhi(w.x), bflo(w.y), bfhi(w.y)}; b = (f32x4){bflo(w.z), bfhi(w.z), bflo(w.w), bfhi(w.w)}; }
DEVI f32x4 gelu4(f32x4 v) { return (f32x4){gelu_tanh(v.x), gelu_tanh(v.y), gelu_tanh(v.z), gelu_tanh(v.w)}; }
DEVI f32x4 sigm4(f32x4 v) { return (f32x4){sigm(v.x), sigm(v.y), sigm(v.z), sigm(v.w)}; }

struct G1 {
    static constexpr bool FP8 = false; static constexpr int SCALE_W = 0;
    static constexpr int EPI_FENCE = 8;
    static constexpr bool GATHER = false;
    const bf16_t* A; const bf16_t* Bt; bf16_t *zrnn, *zgelu, *zq, *zkvr, *g;
    struct U { int pm, pn; };
    DEVI bool sched(int i, int bid, int nblk, U& r) const {
        if (tile_order(i, bid, nblk, 128, 10, r.pm, r.pn)) return true;
        const int v = i * nblk + bid - 1280; if (v >= 40) return false;
        const int j = v % 5; r.pm = 128 + v / 5; r.pn = j < 4 ? j : 9; return true; }
    DEVI int K(const U&) const { return 1024; }
    DEVI const char* abase(const U& u) const { return (const char*)(A + (size_t)u.pm * 256 * 1024); }
    DEVI unsigned arow_off(const U&, int r) const { return (unsigned)r * 2048u; }
    DEVI const char* bbase(const U& u) const { return (const char*)(Bt + (size_t)u.pn * 256 * 1024); }
    typedef NoPre Pre;
    DEVI void pre(const U&, int, int, Pre&) const {}
    DEVI void epi4(const U& u, int r, int cb, f32x4 a, f32x4 b, f32x4 c, f32x4 d, const Pre&) const { const int c8 = col8(cb); epi8(u, r, c8, a, b); epi8(u, r, 128 + c8, c, d); }
    DEVI void epi8(const U& u, int r, int c, f32x4 v0, f32x4 v1) const {
        const size_t row = (size_t)u.pm * 256 + r;
        if (u.pn < 4) store8bf(zrnn + row * 1024 + u.pn * 256 + c, v0, v1);
        else if (u.pn < 8) store8bf(zgelu + row * 1024 + (u.pn - 4) * 256 + c, gelu4(v0), gelu4(v1));
        else if (u.pn == 8) store8bf(zq + row * 256 + c, v0, v1);
        else if (u.pn == 9) store8bf(zkvr + row * 256 + c, v0, v1);
        else store8bf(g + row * 2048 + (u.pn - 10) * 256 + c, sigm4(v0), sigm4(v1));
    }
};

struct G1g {
    static constexpr bool FP8 = true; static constexpr int SCALE_W = W8_MXS;
    static constexpr int EPI_FENCE = 8;
    static constexpr bool GATHER = false;
    const unsigned char *A8, *W8; bf16_t* g;
    struct U { int pm, pn; };
    DEVI bool sched(int i, int bid, int nblk, U& r) const { return tile_order(i, bid, nblk, 128, 8, r.pm, r.pn); }
    DEVI int K(const U&) const { return 512; }
    DEVI const char* abase(const U& u) const { return (const char*)(A8 + (size_t)u.pm * 256 * 1024); }
    DEVI unsigned arow_off(const U&, int r) const { return (unsigned)r * 1024u; }
    DEVI const char* bbase(const U& u) const { return (const char*)(W8 + (size_t)u.pn * 256 * 1024); }
    typedef NoPre Pre;
    DEVI void pre(const U&, int, int, Pre&) const {}
    DEVI void epi4(const U& u, int r, int cb, f32x4 a, f32x4 b, f32x4 c, f32x4 d, const Pre&) const {
        bf16_t* o = g + ((size_t)u.pm * 256 + r) * 2048 + u.pn * 256 + col8(cb);
        store8bf(o, sigm4(a), sigm4(b)); store8bf(o + 128, sigm4(c), sigm4(d));
    }
};

struct G2 {
    static constexpr bool FP8 = false; static constexpr int SCALE_W = 0;
    static constexpr int EPI_FENCE = 4;
    static constexpr bool GATHER = false;
    const bf16_t *rnn, *attn, *WrT, *WmT, *g; bf16_t* merged;
    struct U { int pm, pn, sub; };
    DEVI bool sched(int i, int bid, int nblk, U& r) const { r.sub = i & 1; return tile_order(i >> 1, bid, nblk, 128, 4, r.pm, r.pn); }
    DEVI int K(const U& u) const { return u.sub ? 512 : 1024; }
    DEVI const char* abase(const U& u) const { return u.sub ? (const char*)(attn + (size_t)u.pm * 256 * 512) : (const char*)(rnn + (size_t)u.pm * 256 * 1024); }
    DEVI unsigned arow_off(const U& u, int r) const { return (unsigned)r * (u.sub ? 1024u : 2048u); }
    DEVI const char* bbase(const U& u) const { return u.sub ? (const char*)(WmT + (size_t)u.pn * 256 * 512) : (const char*)(WrT + (size_t)u.pn * 256 * 1024); }
    struct Pre { u32x4 g[2], m[2]; };
    DEVI void pre(const U& u, int r, int cb, Pre& q) const {
        const size_t row = (size_t)u.pm * 256 + r; const int col = u.pn * 256 + col8(cb);
        q.g[0] = gld16(g + row * 2048 + u.sub * 1024 + col); q.g[1] = gld16(g + row * 2048 + u.sub * 1024 + col + 128);
        if (u.sub) { q.m[0] = gld16(merged + row * 1024 + col); q.m[1] = gld16(merged + row * 1024 + col + 128); }
    }
    DEVI void epi4(const U& u, int r, int cb, f32x4 a, f32x4 b, f32x4 c, f32x4 d, const Pre& q) const {
        const size_t row = (size_t)u.pm * 256 + r; const int col = u.pn * 256 + col8(cb);
        bf16_t* o = merged + row * 1024 + col;
        f32x4 g0, g1, h0, h1; unpack8bf(q.g[0], g0, g1); unpack8bf(q.g[1], h0, h1);
        f32x4 r0 = g0 * a, r1 = g1 * b, r2 = h0 * c, r3 = h1 * d;
        if (u.sub) { f32x4 p0, p1, p2, p3; unpack8bf(q.m[0], p0, p1); unpack8bf(q.m[1], p2, p3); r0 += p0; r1 += p1; r2 += p2; r3 += p3; }
        store8bf(o, r0, r1); store8bf(o + 128, r2, r3);
    }
};

struct G3 {
    static constexpr bool FP8 = false; static constexpr int SCALE_W = 0;
    static constexpr int EPI_FENCE = 4;
    static constexpr bool GATHER = false;
    const bf16_t *A, *Bt; const float *x, *mod; float* out;
    struct U { int pm, pn; };
    DEVI bool sched(int i, int bid, int nblk, U& r) const { return tile_order(i, bid, nblk, 128, 4, r.pm, r.pn); }
    DEVI int K(const U&) const { return 1024; }
    DEVI const char* abase(const U& u) const { return (const char*)(A + (size_t)u.pm * 256 * 1024); }
    DEVI unsigned arow_off(const U&, int r) const { return (unsigned)r * 2048u; }
    DEVI const char* bbase(const U& u) const { return (const char*)(Bt + (size_t)u.pn * 256 * 1024); }
    struct Pre { f32x4 x[4]; };
    DEVI void pre(const U& u, int r, int cb, Pre& q) const {
        const float* xp = x + ((size_t)u.pm * 256 + r) * 1024 + u.pn * 256 + col8(cb);
        q.x[0] = gldf4(xp); q.x[1] = gldf4(xp + 4); q.x[2] = gldf4(xp + 128); q.x[3] = gldf4(xp + 132);
    }
    DEVI void epi4(const U& u, int r, int cb, f32x4 a, f32x4 b, f32x4 c, f32x4 d, const Pre& q) const {
        const size_t row = (size_t)u.pm * 256 + r; const int col = u.pn * 256 + col8(cb);
        const float* mp = mod + (u.pm >> 4) * 6144 + 2048 + col; float* o = out + row * 1024 + col;
        gstf4(o, q.x[0] + gldf4(mp) * a); gstf4(o + 4, q.x[1] + gldf4(mp + 4) * b);
        gstf4(o + 128, q.x[2] + gldf4(mp + 128) * c); gstf4(o + 132, q.x[3] + gldf4(mp + 132) * d);
    }
};

struct GM1 {
    static constexpr int EPI_FENCE = 8;
    static constexpr bool GATHER = true;
    static constexpr bool FP8 = true; static constexpr int SCALE_W = W8_MXS;
    const unsigned char *h8, *Wgu8; const int* idx; unsigned char* hid8;
    struct U { int be, pm, pn; };
    DEVI bool sched(int i, int bid, int nblk, U& r) const { const int w = xcd_contig(i, bid, nblk, 128 * 16); if (w < 0) return false;
        const int pair = w >> 4, e = pair >> 3, b = pair & 7; r.be = b * 16 + e; r.pm = w & 1; r.pn = (w >> 1) & 7; return true; }
    DEVI int K(const U&) const { return 512; }
    DEVI const char* abase(const U& u) const { return (const char*)(h8 + (size_t)(u.be >> 4) * 4096 * 1024); }
    DEVI unsigned arow_off(const U& u, int r) const { return (unsigned)idx[u.be * 512 + u.pm * 256 + r] * 1024u; }
    DEVI const char* bbase(const U& u) const { return (const char*)(Wgu8 + wgu_off(u.be & 15) + (size_t)u.pn * 256 * 1024); }
    typedef NoPre Pre;
    DEVI void pre(const U&, int, int, Pre&) const {}
    DEVI void epi4(const U& u, int r, int cb, f32x4 g0, f32x4 u0, f32x4 g1, f32x4 u1, const Pre&) const {
        const int hidx = u.pn * 128 + (cb & ~31) + 2 * (cb & 31);
        u32x2 w; w.x = pk4f8(g0 * sigm4(g0) * u0); w.y = pk4f8(g1 * sigm4(g1) * u1);
        gst8(hid8 + ((size_t)u.be * 512 + u.pm * 256 + r) * 1024 + hidx, w);
    }
};

struct GM2 {
    static constexpr int EPI_FENCE = 8;
    static constexpr bool GATHER = false;
    static constexpr bool FP8 = true; static constexpr int SCALE_W = W8_MXS;
    const unsigned char *hid8, *Wd8; const float* gate; bf16_t* Y;
    struct U { int be, pm, pn; };
    DEVI bool sched(int i, int bid, int nblk, U& r) const { const int w = xcd_contig(i, bid, nblk, 128 * 8); if (w < 0) return false;
        const int pair = w >> 3, e = pair >> 3, b = pair & 7; r.be = b * 16 + e; r.pm = w & 1; r.pn = (w >> 1) & 3; return true; }
    DEVI int K(const U&) const { return 512; }
    DEVI const char* abase(const U& u) const { return (const char*)(hid8 + ((size_t)u.be * 512 + u.pm * 256) * 1024); }
    DEVI unsigned arow_off(const U&, int r) const { return (unsigned)r * 1024u; }
    DEVI const char* bbase(const U& u) const { return (const char*)(Wd8 + ((size_t)(u.be & 15) * 1024 + u.pn * 256) * 1024); }
    struct Pre { float gt; };
    DEVI void pre(const U& u, int r, int, Pre& q) const { q.gt = gldf(gate + (size_t)u.be * 512 + u.pm * 256 + r); }
    DEVI void epi4(const U& u, int r, int cb, f32x4 a, f32x4 b, f32x4 c, f32x4 d, const Pre& q) const {
        bf16_t* o = Y + ((size_t)u.be * 512 + u.pm * 256 + r) * 1024 + u.pn * 256 + col8(cb);
        store8bf(o, a * q.gt, b * q.gt); store8bf(o + 128, c * q.gt, d * q.gt);
    }
};

DEVI float dot4(f32x4 a) { return a.x * a.x + a.y * a.y + a.z * a.z + a.w * a.w; }
struct GP4 {
    static constexpr bool FP8 = false; static constexpr int SCALE_W = 0;
    static constexpr int EPI_FENCE = 4;
    static constexpr bool GATHER = false;
    unsigned char* ws; const LAS float* cst;
    struct U { int type, pm, pn; };
    DEVI bool sched(int i, int bid, int nblk, U& r) const {
        const int u = i * nblk + bid;
        if (u < 384) { r.type = 0; r.pm = u / 3; r.pn = u % 3; return true; }
        if (u < 656) { const int v = u - 384; r.type = 1; r.pm = v >> 1; r.pn = v & 1; return true; }
        if (u < 928) { const int v = u - 656; r.type = 2; r.pm = v & 1; r.pn = v >> 1; return true; }
        return false; }
    DEVI int K(const U&) const { return 256; }
    DEVI const char* abase(const U& u) const { const size_t o = u.type == 0 ? WS_ZQ : (u.type == 1 ? WS_ZKVR : WS_WUV); return (const char*)ws + o + (size_t)u.pm * 256 * 512; }
    DEVI unsigned arow_off(const U&, int r) const { return (unsigned)r * 512u; }
    DEVI const char* bbase(const U& u) const { const size_t o = u.type == 0 ? WS_WUQ : (u.type == 1 ? WS_WUK : WS_ZKVR); return (const char*)ws + o + (size_t)u.pn * 256 * 512; }
    typedef NoPre Pre;
    DEVI void pre(const U&, int, int, Pre&) const {}
    DEVI void epi4(const U& u, int r, int cb, f32x4 v00, f32x4 v01, f32x4 v10, f32x4 v11, const Pre&) const {
        const int wc = cb >> 5, f4 = cb & 31;
        const LAS float* gqn = cst; const LAS float* gkn = cst + 64; const LAS float* gqr = cst + 128; const LAS float* rope = cst + 160;
        bf16_t* Q = (bf16_t*)(ws + WS_A); bf16_t* Kb = (bf16_t*)(ws + WS_K); bf16_t* VT = (bf16_t*)(ws + WS_VT);
        if (u.type == 2) {
            const int dv = u.pm * 256 + r, head = dv >> 6, d = dv & 63;
            int b, key0; size_t m0;
            if (u.pn < 128) { b = u.pn >> 4; key0 = CTXL + (u.pn & 15) * 256; m0 = (size_t)u.pn * 256; } else { b = u.pn - 128; key0 = 0; m0 = (size_t)u.pn * 256; }
            const int cbp = (cb & ~12) | ((cb & 4) << 1) | ((cb & 8) >> 1);
            bf16_t* vo = VT + ((size_t)(b * 8 + head) * 64 + d) * NKEY + key0 + cbp; (void)m0;
            store4bf(vo, v00); store4bf(vo + 16, v01); store4bf(vo + 128, v10); store4bf(vo + 144, v11);
            return;
        }
        const size_t m = (size_t)u.pm * 256 + r;
        if (u.type == 1) {
            float ss = dot4(v00) + dot4(v01) + dot4(v10) + dot4(v11); ss += swz_xor<16>(ss); ss = xor32_sum(ss);
            const float sc = rsqrtf(ss * (1.f / 64.f) + EPS);
            int b, key; if (u.pm < 128) { b = u.pm >> 4; key = CTXL + (int)(m & 4095); } else { b = u.pm - 128; key = r; }
            bf16_t* ko = Kb + ((size_t)(b * 8 + u.pn * 4 + wc) * NKEY + key) * 96 + f4; const LAS float* gp = gkn + f4;
            store4bf(ko, v00 * sc * *(const LAS f32x4*)gp); store4bf(ko + 16, v01 * sc * *(const LAS f32x4*)(gp + 16));
            store4bf(ko + 32, v10 * sc * *(const LAS f32x4*)(gp + 32)); store4bf(ko + 48, v11 * sc * *(const LAS f32x4*)(gp + 48));
            return;
        }
        const int b = (int)(m >> 12), t = (int)(m & 4095);
        if (u.pn < 2) {
            float ss = dot4(v00) + dot4(v01) + dot4(v10) + dot4(v11); ss += swz_xor<16>(ss); ss = xor32_sum(ss);
            const float sc = rsqrtf(ss * (1.f / 64.f) + EPS) * QSCALE;
            bf16_t* qo = Q + ((size_t)(b * 8 + u.pn * 4 + wc) * SEQ + t) * 96 + f4; const LAS float* gp = gqn + f4;
            store4bf(qo, v00 * sc * *(const LAS f32x4*)gp); store4bf(qo + 16, v01 * sc * *(const LAS f32x4*)(gp + 16));
            store4bf(qo + 32, v10 * sc * *(const LAS f32x4*)(gp + 32)); store4bf(qo + 48, v11 * sc * *(const LAS f32x4*)(gp + 48));
        } else {
            const int pos = f4 < 8 ? (t >> 6) : (t & 63); const LAS float* rp = rope + (pos * 8 + (f4 & 7)) * 2;
            const f32x4 c0 = *(const LAS f32x4*)rp, c1 = *(const LAS f32x4*)(rp + 4);
            const f32x4 cs = {c0.x, c0.z, c1.x, c1.z}, sn = {c0.y, c0.w, c1.y, c1.w};
            const f32x4 g1 = *(const LAS f32x4*)(gqr + f4), g2 = *(const LAS f32x4*)(gqr + 16 + f4);
            float s0 = dot4(v00) + dot4(v01), s1 = dot4(v10) + dot4(v11);
            s0 += swz_xor<16>(s0); s0 = xor32_sum(s0); s1 += swz_xor<16>(s1); s1 = xor32_sum(s1);
            const float sc0 = rsqrtf(s0 * (1.f / 32.f) + EPS) * QSCALE, sc1 = rsqrtf(s1 * (1.f / 32.f) + EPS) * QSCALE;
            { const f32x4 y1 = v00 * sc0 * g1, y2 = v01 * sc0 * g2; bf16_t* qo = Q + ((size_t)(b * 8 + wc) * SEQ + t) * 96 + 64 + f4;
              store4bf(qo, y1 * cs - y2 * sn); store4bf(qo + 16, y1 * sn + y2 * cs); }
            { const f32x4 y1 = v10 * sc1 * g1, y2 = v11 * sc1 * g2; bf16_t* qo = Q + ((size_t)(b * 8 + 4 + wc) * SEQ + t) * 96 + 64 + f4;
              store4bf(qo, y1 * cs - y2 * sn); store4bf(qo + 16, y1 * sn + y2 * cs); }
        }
    }
};


constexpr int RNN_XB = 32 * 272;
constexpr int RNN_HOFF = 4 * RNN_XB + 2048;
DEVI void phase_rnn_carry(const P& p, int bid, int nblk) {
    float* S = (float*)(p.ws + WS_RNNSUM);
    for (int id = bid * NTHR + tid_(); id < NB * 2 * 1024; id += nblk * NTHR) {
        const int ch = id & 1023, dir = (id >> 10) & 1, b = id >> 11;
        float* sp = S + ((size_t)(b * 2 + dir) * 34) * 2048 + ch;
        float A[34], B[34];
#pragma unroll
        for (int c = 0; c < 34; ++c) { A[c] = sp[c * 2048]; B[c] = sp[c * 2048 + 1024]; }
        float h = 0.f;
        if (dir == 0) {
#pragma unroll
            for (int k = 0; k < 34; ++k) { sp[k * 2048 + 1024] = h; h = fmaf(A[k], h, B[k]); }
        } else {
#pragma unroll
            for (int k = 0; k < 34; ++k) { const int c = k < 2 ? 1 - k : 35 - k; sp[c * 2048 + 1024] = h; h = fmaf(A[c], h, B[c]); }
        }
    }
}

DEVI void convert_tail(const P& p, int qidx, int e0, int e1, LAS unsigned char* lds) {
    const int tid = tid_(), lane = tid & 63, wave = tid >> 6;
    unsigned* cq = (unsigned*)(p.ws + WS_CTL) + 8192 + qidx * 64;
    volatile LAS unsigned* qs = (volatile LAS unsigned*)(lds + MISC_OFF) + 24;
    float* scr = (float*)(unsigned char*)lds + wave * (64 * 33);
    const int ne = e1 - e0, nbi = 2 * ne * 512 / 8;
    for (;;) {
        __syncthreads();
        if (tid == 0) qs[0] = __hip_atomic_fetch_add(cq, 1u, __ATOMIC_RELAXED, __HIP_MEMORY_SCOPE_AGENT);
        __syncthreads();
        const int bi = (int)qs[0];
        if (bi >= nbi) break;
        const int it = bi * 8 + wave, which = it / (ne * 512), r = it % (ne * 512), e = e0 + r / 512, t = r % 512, k0 = 64 * (t / 32), n0 = 32 * (t % 32);
        if (which == 0) transpose_item8(p.w_e_gate + (size_t)e * 1048576, 1024, 1024, p.ws + wgu_off(e), RmGU{0}, scr, k0, n0, lane);
        else transpose_item8(p.w_e_up + (size_t)e * 1048576, 1024, 1024, p.ws + wgu_off(e), RmGU{1}, scr, k0, n0, lane);
    }
    __syncthreads();
}

template <bool APPLY>
DEVI void phase_rnn(const P& p, int bid, int nblk, LAS unsigned char* lds) {
    const int tid = tid_(), wid = __builtin_amdgcn_readfirstlane(tid >> 6), lane = tid & 63, r = lane & 31, hh = lane >> 5;
    const int dir = wid >> 2, cg = wid & 3;
    const int n = bid & 7, bl = bid >> 3, nbl = (nblk - n + 7) >> 3;
    const bf16_t* z = (const bf16_t*)(p.ws + WS_ZRNN); float* S = (float*)(p.ws + WS_RNNSUM); bf16_t* gl = (bf16_t*)(p.ws + WS_GELU);
    const int ch = n * 128 + cg * 32 + r;
    bf16x8 wfa[8], wfx[8];
    { const bf16_t* wa = (const bf16_t*)(p.ws + WS_WRG) + ((size_t)((0 * 2 + dir) * 8 + n) * 128 + cg * 32 + r) * 128 + hh * 8;
      const bf16_t* wx = (const bf16_t*)(p.ws + WS_WRG) + ((size_t)((1 * 2 + dir) * 8 + n) * 128 + cg * 32 + r) * 128 + hh * 8;
#pragma unroll
      for (int ks = 0; ks < 8; ++ks) { wfa[ks] = *(const bf16x8*)(wa + ks * 16); wfx[ks] = *(const bf16x8*)(wx + ks * 16); } }
    const float eba = __builtin_amdgcn_exp2f(-1.4426950408889634f * p.rg_ba[dir * 1024 + ch]), ebx = __builtin_amdgcn_exp2f(-1.4426950408889634f * p.rg_bx[dir * 1024 + ch]), sp2 = ((const float*)(p.ws + WS_SP))[dir * 1024 + ch] * 1.4426950408889634f;
    const int t8 = tid & 255, c4 = t8 & 31, rgp = t8 >> 5, cch = n * 128 + c4 * 4;
    const f32x4 cw0 = *(const f32x4*)(p.conv_w + cch), cw1 = *(const f32x4*)(p.conv_w + 1024 + cch), cw2 = *(const f32x4*)(p.conv_w + 2048 + cch), cw3 = *(const f32x4*)(p.conv_w + 3072 + cch);
    const f32x4 cb = *(const f32x4*)(p.conv_b + cch);
    const int nitems = APPLY ? NB * 32 : NB * 34;
#define RNN_COORDS(li_, b_, c_, pos0_, len_, m0_) do { if (APPLY) { b_ = (li_) >> 5; c_ = 2 + ((li_) & 31); } else { b_ = (li_) / 34; c_ = (li_) % 34; } \
        if (c_ < 2) { pos0_ = c_ * 128; len_ = CTXL; m0_ = (size_t)NLAT + b_ * CTXL + pos0_; } else { pos0_ = (c_ - 2) * 128; len_ = SEQ; m0_ = (size_t)b_ * SEQ + pos0_; } } while (0)
#define RNN_LOADZ(pos0_, len_, m0_, st_) do { const int row0_ = (st_) * 32 + rgp * 4; _Pragma("unroll") for (int i = 0; i < 7; ++i) { const int pos_ = pos0_ + row0_ - 2 + i; zp[i] = (u32x2){0u, 0u}; \
        if (pos_ >= 0 && pos_ < len_) zp[i] = *(const u32x2*)(z + (m0_ + row0_ + i - 2) * 1024 + cch); } } while (0)
    u32x2 zp[7]; float hnext = 0.f;
    (void)bl; (void)nbl;
    unsigned* qhead = (unsigned*)(p.ws + WS_CTL) + 8192 + ((APPLY ? 8 : 0) + n) * 64;
    volatile LAS unsigned* qs = (volatile LAS unsigned*)(lds + MISC_OFF) + 24;
    if (tid == 0) { qs[0] = __hip_atomic_fetch_add(qhead, 1u, __ATOMIC_RELAXED, __HIP_MEMORY_SCOPE_AGENT); qs[1] = __hip_atomic_fetch_add(qhead, 1u, __ATOMIC_RELAXED, __HIP_MEMORY_SCOPE_AGENT); }
    __syncthreads();
    int li = (int)qs[0], lin = (int)qs[1], par = 0;
    if (li < nitems) { int b, c, pos0, len; size_t m0; RNN_COORDS(li, b, c, pos0, len, m0); RNN_LOADZ(pos0, len, m0, (dir ? 3 : 0));
        if (APPLY) hnext = S[((size_t)((b * 2 + dir) * 34 + c)) * 2048 + ch + 1024]; }
    for (; li < nitems; ) {
        unsigned drawn = 0u; if (tid == 0) drawn = __hip_atomic_fetch_add(qhead, 1u, __ATOMIC_RELAXED, __HIP_MEMORY_SCOPE_AGENT);
        int b, c, pos0, len; size_t m0; RNN_COORDS(li, b, c, pos0, len, m0);
        float* sp = S + ((size_t)((b * 2 + dir) * 34 + c)) * 2048 + ch;
        float h = APPLY ? hnext : 0.f, Ap = 1.f;
        for (int s = 0; s < 4; ++s) {
            const int st = dir ? 3 - s : s;
            LAS unsigned char* xb = lds + (dir * 2 + (s & 1)) * RNN_XB;
            {
                f32x4 zr[7];
#pragma unroll
                for (int i = 0; i < 7; ++i) zr[i] = (f32x4){bflo(zp[i].x), bfhi(zp[i].x), bflo(zp[i].y), bfhi(zp[i].y)};
#pragma unroll
                for (int o = 0; o < 4; ++o) { const f32x4 v = cb + cw0 * zr[o] + cw1 * zr[o + 1] + cw2 * zr[o + 2] + cw3 * zr[o + 3];
                    u32x2 w; w.x = pk2(v.x, v.y); w.y = pk2(v.z, v.w); *(LAS u32x2*)(xb + (rgp * 4 + o) * 272 + c4 * 8) = w; }
                if (s < 3) { RNN_LOADZ(pos0, len, m0, (dir ? 2 - s : s + 1)); }
                else if (lin < nitems) { int nb_, nc_, npos0, nlen; size_t nm0; RNN_COORDS(lin, nb_, nc_, npos0, nlen, nm0); RNN_LOADZ(npos0, nlen, nm0, (dir ? 3 : 0));
                    if (APPLY) hnext = S[((size_t)((nb_ * 2 + dir) * 34 + nc_)) * 2048 + ch + 1024]; }
            }
            if (s == 1 && tid == 0) qs[2 + par] = drawn;
            __syncthreads();
            f32x16 ar, ai;
            {   const f32x16 z16 = {0.f, 0.f, 0.f, 0.f, 0.f, 0.f, 0.f, 0.f, 0.f, 0.f, 0.f, 0.f, 0.f, 0.f, 0.f, 0.f};
                const bf16x8 af0 = *(const LAS bf16x8*)(xb + r * 272 + hh * 16);
                ar = __builtin_amdgcn_mfma_f32_32x32x16_bf16(af0, wfa[0], z16, 0, 0, 0);
                ai = __builtin_amdgcn_mfma_f32_32x32x16_bf16(af0, wfx[0], z16, 0, 0, 0); }
#pragma unroll
            for (int ks = 1; ks < 8; ++ks) {
                const bf16x8 af = *(const LAS bf16x8*)(xb + r * 272 + ks * 32 + hh * 16);
                ar = __builtin_amdgcn_mfma_f32_32x32x16_bf16(af, wfa[ks], ar, 0, 0, 0);
                ai = __builtin_amdgcn_mfma_f32_32x32x16_bf16(af, wfx[ks], ai, 0, 0, 0);
            }
            float a_[16], b_[16];
#pragma unroll
            for (int i = 0; i < 16; ++i) {
                const int row = (i & 3) + 8 * (i >> 2) + 4 * hh;
                const float xv = bf2f(*(const LAS bf16_t*)(xb + row * 272 + (cg * 32 + r) * 2));
                const float rr = __builtin_amdgcn_rcpf(fmaf(__builtin_amdgcn_exp2f(ar[i]), eba, 1.f)), ig = __builtin_amdgcn_rcpf(fmaf(__builtin_amdgcn_exp2f(ai[i]), ebx, 1.f));
                const float a = __builtin_amdgcn_exp2f(-sp2 * rr);
                a_[i] = a; b_[i] = __builtin_amdgcn_sqrtf(fmaxf(fmaf(-a, a, 1.f), 0.f)) * (ig * xv);
            }
            float gA[4], gB[4], fA[4], fB[4], sA[4], sB[4];
#pragma unroll
            for (int q = 0; q < 4; ++q) {
                if (dir == 0) { float hb = b_[4 * q]; hb = fmaf(a_[4 * q + 1], hb, b_[4 * q + 1]); hb = fmaf(a_[4 * q + 2], hb, b_[4 * q + 2]); hb = fmaf(a_[4 * q + 3], hb, b_[4 * q + 3]); gB[q] = hb; }
                else { float hb = b_[4 * q + 3]; hb = fmaf(a_[4 * q + 2], hb, b_[4 * q + 2]); hb = fmaf(a_[4 * q + 1], hb, b_[4 * q + 1]); hb = fmaf(a_[4 * q], hb, b_[4 * q]); gB[q] = hb; }
                gA[q] = (a_[4 * q] * a_[4 * q + 1]) * (a_[4 * q + 2] * a_[4 * q + 3]);
                const u32x2v ra = __builtin_amdgcn_permlane32_swap(__float_as_uint(gA[q]), __float_as_uint(gA[q]), false, false), rb = __builtin_amdgcn_permlane32_swap(__float_as_uint(gB[q]), __float_as_uint(gB[q]), false, false);
                fA[q] = __uint_as_float(ra[0]); sA[q] = __uint_as_float(ra[1]); fB[q] = __uint_as_float(rb[0]); sB[q] = __uint_as_float(rb[1]);
            }
            float hin[4];
#define RNN_STEP(q) do { if (dir == 0) { const float t1 = fmaf(fA[q], h, fB[q]), t2 = fmaf(sA[q], t1, sB[q]); hin[q] = hh ? t1 : h; h = t2; } \
                else { const float t1 = fmaf(sA[q], h, sB[q]), t2 = fmaf(fA[q], t1, fB[q]); hin[q] = hh ? h : t1; h = t2; } \
                if (!APPLY) Ap *= fA[q] * sA[q]; } while (0)
            if (dir == 0) { RNN_STEP(0); RNN_STEP(1); RNN_STEP(2); RNN_STEP(3); } else { RNN_STEP(3); RNN_STEP(2); RNN_STEP(1); RNN_STEP(0); }
#undef RNN_STEP
            if (APPLY) {
                LAS bf16_t* ht = (LAS bf16_t*)(lds + RNN_HOFF + dir * 32768) + (st * 32 + 4 * hh) * 128 + cg * 32 + r;
#pragma unroll
                for (int q = 0; q < 4; ++q) {
                    float hv = hin[q];
                    if (dir == 0) {
#pragma unroll
                        for (int e = 0; e < 4; ++e) { hv = fmaf(a_[4 * q + e], hv, b_[4 * q + e]); ht[(8 * q + e) * 128] = (bf16_t)(pk2(hv, 0.f) & 0xffffu); }
                    } else {
#pragma unroll
                        for (int e = 3; e >= 0; --e) { hv = fmaf(a_[4 * q + e], hv, b_[4 * q + e]); ht[(8 * q + e) * 128] = (bf16_t)(pk2(hv, 0.f) & 0xffffu); }
                    }
                }
            }
        }
        if (APPLY) {
            __syncthreads();
            const int row = tid >> 2, cs = (tid & 3) * 32;
            const LAS unsigned char* hf = lds + RNN_HOFF + row * 256 + cs * 2; const LAS unsigned char* hb = hf + 32768;
            bf16_t* gp = gl + (m0 + row) * 1024 + n * 128 + cs;
#pragma unroll
            for (int j = 0; j < 4; ++j) {
                const u32x4 f = *(const LAS u32x4*)(hf + j * 16), bk = *(const LAS u32x4*)(hb + j * 16), g = *(const u32x4*)(gp + j * 8);
                u32x4 o;
                o.x = pk2((bflo(f.x) + bflo(bk.x)) * bflo(g.x), (bfhi(f.x) + bfhi(bk.x)) * bfhi(g.x));
                o.y = pk2((bflo(f.y) + bflo(bk.y)) * bflo(g.y), (bfhi(f.y) + bfhi(bk.y)) * bfhi(g.y));
                o.z = pk2((bflo(f.z) + bflo(bk.z)) * bflo(g.z), (bfhi(f.z) + bfhi(bk.z)) * bfhi(g.z));
                o.w = pk2((bflo(f.w) + bflo(bk.w)) * bflo(g.w), (bfhi(f.w) + bfhi(bk.w)) * bfhi(g.w));
                *(u32x4*)(gp + j * 8) = o;
            }
        } else if (hh == 0) { sp[0] = Ap; sp[1024] = h; }
        li = lin; lin = (int)qs[2 + par]; par ^= 1;
    }
#undef RNN_COORDS
#undef RNN_LOADZ
    __syncthreads();
    if (nblk == 256) convert_tail(p, 16 + (APPLY ? 1 : 0), APPLY ? 10 : 6, APPLY ? 14 : 10, lds);
}

DEVI void phase_mla_pre(const P& p, int bid, int nblk) {
    const int tid = tid_(), lane = tid & 63, wave = tid >> 6;
    const bf16_t* zq = (const bf16_t*)(p.ws + WS_ZQ); const bf16_t* zkvr = (const bf16_t*)(p.ws + WS_ZKVR);
    bf16_t* Kb = (bf16_t*)(p.ws + WS_K);
    const float* rope = (const float*)(p.ws + WS_ROPE);
    const int NGW = nblk * 8, per = (NROW + NGW - 1) / NGW, m0 = (bid * 8 + wave) * per, m1 = (m0 + per < NROW) ? m0 + per : NROW;
    if (m0 >= m1) return;
    const float gk1 = lane < 16 ? p.g_k_rope[lane] : 0.f, gk2 = lane < 16 ? p.g_k_rope[16 + lane] : 0.f;
    u32x2 qn = {0u, 0u}, kn = {0u, 0u}; unsigned en = 0u;
#define MP_LOAD(m_) do { if ((m_) < NLAT) qn = gld8(zq + (size_t)(m_) * 256 + 4 * lane); if (lane < 32) { kn = gld8(zkvr + (size_t)(m_) * 256 + 4 * lane); en = *(const GAS unsigned short*)(zkvr + (size_t)(m_) * 256 + 128 + lane); } } while (0)
    MP_LOAD(m0);
    for (int m = m0; m < m1; ++m) {
        const u32x2 qc = qn, kc = kn; const float e = lane < 32 ? __uint_as_float(en << 16) : 0.f;
        if (m + 1 < m1) MP_LOAD(m + 1);
        if (m < NLAT) { const f32x4 v = {bflo(qc.x), bfhi(qc.x), bflo(qc.y), bfhi(qc.y)}; const float s = wave_sum(v.x * v.x + v.y * v.y + v.z * v.z + v.w * v.w);
            store4bf((bf16_t*)zq + (size_t)m * 256 + 4 * lane, v * rsqrtf(s * (1.f / 256.f) + EPS)); }
        const f32x4 kv4 = {bflo(kc.x), bfhi(kc.x), bflo(kc.y), bfhi(kc.y)};
        float s1 = 0.f; if (lane < 32) s1 = kv4.x * kv4.x + kv4.y * kv4.y + kv4.z * kv4.z + kv4.w * kv4.w;
        s1 = wave_sum(s1); if (lane < 32) store4bf((bf16_t*)zkvr + (size_t)m * 256 + 4 * lane, kv4 * rsqrtf(s1 * (1.f / 128.f) + EPS));
        const float rkr = rsqrtf(wave_sum(e * e) * (1.f / 32.f) + EPS);
        const float e2 = swz_xor<16>(e);
        if (lane < 16) {
            const float y1 = e * rkr * gk1, y2 = e2 * rkr * gk2;
            float cs = 1.f, sn = 0.f; int b, key;
            if (m < NLAT) { const int t = m & 4095; b = m >> 12; key = CTXL + t; const int pos = lane < 8 ? (t >> 6) : (t & 63); cs = rope[(pos * 8 + (lane & 7)) * 2]; sn = rope[(pos * 8 + (lane & 7)) * 2 + 1]; }
            else { b = (m - NLAT) >> 8; key = (m - NLAT) & 255; }
            const bf16_t o1 = (bf16_t)(pk2(y1 * cs - y2 * sn, 0.f) & 0xffffu), o2 = (bf16_t)(pk2(y1 * sn + y2 * cs, 0.f) & 0xffffu);
#pragma unroll
            for (int h = 0; h < 8; ++h) { bf16_t* kp = Kb + ((size_t)(b * 8 + h) * NKEY + key) * 96 + 64; kp[lane] = o1; kp[16 + lane] = o2; }
        }
    }
#undef MP_LOAD
}

template <bool SHIFT>
DEVI void attn_body(const P& p, int bid, int nblk, LAS unsigned char* lds, const float nshift) {
    const int tid = tid_(), wid = __builtin_amdgcn_readfirstlane(tid >> 6), lane = tid & 63, r = lane & 31, hh = lane >> 5;
    const bf16_t* Q = (const bf16_t*)(p.ws + WS_A); const bf16_t* Kb = (const bf16_t*)(p.ws + WS_K); const bf16_t* VT = (const bf16_t*)(p.ws + WS_VT);
    bf16_t* O = (bf16_t*)(p.ws + WS_ATTN);
    const int vcu = (nblk & 7) == 0 ? (bid & 7) * (nblk >> 3) + (bid >> 3) : bid;
    constexpr int KROW = 208, KBUF = 64 * KROW, VROW = 144, VBUF = 64 * VROW, BUFSZ = KBUF + VBUF, NT = NKEY / 64;
    unsigned ofs0, ofs1, ofs2;
    { const int q = wid * 64 + lane, c = q % 13; ofs0 = (unsigned)((q / 13) * 192 + (c < 12 ? c : 11) * 16); }
    if (wid < 5) { const int q = (wid + 8) * 64 + lane, c = q % 13; ofs1 = (unsigned)((q / 13) * 192 + (c < 12 ? c : 11) * 16); }
    else { const int q = (wid - 5) * 64 + lane, c = q % 9; ofs1 = (unsigned)((q / 9) * (NKEY * 2) + (c < 8 ? c : 7) * 16); }
    { const int q = (wid + 3) * 64 + lane, c = q % 9; ofs2 = (unsigned)((q / 9) * (NKEY * 2) + (c < 8 ? c : 7) * 16); }
    const unsigned d0 = (unsigned)wid * 1024u, d1 = wid < 5 ? (unsigned)(wid + 8) * 1024u : (unsigned)(KBUF + (wid - 5) * 1024), d2 = (unsigned)(KBUF + (wid + 3) * 1024);
#define AT_GLDS(src, dstoff) __builtin_amdgcn_global_load_lds((const unsigned*)(src), (LAS unsigned*)(lds + (dstoff)), 16, 0, 0)
#define AT_DMA(kg_, vg_, j_, boff_) do { const char* kt_ = uptr((kg_) + (size_t)(j_) * (64 * 192)); const char* vt_ = uptr((vg_) + (size_t)(j_) * 128); \
        AT_GLDS(kt_ + ofs0, (boff_) + d0); AT_GLDS((wid < 5 ? kt_ : vt_) + ofs1, (boff_) + d1); if (wid < 6) AT_GLDS(vt_ + ofs2, (boff_) + d2); } while (0)
#define AT_LDK(boff_, sub_) do { _Pragma("unroll") for (int ks = 0; ks < 6; ++ks) kf[ks] = *(const LAS bf16x8*)(lds + (boff_) + ((sub_) * 32 + r) * KROW + ks * 32 + hh * 16); } while (0)
#define SH_(x_) (SHIFT ? (x_) + nshift : (x_))
#define AT_EXP8(S_, LV_, PV_, o_, ONE_) do { const float e0 = __builtin_amdgcn_exp2f(SH_(S_[o_])), e1 = __builtin_amdgcn_exp2f(SH_(S_[o_ + 1])), e2 = __builtin_amdgcn_exp2f(SH_(S_[o_ + 2])), e3 = __builtin_amdgcn_exp2f(SH_(S_[o_ + 3])), \
        e4 = __builtin_amdgcn_exp2f(SH_(S_[o_ + 4])), e5 = __builtin_amdgcn_exp2f(SH_(S_[o_ + 5])), e6 = __builtin_amdgcn_exp2f(SH_(S_[o_ + 6])), e7 = __builtin_amdgcn_exp2f(SH_(S_[o_ + 7])); \
        LV_ = __builtin_fmaf(e7, ONE_, __builtin_fmaf(e6, ONE_, __builtin_fmaf(e5, ONE_, __builtin_fmaf(e4, ONE_, __builtin_fmaf(e3, ONE_, __builtin_fmaf(e2, ONE_, __builtin_fmaf(e1, ONE_, __builtin_fmaf(e0, ONE_, LV_)))))))); \
        PV_.x = pk2(e0, e1); PV_.y = pk2(e2, e3); PV_.z = pk2(e4, e5); PV_.w = pk2(e6, e7); } while (0)
#define AT_STEP(CA_, CB_, NA_, NB_, PP_, PC_, VPREV_, KNEXT_) do { \
        const LAS unsigned char* vp_ = (VPREV_); \
        const bf16x8 va0 = *(const LAS bf16x8*)(vp_), va1 = *(const LAS bf16x8*)(vp_ + 32), vb0 = *(const LAS bf16x8*)(vp_ + 32 * VROW), vb1 = *(const LAS bf16x8*)(vp_ + 32 * VROW + 32); \
        NA_ = __builtin_amdgcn_mfma_f32_32x32x16_bf16(kf[0], qf[0][0], zinit, 0, 0, 0); NB_ = __builtin_amdgcn_mfma_f32_32x32x16_bf16(kf[0], qf[1][0], zinit, 0, 0, 0); \
        NA_ = __builtin_amdgcn_mfma_f32_32x32x16_bf16(kf[1], qf[0][1], NA_, 0, 0, 0); NB_ = __builtin_amdgcn_mfma_f32_32x32x16_bf16(kf[1], qf[1][1], NB_, 0, 0, 0); \
        NA_ = __builtin_amdgcn_mfma_f32_32x32x16_bf16(kf[2], qf[0][2], NA_, 0, 0, 0); NB_ = __builtin_amdgcn_mfma_f32_32x32x16_bf16(kf[2], qf[1][2], NB_, 0, 0, 0); \
        NA_ = __builtin_amdgcn_mfma_f32_32x32x16_bf16(kf[3], qf[0][3], NA_, 0, 0, 0); NB_ = __builtin_amdgcn_mfma_f32_32x32x16_bf16(kf[3], qf[1][3], NB_, 0, 0, 0); \
        NA_ = __builtin_amdgcn_mfma_f32_32x32x16_bf16(kf[4], qf[0][4], NA_, 0, 0, 0); NB_ = __builtin_amdgcn_mfma_f32_32x32x16_bf16(kf[4], qf[1][4], NB_, 0, 0, 0); \
        NA_ = __builtin_amdgcn_mfma_f32_32x32x16_bf16(kf[5], qf[0][5], NA_, 0, 0, 0); NB_ = __builtin_amdgcn_mfma_f32_32x32x16_bf16(kf[5], qf[1][5], NB_, 0, 0, 0); \
        { const LAS unsigned char* kn_ = (KNEXT_); _Pragma("unroll") for (int ks = 0; ks < 6; ++ks) kf[ks] = *(const LAS bf16x8*)(kn_ + ks * 32); }     \
        { const bf16x8 pfa0 = __builtin_bit_cast(bf16x8, PP_[0]), pfa1 = __builtin_bit_cast(bf16x8, PP_[1]), pfb0 = __builtin_bit_cast(bf16x8, PP_[2]), pfb1 = __builtin_bit_cast(bf16x8, PP_[3]); \
        o[0][0] = __builtin_amdgcn_mfma_f32_32x32x16_bf16(va0, pfa0, o[0][0], 0, 0, 0); \
        o[1][0] = __builtin_amdgcn_mfma_f32_32x32x16_bf16(va0, pfb0, o[1][0], 0, 0, 0); \
        o[0][0] = __builtin_amdgcn_mfma_f32_32x32x16_bf16(va1, pfa1, o[0][0], 0, 0, 0); \
        o[1][0] = __builtin_amdgcn_mfma_f32_32x32x16_bf16(va1, pfb1, o[1][0], 0, 0, 0); \
        o[0][1] = __builtin_amdgcn_mfma_f32_32x32x16_bf16(vb0, pfa0, o[0][1], 0, 0, 0); \
        o[1][1] = __builtin_amdgcn_mfma_f32_32x32x16_bf16(vb0, pfb0, o[1][1], 0, 0, 0); \
        o[0][1] = __builtin_amdgcn_mfma_f32_32x32x16_bf16(vb1, pfa1, o[0][1], 0, 0, 0); \
        o[1][1] = __builtin_amdgcn_mfma_f32_32x32x16_bf16(vb1, pfb1, o[1][1], 0, 0, 0); } \
        AT_EXP8(CA_, l0v, PC_[0], 0, 1.0f); AT_EXP8(CA_, l0v, PC_[1], 8, 1.0f); AT_EXP8(CB_, l1v, PC_[2], 0, one_); AT_EXP8(CB_, l1v, PC_[3], 8, one_); \
        _Pragma("unroll") for (int g_ = 0; g_ < 4; ++g_) {   \
            __builtin_amdgcn_sched_group_barrier(0x008, 1, 0); __builtin_amdgcn_sched_group_barrier(0x400, 2, 0); __builtin_amdgcn_sched_group_barrier(0x002, 2, 0); \
            __builtin_amdgcn_sched_group_barrier(0x008, 1, 0); __builtin_amdgcn_sched_group_barrier(0x400, 1, 0); __builtin_amdgcn_sched_group_barrier(0x002, 3, 0); \
            __builtin_amdgcn_sched_group_barrier(0x008, 1, 0); __builtin_amdgcn_sched_group_barrier(0x400, 2, 0); __builtin_amdgcn_sched_group_barrier(0x002, 2, 0); \
            __builtin_amdgcn_sched_group_barrier(0x008, 1, 0); __builtin_amdgcn_sched_group_barrier(0x400, 1, 0); __builtin_amdgcn_sched_group_barrier(0x002, 3, 0); \
            __builtin_amdgcn_sched_group_barrier(0x008, 1, 0); __builtin_amdgcn_sched_group_barrier(0x400, 2, 0); __builtin_amdgcn_sched_group_barrier(0x002, 2, 0); } \
        asm volatile("" : "+v"(PC_[0]), "+v"(PC_[1]), "+v"(PC_[2]), "+v"(PC_[3]), "+v"(l0v), "+v"(l1v));   \
        __builtin_amdgcn_sched_barrier(0); \
    } while (0)
    f32x16 zinit;
#pragma unroll
    for (int i = 0; i < 16; ++i) zinit[i] = 0.f;
    float one_ = 1.0f; asm volatile("" : "+v"(one_));
    unsigned prv = 3u * BUFSZ, cur = 0u, nxt = (unsigned)BUFSZ, nn = 2u * BUFSZ;
    bool primed = false;
    for (int u = vcu; u < NB * 8 * 8; u += nblk) {
        const int bh = u >> 3, qb = u & 7;
        const bool more = u + nblk < NB * 8 * 8; const int bhn = more ? (u + nblk) >> 3 : bh;
        bf16x8 qf[2][6];
#pragma unroll
        for (int qs = 0; qs < 2; ++qs) { const bf16_t* qp = uptr(Q + ((size_t)bh * SEQ + qb * 512 + wid * 64 + qs * 32) * 96) + (unsigned)(r * 96 + hh * 8);
#pragma unroll
          for (int ks = 0; ks < 6; ++ks) { const u32x4 t = gld16(qp + ks * 16); qf[qs][ks] = __builtin_bit_cast(bf16x8, t); } }
        f32x16 o[2][2];
#pragma unroll
        for (int qs = 0; qs < 2; ++qs)
#pragma unroll
            for (int d = 0; d < 2; ++d)
#pragma unroll
                for (int i = 0; i < 16; ++i) o[qs][d][i] = 0.f;
        float l0v = 0.f, l1v = 0.f;
        const char* kg = uptr((const char*)(Kb + (size_t)bh * NKEY * 96)); const char* vg = uptr((const char*)(VT + (size_t)bh * 64 * NKEY));
        const char* kgn = uptr((const char*)(Kb + (size_t)bhn * NKEY * 96)); const char* vgn = uptr((const char*)(VT + (size_t)bhn * 64 * NKEY));
        if (!primed) {
            __syncthreads();
            AT_DMA(kg, vg, 0, cur); AT_DMA(kg, vg, 1, nxt);
            asm volatile("s_waitcnt vmcnt(0)" ::: "memory");
            __syncthreads();
        }
        bf16x8 kf[6];
        f32x16 sa = zinit, sb = zinit, ta, tb;
        AT_LDK(cur, 0);
#pragma unroll
        for (int ks = 0; ks < 6; ++ks) { sa = __builtin_amdgcn_mfma_f32_32x32x16_bf16(kf[ks], qf[0][ks], sa, 0, 0, 0); sb = __builtin_amdgcn_mfma_f32_32x32x16_bf16(kf[ks], qf[1][ks], sb, 0, 0, 0); }
        AT_LDK(cur, 1);
        u32x4 p0[4], p1[4];
#pragma unroll
        for (int i = 0; i < 4; ++i) p1[i] = (u32x4){0u, 0u, 0u, 0u};
        const unsigned vlane = (unsigned)(KBUF + r * VROW + hh * 16), klane = (unsigned)(r * KROW + hh * 16);
#pragma unroll 1
        for (int j = 0; j < NT; ++j) {
            asm volatile("s_waitcnt vmcnt(0)" ::: "memory"); __syncthreads();
            if (j + 2 < NT) AT_DMA(kg, vg, j + 2, nn); else if (more) AT_DMA(kgn, vgn, j + 2 - NT, nn);
            AT_STEP(sa, sb, ta, tb, p1, p0, lds + (j == 0 ? cur : prv + 64u) + vlane, lds + nxt + klane);
            AT_STEP(ta, tb, sa, sb, p0, p1, lds + cur + vlane, lds + nxt + 32 * KROW + klane);
            const unsigned t_ = prv; prv = cur; cur = nxt; nxt = nn; nn = t_;
        }
        {
            const LAS unsigned char* vp_ = lds + prv + 64u + vlane;
            const bf16x8 va0 = *(const LAS bf16x8*)(vp_), va1 = *(const LAS bf16x8*)(vp_ + 32), vb0 = *(const LAS bf16x8*)(vp_ + 32 * VROW), vb1 = *(const LAS bf16x8*)(vp_ + 32 * VROW + 32);
            const bf16x8 pfa0 = __builtin_bit_cast(bf16x8, p1[0]), pfa1 = __builtin_bit_cast(bf16x8, p1[1]), pfb0 = __builtin_bit_cast(bf16x8, p1[2]), pfb1 = __builtin_bit_cast(bf16x8, p1[3]);
            o[0][0] = __builtin_amdgcn_mfma_f32_32x32x16_bf16(va0, pfa0, o[0][0], 0, 0, 0);
            o[1][0] = __builtin_amdgcn_mfma_f32_32x32x16_bf16(va0, pfb0, o[1][0], 0, 0, 0);
            o[0][0] = __builtin_amdgcn_mfma_f32_32x32x16_bf16(va1, pfa1, o[0][0], 0, 0, 0);
            o[1][0] = __builtin_amdgcn_mfma_f32_32x32x16_bf16(va1, pfb1, o[1][0], 0, 0, 0);
            o[0][1] = __builtin_amdgcn_mfma_f32_32x32x16_bf16(vb0, pfa0, o[0][1], 0, 0, 0);
            o[1][1] = __builtin_amdgcn_mfma_f32_32x32x16_bf16(vb0, pfb0, o[1][1], 0, 0, 0);
            o[0][1] = __builtin_amdgcn_mfma_f32_32x32x16_bf16(vb1, pfa1, o[0][1], 0, 0, 0);
            o[1][1] = __builtin_amdgcn_mfma_f32_32x32x16_bf16(vb1, pfb1, o[1][1], 0, 0, 0);
        }
        primed = more;
        const float l0 = l0v, l1 = l1v;
        const int b = bh >> 3, h = bh & 7;
#pragma unroll
        for (int qs = 0; qs < 2; ++qs) {
            const float inv = 1.f / xor32_sum(qs ? l1 : l0);
            bf16_t* op = uptr(O + ((size_t)(b * SEQ + qb * 512 + wid * 64 + qs * 32)) * 512 + h * 64) + (unsigned)(r * 512 + 4 * hh);
#pragma unroll
            for (int g = 0; g < 4; ++g) {
                store4bf(op + 8 * g, (f32x4){o[qs][0][4 * g], o[qs][0][4 * g + 1], o[qs][0][4 * g + 2], o[qs][0][4 * g + 3]} * inv);
                store4bf(op + 32 + 8 * g, (f32x4){o[qs][1][4 * g], o[qs][1][4 * g + 1], o[qs][1][4 * g + 2], o[qs][1][4 * g + 3]} * inv);
            }
        }
    }
#undef AT_STEP
#undef AT_EXP8
#undef SH_
#undef AT_LDK
#undef AT_DMA
#undef AT_GLDS
}

DEVI void phase_attn(const P& p, int bid, int nblk, LAS unsigned char* lds) {
    const float smax = ((const float*)(p.ws + WS_SMAX))[0];
    if (smax <= 64.f) attn_body<false>(p, bid, nblk, lds, 0.f); else attn_body<true>(p, bid, nblk, lds, -smax);
}

DEVI void phase_norm2_router(const P& p, int bid, int nblk, unsigned char* lds) {
    const int tid = tid_(), lane = tid & 63, wave = __builtin_amdgcn_readfirstlane(tid >> 6);
    float* wrT = (float*)lds;
    float* gsS = wrT + 16384;
    for (int i = tid; i < 16384; i += NTHR) { const int k = i >> 4, e = i & 15; wrT[e * 1024 + k] = p.w_router[i]; }
    const float* mod = (const float*)(p.ws + WS_MOD); bf16_t* hb = (bf16_t*)(p.ws + WS_A); float* aff = (float*)(p.ws + WS_AFF);
    for (int i = tid; i < NB * 1024; i += NTHR) { const int bb = i >> 10, k = i & 1023; gsS[i] = p.g_norm2[k] * (mod[bb * 6144 + 4096 + k] + 1.f); gsS[NB * 1024 + i] = mod[bb * 6144 + 3072 + k]; }
    __syncthreads();
    const int NGW = nblk * 8, per = (NLAT + NGW - 1) / NGW, m0 = (bid * 8 + wave) * per, m1 = (m0 + per < NLAT) ? m0 + per : NLAT;
    if (m0 >= m1) return;
    const bool b4 = (lane & 16) != 0, b3 = (lane & 8) != 0, b2 = (lane & 4) != 0;
    f32x4 na[4], nb[4];
#pragma unroll
    for (int j = 0; j < 4; ++j) { na[j] = gldf4(uptr(p.out + (size_t)m0 * 1024) + (unsigned)(4 * lane) + 256 * j); nb[j] = gldf4(uptr(p.out + (size_t)(m0 + 1 < m1 ? m0 + 1 : m0) * 1024) + (unsigned)(4 * lane) + 256 * j); }
    for (int m = m0; m < m1; m += 2) {
        const bool two = m + 1 < m1;
        const int ma = m, mb = two ? m + 1 : m;
        f32x4 va[4], vb[4];
#pragma unroll
        for (int j = 0; j < 4; ++j) { va[j] = na[j]; vb[j] = nb[j]; }
        if (m + 2 < m1) { const int pa = m + 2, pb = (m + 3 < m1) ? m + 3 : m + 2;
#pragma unroll
            for (int j = 0; j < 4; ++j) { na[j] = gldf4(uptr(p.out + (size_t)pa * 1024) + (unsigned)(4 * lane) + 256 * j); nb[j] = gldf4(uptr(p.out + (size_t)pb * 1024) + (unsigned)(4 * lane) + 256 * j); } }
        float sa = 0.f, sb = 0.f;
#pragma unroll
        for (int j = 0; j < 4; ++j) { sa += va[j].x * va[j].x + va[j].y * va[j].y + va[j].z * va[j].z + va[j].w * va[j].w; sb += vb[j].x * vb[j].x + vb[j].y * vb[j].y + vb[j].z * vb[j].z + vb[j].w * vb[j].w; }
        const float ra = rsqrtf(wave_sum(sa) * (1.f / 1024.f) + EPS), rb = rsqrtf(wave_sum(sb) * (1.f / 1024.f) + EPS);
        const float* gpa = gsS + (ma >> 12) * 1024; const float* gpb = gsS + (mb >> 12) * 1024;
        f32x2 vv[4][4];
#pragma unroll
        for (int j = 0; j < 4; ++j) { const int k = 4 * (lane + 64 * j);
            const f32x4 xa = va[j] * ra * *(const f32x4*)(gpa + k) + *(const f32x4*)(gpa + NB * 1024 + k), xb = vb[j] * rb * *(const f32x4*)(gpb + k) + *(const f32x4*)(gpb + NB * 1024 + k);
            *(GAS unsigned*)(uptr((unsigned char*)hb + (size_t)ma * 1024) + (unsigned)(4 * lane) + 256 * j) = pk4f8(xa);
            if (two) *(GAS unsigned*)(uptr((unsigned char*)hb + (size_t)mb * 1024) + (unsigned)(4 * lane) + 256 * j) = pk4f8(xb);
            vv[j][0] = (f32x2){xa.x, xb.x}; vv[j][1] = (f32x2){xa.y, xb.y}; vv[j][2] = (f32x2){xa.z, xb.z}; vv[j][3] = (f32x2){xa.w, xb.w}; }
        f32x2 lg[16];
        unsigned wo = (unsigned)lane * 16u; asm volatile("" : "+v"(wo));
        const unsigned char* wb = (const unsigned char*)wrT + wo;
#pragma unroll
        for (int e = 0; e < 16; ++e) {
            f32x2 acc = {0.f, 0.f};
#pragma unroll
            for (int j = 0; j < 4; ++j) { const f32x4 w = *(const f32x4*)(wb + e * 4096 + j * 1024);
                acc += vv[j][0] * (f32x2){w.x, w.x}; acc += vv[j][1] * (f32x2){w.y, w.y}; acc += vv[j][2] * (f32x2){w.z, w.z}; acc += vv[j][3] * (f32x2){w.w, w.w}; }
            lg[e] = acc;
        }
#pragma unroll
        for (int r = 0; r < 2; ++r) {
            float r8[8], r4[4], r2[2];
#pragma unroll
            for (int e = 0; e < 8; ++e) { const u32x2v q = __builtin_amdgcn_permlane32_swap(__float_as_uint(r ? lg[e].y : lg[e].x), __float_as_uint(r ? lg[e + 8].y : lg[e + 8].x), false, false); r8[e] = __uint_as_float(q[0]) + __uint_as_float(q[1]); }
#pragma unroll
            for (int e = 0; e < 4; ++e) r4[e] = (b4 ? r8[e + 4] : r8[e]) + swz_xor<16>(b4 ? r8[e] : r8[e + 4]);
#pragma unroll
            for (int e = 0; e < 2; ++e) r2[e] = (b3 ? r4[e + 2] : r4[e]) + swz_xor<8>(b3 ? r4[e] : r4[e + 2]);
            float lgt = (b2 ? r2[1] : r2[0]) + swz_xor<4>(b2 ? r2[0] : r2[1]);
            lgt += swz_xor<2>(lgt); lgt += swz_xor<1>(lgt);
            const float mx = wave_max(lgt), ex = expf(lgt - mx), den = wave_sum(ex) * 0.25f;
            const int mr = r ? mb : ma, b = mr >> 12, t = mr & 4095;
            if ((r == 0 || two) && (lane & 3) == 0) *(GAS float*)(uptr(aff + (size_t)b * 16 * 4096 + t) + (unsigned)(((lane >> 2) & 15) * 4096)) = ex / den;
        }
    }
}

DEVI void phase_topk(const P& p, int bid, int nblk, unsigned char* lds) {
    const int tid = tid_(), lane = tid & 63, wave = tid >> 6;
    unsigned* hist = (unsigned*)lds; unsigned* sh = hist + 256;
    const float* aff = (const float*)(p.ws + WS_AFF); int* idx = (int*)(p.ws + WS_IDX); float* gate = (float*)(p.ws + WS_GATE); int* slot_of = (int*)(p.ws + WS_SLOT);
    for (int item = bid; item < NB * NE; item += nblk) {
        const float* a = aff + (size_t)item * 4096 + tid * 8;
        unsigned u[8];
        { const u32x4 t0 = *(const u32x4*)a, t1 = *(const u32x4*)(a + 4); u[0] = t0.x; u[1] = t0.y; u[2] = t0.z; u[3] = t0.w; u[4] = t1.x; u[5] = t1.y; u[6] = t1.z; u[7] = t1.w; }
        unsigned prefix = 0u, mask = 0u, need = CAP;
        for (int pass = 0; pass < 4; ++pass) {
            const int shift = 24 - 8 * pass;
            if (tid < 256) hist[tid] = 0u;
            __syncthreads();
#pragma unroll
            for (int j = 0; j < 8; ++j) if ((u[j] & mask) == prefix) atomicAdd(&hist[(u[j] >> shift) & 255u], 1u);
            __syncthreads();
            if (wave == 0) {
                const unsigned c0 = hist[255 - 4 * lane], c1 = hist[254 - 4 * lane], c2 = hist[253 - 4 * lane], c3 = hist[252 - 4 * lane], T4 = c0 + c1 + c2 + c3;
                unsigned inc = T4;
#pragma unroll
                for (int o = 1; o < 64; o <<= 1) { const unsigned n = (unsigned)__builtin_amdgcn_ds_bpermute(((lane - o) & 63) << 2, (int)inc); if (lane >= o) inc += n; }
                const unsigned exc = inc - T4;
                if (exc < need && need <= inc) {
                    unsigned cum = exc; int sel = 255 - 4 * lane;
                    if (cum + c0 < need) { cum += c0; --sel; if (cum + c1 < need) { cum += c1; --sel; if (cum + c2 < need) { cum += c2; --sel; } } }
                    sh[0] = (unsigned)sel; sh[1] = need - cum;
                }
            }
            __syncthreads();
            prefix |= sh[0] << shift; mask |= 255u << shift; need = sh[1];
            __syncthreads();
        }
        const unsigned T = prefix;
        unsigned cg = 0u, ce = 0u;
#pragma unroll
        for (int j = 0; j < 8; ++j) { cg += (u[j] > T) ? 1u : 0u; ce += (u[j] == T) ? 1u : 0u; }
        const unsigned packed = cg | (ce << 16);
        unsigned incl = packed;
#pragma unroll
        for (int o = 1; o < 64; o <<= 1) { const unsigned n = (unsigned)__builtin_amdgcn_ds_bpermute(((lane - o) & 63) << 2, (int)incl); if (lane >= o) incl += n; }
        if (lane == 63) sh[8 + wave] = incl;
        __syncthreads();
        unsigned woff = 0u;
        for (int w = 0; w < wave; ++w) woff += sh[8 + w];
        const unsigned excl = incl - packed + woff;
        unsigned gb = excl & 0xffffu, eb = excl >> 16;
#pragma unroll
        for (int j = 0; j < 8; ++j) {
            const int i = tid * 8 + j; const bool gt = u[j] > T, eq = u[j] == T;
            int slot = -1;
            if (gt) slot = (int)(gb + (eb < need ? eb : need));
            else if (eq && eb < need) slot = (int)(gb + eb);
            if (slot >= 0) { idx[item * CAP + slot] = i; gate[item * CAP + slot] = __uint_as_float(u[j]); }
            slot_of[(size_t)item * 4096 + i] = slot;
            gb += gt ? 1u : 0u; eb += eq ? 1u : 0u;
        }
        __syncthreads();
    }
}

DEVI void phase_combine(const P& p, int bid, int nblk) {
    const int tid = tid_(), lane = tid & 63, wave = tid >> 6;
    const float* mod = (const float*)(p.ws + WS_MOD); const int* slot_of = (const int*)(p.ws + WS_SLOT); const bf16_t* Y = (const bf16_t*)(p.ws + WS_Y);
    const int NGW = nblk * 8, per = (NLAT + NGW - 1) / NGW, m0 = (bid * 8 + wave) * per, m1 = (m0 + per < NLAT) ? m0 + per : NLAT;
    if (m0 >= m1) return;
    int sln = -1; f32x4 xn[4];
#define CB_LOAD(m_) do { sln = -1; if (lane < NE) sln = *(const GAS int*)(slot_of + ((size_t)(((m_) >> 12) * 16 + lane)) * 4096 + ((m_) & 4095)); \
        _Pragma("unroll") for (int j = 0; j < 4; ++j) xn[j] = gldf4(p.out + (size_t)(m_) * 1024 + 4 * (lane + 64 * j)); } while (0)
    CB_LOAD(m0);
    int bc = -1; f32x4 md[4];
    for (int m = m0; m < m1; ++m) {
        const int b = m >> 12;
        const int sl = sln; f32x4 xv[4], acc[4];
#pragma unroll
        for (int j = 0; j < 4; ++j) { xv[j] = xn[j]; acc[j] = (f32x4){0.f, 0.f, 0.f, 0.f}; }
        if (m + 1 < m1) CB_LOAD(m + 1);
        if (b != bc) { bc = b;
#pragma unroll
            for (int j = 0; j < 4; ++j) md[j] = gldf4(mod + b * 6144 + 5120 + 4 * (lane + 64 * j)); }
        unsigned long long mask = __ballot(sl >= 0);
        while (mask) {
            int e[4]; float w[4];
#pragma unroll
            for (int q = 0; q < 4; ++q) {
                if (mask) { e[q] = __builtin_ctzll(mask); mask &= mask - 1; w[q] = 1.f; } else { e[q] = e[0]; w[q] = 0.f; }
            }
            u32x2 y[4][4];
#pragma unroll
            for (int q = 0; q < 4; ++q) {
                const int sq = __builtin_amdgcn_readlane(sl, e[q]);
                const bf16_t* yp = Y + ((size_t)(b * 16 + e[q]) * CAP + sq) * 1024 + 4 * lane;
#pragma unroll
                for (int j = 0; j < 4; ++j) y[q][j] = gld8(yp + 256 * j);
            }
#pragma unroll
            for (int q = 0; q < 4; ++q)
#pragma unroll
                for (int j = 0; j < 4; ++j) acc[j] += (f32x4){bflo(y[q][j].x), bfhi(y[q][j].x), bflo(y[q][j].y), bfhi(y[q][j].y)} * w[q];
        }
#pragma unroll
        for (int j = 0; j < 4; ++j) gstf4(p.out + (size_t)m * 1024 + 4 * (lane + 64 * j), xv[j] + md[j] * acc[j]);
    }
#undef CB_LOAD
}

template <int PH>
DEVI void run_phase(const P& p, int bid, int nblk, unsigned char* lds) {
    LAS unsigned char* l3 = (LAS unsigned char*)lds;
    if (PH == 0) { phase_prep(p, bid, nblk, lds);
        if (nblk == 256) { __syncthreads(); phase_expert_convert(p, 0, 192, bid, nblk, lds, 0, 1); } }
    if (PH == 1) phase_norm1(p, bid, nblk);
    if (PH == 2) { G1 g{(const bf16_t*)(p.ws + WS_A), (const bf16_t*)(p.ws + WS_WIN), (bf16_t*)(p.ws + WS_ZRNN), (bf16_t*)(p.ws + WS_GELU), (bf16_t*)(p.ws + WS_ZQ), (bf16_t*)(p.ws + WS_ZKVR), (bf16_t*)(p.ws + WS_G)}; gemm_fast(g, bid, nblk, l3);
        { G1g g8{p.ws + WS_A18, p.ws + WS_WIN8, (bf16_t*)(p.ws + WS_G)}; gemm_fast(g8, bid, nblk, l3); }
        __syncthreads(); phase_expert_convert(p, 1, (nblk == 256 ? 40 : 0), bid, nblk, lds); }
    if (PH == 3) { phase_mla_pre(p, bid, nblk); phase_rnn<false>(p, bid, nblk, l3); }
    if (PH == 4) { phase_rnn_carry(p, bid, nblk);
        LAS float* cst = (LAS float*)(l3 + 131072);
        { const int tid = tid_(); const float* rope = (const float*)(p.ws + WS_ROPE);
          for (int i = tid; i < 160 + 1024; i += NTHR) cst[i] = i < 64 ? p.g_q_nope[i] : i < 128 ? p.g_k_nope[i - 64] : i < 160 ? p.g_q_rope[i - 128] : rope[i - 160]; }
        __syncthreads();
        GP4 g{p.ws, cst}; gemm_fast(g, bid, nblk, l3);
        if (nblk == 256) { __syncthreads(); phase_expert_convert(p, 0, 160, bid, nblk, lds, 1, 3); } }
    if (PH == 5) { phase_attn(p, bid, nblk, l3); __syncthreads(); phase_rnn<true>(p, bid, nblk, l3); }
    if (PH == 6) { phase_expert_convert(p, 0, 0, bid, nblk, lds, nblk == 256 ? E_EARLY : 0, 16); __syncthreads();
        G2 g{(const bf16_t*)(p.ws + WS_GELU), (const bf16_t*)(p.ws + WS_ATTN), (const bf16_t*)(p.ws + WS_WRNN), (const bf16_t*)(p.ws + WS_WMLA), (const bf16_t*)(p.ws + WS_G), (bf16_t*)(p.ws + WS_A)}; gemm_fast(g, bid, nblk, l3); }
    if (PH == 7) { G3 g{(const bf16_t*)(p.ws + WS_A), (const bf16_t*)(p.ws + WS_WO), p.x, (const float*)(p.ws + WS_MOD), p.out}; gemm_fast(g, bid, nblk, l3); }
    if (PH == 8) phase_norm2_router(p, bid, nblk, lds);
    if (PH == 9) { phase_topk(p, bid, nblk, lds);
        if (nblk == 256) { __syncthreads(); phase_expert_convert(p, 0, 128, bid, nblk, lds, 3, 6); } }
    if (PH == 10) { GM1 g{p.ws + WS_A, p.ws, (const int*)(p.ws + WS_IDX), p.ws + WS_HID}; gemm_fast(g, bid, nblk, l3); }
    if (PH == 11) { GM2 g{p.ws + WS_HID, p.ws + WS_WD, (const float*)(p.ws + WS_GATE), (bf16_t*)(p.ws + WS_Y)}; gemm_fast(g, bid, nblk, l3); }
    if (PH == 12) phase_combine(p, bid, nblk);
}

#define XB_TMO      128
#define XB_XCNT(j)  (256  + 64 * (j))
#define XB_XSUB(j)  (1280 + 64 * (j))
#define XB_XGEN(j)  (2304 + 64 * (j))
#define XB_TOP      3328
#define XB_TOPGEN   3392
#define XCD_BAR_WORDS 3456
#define XB_SPIN_CAP (1u << 20)
DEVI unsigned xb_ld(unsigned* p)              { return __hip_atomic_load(p, __ATOMIC_RELAXED, __HIP_MEMORY_SCOPE_AGENT); }
DEVI unsigned xb_add(unsigned* p, unsigned v) { return __hip_atomic_fetch_add(p, v, __ATOMIC_RELAXED, __HIP_MEMORY_SCOPE_AGENT); }
DEVI unsigned xb_xcc_id() { return (unsigned)__builtin_amdgcn_s_getreg((3 << 11) | 20) & 0xFu; }
#define XB_SPIN(cond, bar) do { unsigned _sp = 0; while (cond) { __builtin_amdgcn_s_sleep(1); \
    if ((++_sp & 255u) == 0u) { if (xb_ld(&(bar)[XB_TMO])) break; if (_sp > XB_SPIN_CAP) { atomicAdd(&(bar)[XB_TMO], 1u); break; } } } } while (0)
struct XcdBarrier { unsigned* bar; unsigned x; volatile LAS unsigned* st; };
DEVI XcdBarrier xcd_barrier_post(unsigned* bar, volatile LAS unsigned* st) {
    XcdBarrier b; b.bar = bar; b.x = xb_xcc_id(); b.st = st;
    if (threadIdx.x == 0) (void)xb_add(&bar[XB_XCNT(b.x)], 1u);
    return b;
}
DEVI void xcd_barrier_complete(unsigned* bar, unsigned x, unsigned& nloc, unsigned& nx) {
    const unsigned G = gridDim.x * gridDim.y * gridDim.z;
    unsigned sum, cnt, mine, sp = 0u;
    for (;;) {
        sum = 0u; cnt = 0u; mine = 0u;
#pragma unroll
        for (unsigned j = 0; j < 16; ++j) { const unsigned c = xb_ld(&bar[XB_XCNT(j)]); sum += c; cnt += (c > 0u) ? 1u : 0u; mine = (j == x) ? c : mine; }
        if (sum == G) break;
        __builtin_amdgcn_s_sleep(1);
        if ((++sp & 255u) == 0u) { if (xb_ld(&bar[XB_TMO])) break; if (sp > XB_SPIN_CAP) { atomicAdd(&bar[XB_TMO], 1u); break; } }
    }
    nloc = mine > 0u ? mine : 1u; nx = cnt > 0u ? cnt : 1u;
}
DEVI void xcd_barrier(const XcdBarrier& b) {
    asm volatile("s_waitcnt vmcnt(0)" ::: "memory");
    __syncthreads();
    if (threadIdx.x == 0) {
        unsigned* bar = b.bar;
        __builtin_amdgcn_s_waitcnt(0);
        unsigned nloc = b.st[0], nx = b.st[1];
        if (nloc == 0u) { xcd_barrier_complete(bar, b.x, nloc, nx); b.st[0] = nloc; b.st[1] = nx; }
        const unsigned old = xb_add(&bar[XB_XSUB(b.x)], 1u);
        const unsigned gen = old / nloc;
        if (old + 1u == (gen + 1u) * nloc) {
            __builtin_amdgcn_fence(__ATOMIC_RELEASE, "agent");
            asm volatile("s_waitcnt vmcnt(0)" ::: "memory");
            const unsigned og = xb_add(&bar[XB_TOP], 1u);
            const unsigned tg = og / nx;
            if (og + 1u == (tg + 1u) * nx) xb_add(&bar[XB_TOPGEN], 1u);
            else XB_SPIN(xb_ld(&bar[XB_TOPGEN]) == tg, bar);
            __builtin_amdgcn_fence(__ATOMIC_ACQUIRE, "agent");
            xb_add(&bar[XB_XGEN(b.x)], 1u);
            asm volatile("s_waitcnt vmcnt(0)" ::: "memory");
        } else {
            XB_SPIN(xb_ld(&bar[XB_XGEN(b.x)]) == gen, bar);
            __builtin_amdgcn_fence(__ATOMIC_ACQUIRE, "agent");
            asm volatile("s_waitcnt vmcnt(0)" ::: "memory");
        }
    }
    __syncthreads();
}

constexpr int CW_BAR = 4096;

constexpr unsigned PROBE_MASK = 0u;
__global__ void __launch_bounds__(NTHR, 2) mega_fwd(P p) {
    extern __shared__ __attribute__((aligned(16))) unsigned char lds[];
    const int bid = (int)blockIdx.x, nblk = (int)gridDim.x;
    volatile LAS unsigned* MISC = (volatile LAS unsigned*)((LAS unsigned char*)lds + MISC_OFF);
    if (threadIdx.x < 32) MISC[threadIdx.x] = 0u;
    if ((threadIdx.x & 63) == 0) MISC[32 + hw_slot_()] = threadIdx.x >> 6;
    __syncthreads();
    XcdBarrier bar = xcd_barrier_post((unsigned*)(p.ws + WS_CTL) + CW_BAR, MISC + 8);
    unsigned long long t_prev = 0ull;
    if (PROBE_MASK) t_prev = __builtin_amdgcn_s_memrealtime();
#define SEAM(k) do { xcd_barrier(bar); asm volatile("" : "+s"(p.ws)); \
    if (PROBE_MASK) { const unsigned long long t1_ = __builtin_amdgcn_s_memrealtime(); \
        if ((PROBE_MASK >> (k)) & 1u) { const unsigned long long d_ = t1_ - t_prev; while (__builtin_amdgcn_s_memrealtime() - t1_ < d_) __builtin_amdgcn_s_sleep(8); } \
        t_prev = __builtin_amdgcn_s_memrealtime(); } } while (0)
    run_phase<0>(p, bid, nblk, lds); SEAM(0);
    run_phase<1>(p, bid, nblk, lds); SEAM(1);
    run_phase<2>(p, bid, nblk, lds); SEAM(2);
    run_phase<3>(p, bid, nblk, lds); SEAM(3);
    run_phase<4>(p, bid, nblk, lds); SEAM(4);
    run_phase<5>(p, bid, nblk, lds); SEAM(5);
    run_phase<6>(p, bid, nblk, lds); SEAM(6);
    run_phase<7>(p, bid, nblk, lds); SEAM(7);
    run_phase<8>(p, bid, nblk, lds); SEAM(8);
    run_phase<9>(p, bid, nblk, lds); SEAM(9);
    run_phase<10>(p, bid, nblk, lds); SEAM(10);
    run_phase<11>(p, bid, nblk, lds); SEAM(11);
    run_phase<12>(p, bid, nblk, lds);
    if (PROBE_MASK) SEAM(12);
#undef SEAM
}

extern "C" void kernel_launch(void* const* d_in, const int* in_sizes, int n_in, void* d_out, int out_size, void* d_ws, size_t ws_size, hipStream_t stream) {
    static int grid = 0;
    if (grid == 0) {
        if (n_in != 32 || ws_size < WS_END) { fprintf(stderr, "kernel_launch: unexpected n_in %d / ws_size %zu\n", n_in, ws_size); grid = -1; return; }
        int dev = 0, cus = 0, per_cu = 0;
        if (hipGetDevice(&dev) != hipSuccess || hipDeviceGetAttribute(&cus, hipDeviceAttributeMultiprocessorCount, dev) != hipSuccess) { grid = -1; return; }
        if (hipFuncSetAttribute((const void*)mega_fwd, hipFuncAttributeMaxDynamicSharedMemorySize, LDS_BYTES) != hipSuccess) { fprintf(stderr, "kernel_launch: hipFuncSetAttribute failed\n"); grid = -1; return; }
        if (hipOccupancyMaxActiveBlocksPerMultiprocessor(&per_cu, (const void*)mega_fwd, NTHR, LDS_BYTES) != hipSuccess || per_cu < 1) { fprintf(stderr, "kernel_launch: occupancy query says %d\n", per_cu); }
        (void)hipGetLastError();
        grid = cus;
    }
    if (grid < 0) return;
    P p{};
    const float** fp = (const float**)&p;
    for (int i = 0; i < 32; ++i) fp[i] = (const float*)d_in[i];
    p.out = (float*)d_out; p.ws = (unsigned char*)d_ws;
    (void)hipMemsetAsync((char*)d_ws + WS_CTL, 0, 64 * 1024, stream);
    hipLaunchKernelGGL(mega_fwd, dim3(grid), dim3(NTHR), LDS_BYTES, stream, p);
}
```

```cpp
#include <hip/hip_runtime.h>
#include <stdint.h>
#include <stdio.h>

#define DEVI __device__ __forceinline__
typedef unsigned short bf16_t;
typedef float f32x4 __attribute__((ext_vector_type(4)));
typedef unsigned u32x4 __attribute__((ext_vector_type(4)));
typedef unsigned u32x2 __attribute__((ext_vector_type(2)));

constexpr int NTHR = 512;
constexpr int DM = 1024, NB = 8, SEQ = 4096, CTXL = 256;
constexpr int NLAT = NB * SEQ, NCTX = NB * CTXL, NROW = NLAT + NCTX, NKEY = SEQ + CTXL;
constexpr int NE = 16, CAP = 512;
constexpr float EPS = 1e-6f;
constexpr float QSCALE = 0.10206207261596575f * 1.4426950408889634f;

constexpr size_t MiB = 1u << 20;
constexpr size_t WS_CTL = 0;
constexpr size_t WS_MOD = 1 * MiB;
constexpr size_t WS_ROPE = WS_MOD + 256 * 1024;
constexpr size_t WS_SP = WS_ROPE + 4096;
constexpr size_t WS_SMAX = WS_SP + 8192;
constexpr size_t WS_RSTDQ = 1 * MiB + 512 * 1024;
constexpr size_t WS_RSTDKV = WS_RSTDQ + 128 * 1024;
constexpr size_t WS_WIN = 2 * MiB;
constexpr size_t WS_WRNN = 11 * MiB;
constexpr size_t WS_WMLA = 13 * MiB;
constexpr size_t WS_WO = 14 * MiB;
constexpr size_t WS_WUQ = 16 * MiB;
constexpr size_t WS_WUK = WS_WUQ + 384 * 1024;
constexpr size_t WS_WUV = WS_WUK + 256 * 1024;
constexpr size_t WS_WRG = 17 * MiB;
constexpr size_t WS_RNNSUM = 18 * MiB;
constexpr size_t WS_WIN8 = 27 * MiB;
constexpr size_t WS_A18 = 393 * MiB;
constexpr size_t WS_AFF = 27 * MiB;
constexpr size_t WS_IDX = 29 * MiB;
constexpr size_t WS_GATE = WS_IDX + 256 * 1024;
constexpr size_t WS_SLOT = WS_GATE + 256 * 1024;
constexpr size_t WS_A = 32 * MiB;
constexpr size_t WS_ZRNN = 100 * MiB;
constexpr size_t WS_GELU = 168 * MiB;
constexpr size_t WS_ZQ = 232 * MiB;
constexpr size_t WS_ZKVR = 248 * MiB;
constexpr size_t WS_ATTN = 232 * MiB;
constexpr size_t WS_G = 265 * MiB;
constexpr size_t WS_K = 393 * MiB;
constexpr size_t WS_VT = 444 * MiB;
constexpr size_t WS_HID = 265 * MiB;
constexpr size_t WS_Y = 100 * MiB;
constexpr int E_EARLY = 14;
constexpr size_t WS_WGU_LO = 496 * MiB;
constexpr size_t WS_WGU_MID = 96 * MiB;
constexpr size_t WS_WGU_WIN = 2 * MiB;
DEVI size_t wgu_off(int e) { return e < 8 ? WS_WGU_LO + (size_t)e * 2048 * 1024 : e < 10 ? WS_WGU_MID + (size_t)(e - 8) * 2048 * 1024 : e < E_EARLY ? WS_WGU_WIN + (size_t)(e - 10) * 2048 * 1024 : (393 * MiB) + (size_t)e * 2048 * 1024; }
constexpr size_t WS_XNB = 329 * MiB;
constexpr size_t WS_WGU = 393 * MiB;
constexpr size_t WS_WD = 480 * MiB;
constexpr size_t WS_HF = 393 * MiB;
constexpr size_t WS_END = 512 * MiB;

struct P {
    const float *x, *c, *ctx, *c_ctx, *w_ada, *b_ada, *g_norm1, *g_norm2, *w_in, *conv_w, *conv_b, *rg_wa, *rg_ba, *rg_wx, *rg_bx, *rg_lambda,
        *w_rnn_out, *g_q_lora, *w_uq, *g_kv_lora, *w_uk, *w_uv, *g_q_nope, *g_q_rope, *g_k_nope, *g_k_rope, *w_mla_out, *w_o, *w_router, *w_e_gate,
        *w_e_up, *w_e_down;
    float* out;
    unsigned char* ws;
};

DEVI unsigned f2bf(float f) { unsigned u = __float_as_uint(f); return (u + 0x7fffu + ((u >> 16) & 1u)) >> 16; }
typedef __bf16 bf16v2 __attribute__((ext_vector_type(2)));
typedef float f32x2 __attribute__((ext_vector_type(2)));
DEVI unsigned pk2(float lo, float hi) { const f32x2 v = {lo, hi}; return __builtin_bit_cast(unsigned, __builtin_convertvector(v, bf16v2)); }
DEVI float bflo(unsigned u) { return __uint_as_float(u << 16); }
DEVI float bfhi(unsigned u) { return __uint_as_float(u & 0xffff0000u); }
DEVI float bf2f(bf16_t h) { return __uint_as_float(((unsigned)h) << 16); }
template <int M> DEVI float swz_xor(float x) { return __int_as_float(__builtin_amdgcn_ds_swizzle(__float_as_int(x), (M << 10) | 0x1f)); }
typedef unsigned u32x2v __attribute__((ext_vector_type(2)));
DEVI float xor32_sum(float x) { const u32x2v r = __builtin_amdgcn_permlane32_swap(__float_as_uint(x), __float_as_uint(x), false, false); return __uint_as_float(r[0]) + __uint_as_float(r[1]); }
DEVI float xor32_get(float x, int hi) { const u32x2v r = __builtin_amdgcn_permlane32_swap(__float_as_uint(x), __float_as_uint(x), false, false); return __uint_as_float(hi ? r[0] : r[1]); }
DEVI float xor32_max(float x) { const u32x2v r = __builtin_amdgcn_permlane32_swap(__float_as_uint(x), __float_as_uint(x), false, false); return fmaxf(__uint_as_float(r[0]), __uint_as_float(r[1])); }
DEVI float wave_max(float v) { v = fmaxf(v, swz_xor<1>(v)); v = fmaxf(v, swz_xor<2>(v)); v = fmaxf(v, swz_xor<4>(v)); v = fmaxf(v, swz_xor<8>(v)); v = fmaxf(v, swz_xor<16>(v)); return xor32_max(v); }
DEVI float wave_sum(float v) { v += swz_xor<1>(v); v += swz_xor<2>(v); v += swz_xor<4>(v); v += swz_xor<8>(v); v += swz_xor<16>(v); return xor32_sum(v); }
DEVI float sigm(float x) { return __builtin_amdgcn_rcpf(1.f + __builtin_amdgcn_exp2f(-1.4426950408889634f * x)); }
DEVI float gelu_tanh(float x) { const float u = 0.7978845608028654f * (x + 0.044715f * x * x * x); return x * sigm(2.f * u); }
#define GAS __attribute__((address_space(1)))
template <class T> DEVI T* uptr(T* p) { const unsigned long long v = (unsigned long long)p; const unsigned lo = __builtin_amdgcn_readfirstlane((unsigned)v), hi = __builtin_amdgcn_readfirstlane((unsigned)(v >> 32)); return (T*)(((unsigned long long)hi << 32) | lo); }
DEVI u32x4 gld16(const void* p) { return *(const GAS u32x4*)p; }
DEVI u32x2 gld8(const void* p) { return *(const GAS u32x2*)p; }
DEVI f32x4 gldf4(const void* p) { return *(const GAS f32x4*)p; }
DEVI float gldf(const void* p) { return *(const GAS float*)p; }
DEVI void gst16(void* p, u32x4 v) { *(GAS u32x4*)p = v; }
DEVI void gst8(void* p, u32x2 v) { *(GAS u32x2*)p = v; }
DEVI void gstf4(void* p, f32x4 v) { *(GAS f32x4*)p = v; }
DEVI void store4bf(bf16_t* o, f32x4 v) { u32x2 w; w.x = pk2(v.x, v.y); w.y = pk2(v.z, v.w); gst8(o, w); }
DEVI f32x4 load4bf(const bf16_t* o) { const u32x2 w = gld8(o); return (f32x4){bflo(w.x), bfhi(w.x), bflo(w.y), bfhi(w.y)}; }
DEVI float dot8(u32x4 a, u32x4 b, float acc) {
    acc = fmaf(bflo(a.x), bflo(b.x), acc); acc = fmaf(bfhi(a.x), bfhi(b.x), acc);
    acc = fmaf(bflo(a.y), bflo(b.y), acc); acc = fmaf(bfhi(a.y), bfhi(b.y), acc);
    acc = fmaf(bflo(a.z), bflo(b.z), acc); acc = fmaf(bfhi(a.z), bfhi(b.z), acc);
    acc = fmaf(bflo(a.w), bflo(b.w), acc); acc = fmaf(bfhi(a.w), bfhi(b.w), acc);
    return acc;
}
constexpr int LDS_BYTES = 147456;
constexpr int MISC_OFF = LDS_BYTES - 512;
DEVI unsigned hw_slot_() { return (unsigned)__builtin_amdgcn_s_getreg((5 << 11) | 4) & 63u; }
DEVI int tid_() {
    extern __shared__ __attribute__((aligned(16))) unsigned char lds_dyn_[];
    int w = (int)((volatile __attribute__((address_space(3))) unsigned*)((__attribute__((address_space(3))) unsigned char*)lds_dyn_ + MISC_OFF))[32 + hw_slot_()];
    w = __builtin_amdgcn_readfirstlane(w);
    int l; asm volatile("v_mbcnt_lo_u32_b32 %0, -1, 0\n\tv_mbcnt_hi_u32_b32 %0, -1, %0" : "=v"(l));
    int t = w * 64 + l;
    asm volatile("" : "+v"(t));
    return t;
}
#define LDS_WAIT() asm volatile("s_waitcnt lgkmcnt(0)" ::: "memory")
constexpr float W8_SCALE = 64.f; constexpr int W8_MXS = 0x79797979;
DEVI unsigned pk4f8(f32x4 v) { unsigned w = __builtin_amdgcn_cvt_pk_fp8_f32(v.x, v.y, 0u, false); return __builtin_amdgcn_cvt_pk_fp8_f32(v.z, v.w, w, true); }

template <class RM>
DEVI void transpose_item(const float* W, int ldw, int K, bf16_t* WT, RM rm, float* scr, int k0, int n0, int lane, const float* kscale = nullptr, float mul = 1.f) {
#pragma unroll 8
    for (int i = 0; i < 8; ++i) { const int kk = 8 * i + (lane >> 3), c4 = (lane & 7) * 4;
        f32x4 v = gldf4(W + (size_t)(k0 + kk) * ldw + n0 + c4); if (kscale) v = v * kscale[k0 + kk]; v = v * mul;
        float* d = scr + kk * 33 + c4; d[0] = v.x; d[1] = v.y; d[2] = v.z; d[3] = v.w; }
    LDS_WAIT();
    const int c = lane & 7;
#pragma unroll
    for (int j = 0; j < 4; ++j) {
        const int n = (lane >> 3) + 8 * j; const float* s = scr + (8 * c) * 33 + n;
        u32x4 o; o.x = pk2(s[0 * 33], s[1 * 33]); o.y = pk2(s[2 * 33], s[3 * 33]); o.z = pk2(s[4 * 33], s[5 * 33]); o.w = pk2(s[6 * 33], s[7 * 33]);
        *(u32x4*)(WT + (size_t)rm(n0 + n) * K + k0 + 8 * c) = o;
    }
    LDS_WAIT();
}
struct RmId { DEVI int operator()(int n) const { return n; } };
DEVI int perm_slot(int n) { const int x = n & 31; return (n & ~31) + 16 * ((x >> 2) & 1) + 4 * (x >> 3) + (x & 3); }
struct RmPerm { DEVI int operator()(int n) const { return perm_slot(n); } };
struct RmWin { DEVI int operator()(int n) const { return perm_slot(n < 2464 ? n : n + 96); } };
struct RmUq { DEVI int operator()(int n) const { const int head = n / 96, dd = n % 96; return dd < 64 ? (head >> 2) * 256 + 128 * (dd >> 5) + 32 * (head & 3) + (dd & 31) : 512 + 128 * (head >> 2) + 32 * (head & 3) + (dd - 64); } };
struct RmUk { DEVI int operator()(int n) const { const int head = n >> 6, d = n & 63; return (head >> 2) * 256 + 128 * (d >> 5) + 32 * (head & 3) + (d & 31); } };
struct RmGU { int up; DEVI int operator()(int n) const { const int hl = n & 127, wc = hl >> 5, fq = (hl >> 3) & 3, bj = (hl >> 2) & 1, j = hl & 3; return (n >> 7) * 256 + 128 * bj + 32 * wc + 16 * up + 4 * fq + j; } };

template <class RM>
DEVI void transpose_item8(const float* W, int ldw, int K, unsigned char* WT, RM rm, float* scr, int k0, int n0, int lane) {
#pragma unroll 8
    for (int i = 0; i < 8; ++i) { const int kk = 8 * i + (lane >> 3), c4 = (lane & 7) * 4;
        const f32x4 v = gldf4(W + (size_t)(k0 + kk) * ldw + n0 + c4) * W8_SCALE;
        float* d = scr + kk * 33 + c4; d[0] = v.x; d[1] = v.y; d[2] = v.z; d[3] = v.w; }
    LDS_WAIT();
    const int c = lane & 7;
#pragma unroll
    for (int j = 0; j < 4; ++j) {
        const int n = (lane >> 3) + 8 * j; const float* sp = scr + (8 * c) * 33 + n;
        u32x2 o; o.x = pk4f8((f32x4){sp[0 * 33], sp[1 * 33], sp[2 * 33], sp[3 * 33]}); o.y = pk4f8((f32x4){sp[4 * 33], sp[5 * 33], sp[6 * 33], sp[7 * 33]});
        gst8(WT + (size_t)rm(n0 + n) * K + k0 + 8 * c, o);
    }
    LDS_WAIT();
}
DEVI void phase_prep(const P& p, int bid, int nblk, unsigned char* lds) {
    const int tid = tid_(), lane = tid & 63, wave = tid >> 6;
    float* mod = (float*)(p.ws + WS_MOD);
    if (bid < 192) {
        float* sc = (float*)lds; float* red = sc + 9 * 1024;
        for (int i = tid; i < 9 * 1024; i += NTHR) { const int r = i >> 10, k = i & 1023; const float v = r < 8 ? p.c[r * 1024 + k] : p.c_ctx[k]; sc[i] = v * sigm(v); }
        __syncthreads();
        for (int item = bid; item < 192; item += nblk) {
            const int n0 = item * 32, col = tid & 31, kg = tid >> 5;
            float acc[9];
#pragma unroll
            for (int r = 0; r < 9; ++r) acc[r] = 0.f;
            for (int kk = 0; kk < 64; kk += 16) {
                float w[16];
#pragma unroll
                for (int q = 0; q < 16; ++q) w[q] = gldf(p.w_ada + (size_t)(kg * 64 + kk + q) * 6144 + n0 + col);
#pragma unroll
                for (int q = 0; q < 16; ++q) {
                    const int k = kg * 64 + kk + q;
#pragma unroll
                    for (int r = 0; r < 9; ++r) acc[r] = fmaf(sc[r * 1024 + k], w[q], acc[r]);
                }
            }
#pragma unroll
            for (int r = 0; r < 9; ++r) red[(kg * 9 + r) * 32 + col] = acc[r];
            __syncthreads();
            if (tid < 9 * 32) { const int r = tid >> 5, cc = tid & 31; float s = 0.f; for (int g = 0; g < 16; ++g) s += red[(g * 9 + r) * 32 + cc]; mod[r * 6144 + n0 + cc] = s + p.b_ada[n0 + cc]; }
            __syncthreads();
        }
    }
    __syncthreads();
    if (bid == nblk - 1) {
        float* rope = (float*)(p.ws + WS_ROPE); float* sp = (float*)(p.ws + WS_SP); float* smax = (float*)(p.ws + WS_SMAX);
        { const int pos = tid >> 3, j = tid & 7; const float inv = powf(10000.f, -(float)j / 8.f); const float ang = (float)pos * inv;
          const float n = rintf(ang * 0.15915494309189535f); float r = fmaf(-n, 6.2831854820251465f, ang); r = fmaf(-n, -1.7484555e-7f, r);
          rope[2 * tid] = __cosf(r); rope[2 * tid + 1] = __sinf(r); }
        for (int i = tid; i < 2048; i += NTHR) { const float lam = p.rg_lambda[i]; sp[i] = 8.f * log1pf(__expf(-lam)); }
        if (tid == 0) {
            float a = 0.f, b = 0.f, cc = 0.f, d = 0.f;
            for (int i = 0; i < 64; ++i) { a = fmaxf(a, fabsf(p.g_q_nope[i])); cc = fmaxf(cc, fabsf(p.g_k_nope[i])); }
            for (int i = 0; i < 32; ++i) { b = fmaxf(b, fabsf(p.g_q_rope[i])); d = fmaxf(d, fabsf(p.g_k_rope[i])); }
            smax[0] = (64.f * a * cc + 32.f * b * d) * QSCALE * 1.01f + 0.5f;
        }
    }
    { u32x4* z = (u32x4*)(p.ws + WS_WIN + (size_t)2464 * 1024 * 2); const u32x4 zero = {0u, 0u, 0u, 0u};
      for (int i = bid * NTHR + tid; i < 96 * 1024 * 2 / 16; i += nblk * NTHR) z[i] = zero; }
    { const u32x4 zero = {0u, 0u, 0u, 0u};
      for (int i = bid * NTHR + tid; i < 1024 * 16; i += nblk * NTHR) *(u32x4*)(p.ws + WS_WUK + (size_t)(i >> 4) * 512 + 256 + (i & 15) * 16) = zero; }
    float* scr = (float*)lds + wave * (64 * 33);
    const int gw = bid * 8 + wave, NGW = nblk * 8;
    constexpr int I_WIN8 = 16 * 64;
    for (int it = gw; it < I_WIN8; it += NGW)
        transpose_item8(p.w_in + 2464, 4512, 1024, p.ws + WS_WIN8, RmPerm(), scr, 64 * (it / 64), 32 * (it % 64), lane);
    constexpr int I_WIN = 16 * 141, I_RNN = 16 * 32, I_MLA = 8 * 32, I_WO = 16 * 32, I_RG = 32 * 8, I_UQ = 4 * 24, I_UK = 2 * 16, I_UV = 2 * 16;
    for (int it = gw; it < I_WIN + I_RNN + I_MLA + I_WO + I_RG + I_UQ + I_UK + I_UV; it += NGW) {
        int r = it;
        if (r < I_UQ) { transpose_item(p.w_uq, 768, 256, (bf16_t*)(p.ws + WS_WUQ), RmUq(), scr, 64 * (r / 24), 32 * (r % 24), lane, p.g_q_lora); continue; } r -= I_UQ;
        if (r < I_UK) { transpose_item(p.w_uk, 512, 256, (bf16_t*)(p.ws + WS_WUK), RmUk(), scr, 64 * (r / 16), 32 * (r % 16), lane, p.g_kv_lora); continue; } r -= I_UK;
        if (r < I_UV) { transpose_item(p.w_uv, 512, 256, (bf16_t*)(p.ws + WS_WUV), RmId(), scr, 64 * (r / 16), 32 * (r % 16), lane, p.g_kv_lora); continue; } r -= I_UV;
        if (r < I_RG) { const int mi = r >> 3, sub = r & 7; const float* src = ((mi >> 4) ? p.rg_wx : p.rg_wa) + (size_t)(mi & 15) * 16384;
            transpose_item(src, 128, 128, (bf16_t*)(p.ws + WS_WRG) + (size_t)mi * 16384, RmId(), scr, 64 * (sub >> 2), 32 * (sub & 3), lane, nullptr, -1.4426950408889634f); continue; } r -= I_RG;
        if (r < I_WIN) { transpose_item(p.w_in, 4512, 1024, (bf16_t*)(p.ws + WS_WIN), RmWin(), scr, 64 * (r / 141), 32 * (r % 141), lane); continue; } r -= I_WIN;
        if (r < I_RNN) { transpose_item(p.w_rnn_out, 1024, 1024, (bf16_t*)(p.ws + WS_WRNN), RmPerm(), scr, 64 * (r / 32), 32 * (r % 32), lane); continue; } r -= I_RNN;
        if (r < I_MLA) { transpose_item(p.w_mla_out, 1024, 512, (bf16_t*)(p.ws + WS_WMLA), RmPerm(), scr, 64 * (r / 32), 32 * (r % 32), lane); continue; } r -= I_MLA;
        transpose_item(p.w_o, 1024, 1024, (bf16_t*)(p.ws + WS_WO), RmPerm(), scr, 64 * (r / 32), 32 * (r % 32), lane);
    }
}

DEVI void phase_expert_convert(const P& p, int part, int b0, int bid, int nblk, unsigned char* lds, int e0 = 0, int e1 = 16) {
    const int tid = tid_(), lane = tid & 63, wave = tid >> 6;
    float* scr = (float*)lds + wave * (64 * 33);
    const int gw = (bid - b0) * 8 + wave, NGW = (nblk - b0) * 8;
    if (bid < b0) return;
    if (part == 0) {
        const int ne = e1 - e0;
        for (int it = gw; it < 2 * ne * 512; it += NGW) {
            const int which = it / (ne * 512), r = it % (ne * 512), e = e0 + r / 512, t = r % 512, k0 = 64 * (t / 32), n0 = 32 * (t % 32);
            if (which == 0) transpose_item8(p.w_e_gate + (size_t)e * 1048576, 1024, 1024, p.ws + wgu_off(e), RmGU{0}, scr, k0, n0, lane);
            else transpose_item8(p.w_e_up + (size_t)e * 1048576, 1024, 1024, p.ws + wgu_off(e), RmGU{1}, scr, k0, n0, lane);
        }
    } else {
        for (int it = gw; it < 16 * 512; it += NGW) {
            const int e = it / 512, t = it % 512, k0 = 64 * (t / 32), n0 = 32 * (t % 32);
            transpose_item8(p.w_e_down + (size_t)e * 1048576, 1024, 1024, p.ws + WS_WD + (size_t)e * 1024 * 1024, RmPerm(), scr, k0, n0, lane);
        }
    }
}

DEVI void phase_norm1(const P& p, int bid, int nblk) {
    const int tid = tid_(), lane = tid & 63, wave = tid >> 6;
    const float* mod = (const float*)(p.ws + WS_MOD);
    bf16_t* A1 = (bf16_t*)(p.ws + WS_A);
    const int NGW = nblk * 8, per = (NROW + NGW - 1) / NGW, m0 = (bid * 8 + wave) * per, m1 = (m0 + per < NROW) ? m0 + per : NROW;
    if (m0 >= m1) return;
#define N1_SRC(m_) ((m_) < NLAT ? p.x + (size_t)(m_) * 1024 : p.ctx + (size_t)((m_) - NLAT) * 1024)
    f32x4 vn[4];
#pragma unroll
    for (int j = 0; j < 4; ++j) vn[j] = gldf4(N1_SRC(m0) + 4 * (lane + 64 * j));
    int mrc = -1; f32x4 gs[4], sh[4];
    for (int m = m0; m < m1; ++m) {
        f32x4 v[4];
#pragma unroll
        for (int j = 0; j < 4; ++j) v[j] = vn[j];
        if (m + 1 < m1) {
#pragma unroll
            for (int j = 0; j < 4; ++j) vn[j] = gldf4(N1_SRC(m + 1) + 4 * (lane + 64 * j));
        }
        const int mr = m < NLAT ? (m >> 12) : 8;
        if (mr != mrc) { mrc = mr;
#pragma unroll
            for (int j = 0; j < 4; ++j) { const int k = 4 * (lane + 64 * j); gs[j] = gldf4(p.g_norm1 + k) * (gldf4(mod + mr * 6144 + 1024 + k) + 1.f); sh[j] = gldf4(mod + mr * 6144 + k); } }
        float s = 0.f;
#pragma unroll
        for (int j = 0; j < 4; ++j) s += v[j].x * v[j].x + v[j].y * v[j].y + v[j].z * v[j].z + v[j].w * v[j].w;
        const float rstd = rsqrtf(wave_sum(s) * (1.f / 1024.f) + EPS);
        bf16_t* o = A1 + (size_t)m * 1024 + 4 * lane; unsigned char* o8 = p.ws + WS_A18 + (size_t)m * 1024 + 4 * lane;
#pragma unroll
        for (int j = 0; j < 4; ++j) { const f32x4 y = v[j] * rstd * gs[j] + sh[j]; store4bf(o + 256 * j, y); if (m < NLAT) *(GAS unsigned*)(o8 + 256 * j) = pk4f8(y); }
    }
#undef N1_SRC
}

#define LAS __attribute__((address_space(3)))
typedef short bf16x8 __attribute__((ext_vector_type(8)));
typedef int i32x8 __attribute__((ext_vector_type(8)));
typedef int i32x4 __attribute__((ext_vector_type(4)));
typedef float f32x16 __attribute__((ext_vector_type(16)));
typedef short s16x4 __attribute__((ext_vector_type(4)));
namespace fg {
constexpr int HTB = 128 * 64 * 2;
DEVI int lds_byte(int r, int c) { const int st = (r >> 4) * 2 + (c >> 5), rr = r & 15, cc = c & 31, ob = rr * 64 + cc * 2; return st * 1024 + (ob ^ (((ob >> 9) & 1) << 5)); }
DEVI void stage_rc(int b, int& R, int& C) { const int st = b / 1024, sb = b % 1024, swz = sb ^ (((sb >> 9) & 1) << 5); R = (st >> 1) * 16 + swz / 64; C = (st & 1) * 32 + (swz % 64) / 2; }
}
template <class G>
DEVI void gemm_fast(const G& g, int bid, int nblk, LAS unsigned char* lds) {
    using namespace fg;
    const int tid = tid_(), wid = __builtin_amdgcn_readfirstlane(tid >> 6), lane = tid & 63, wr = wid >> 2, wc = wid & 3, fr = lane & 15, fq = lane >> 4;
    int R0, C0, R1, C1; stage_rc(tid * 16, R0, C0); stage_rc(tid * 16 + 8192, R1, C1);
    const unsigned ldsw = (unsigned)wid * 1024u;
    const int aoff = lds_byte(wr * 64 + fr, fq * 8), boff = lds_byte(wc * 32 + fr, fq * 8);
#define FG_SA(b, h) (((b) * 2 + (h)) * HTB)
#define FG_SB(b, h) ((4 + (b) * 2 + (h)) * HTB)
#define FG_GLDS(src, dstoff) __builtin_amdgcn_global_load_lds((const unsigned*)(src), (LAS unsigned*)(lds + (dstoff)), 16, 0, 0)
#define FG_STAGE_A(bufoff, h, kt) do { const char* _b = xA + (size_t)(kt) * 128 + (G::GATHER ? (size_t)0 : (size_t)(h) * hstepA); FG_GLDS(_b + oA[G::GATHER ? (h) : 0][0], (bufoff) + ldsw); FG_GLDS(_b + oA[G::GATHER ? (h) : 0][1], (bufoff) + ldsw + 8192); } while (0)
#define FG_STAGE_B(bufoff, h, kt) do { const char* _b = xB + (size_t)(h) * hstepB + (size_t)(kt) * 128; FG_GLDS(_b + oB[0], (bufoff) + ldsw); FG_GLDS(_b + oB[1], (bufoff) + ldsw + 8192); } while (0)
#define FG_LDA(dst, b, h) do { _Pragma("unroll") for (int m = 0; m < 4; ++m) { if constexpr (G::FP8) { \
        const i32x4 lo_ = *(const LAS i32x4*)(lds + FG_SA(b, h) + aoff + m * 2048), hi_ = *(const LAS i32x4*)(lds + FG_SA(b, h) + aoff + m * 2048 + 1024); dst##8[m] = __builtin_shufflevector(lo_, hi_, 0, 1, 2, 3, 4, 5, 6, 7); } \
        else { _Pragma("unroll") for (int k = 0; k < 2; ++k) dst[m][k] = *(const LAS bf16x8*)(lds + FG_SA(b, h) + aoff + m * 2048 + k * 1024); } } } while (0)
#define FG_LDB(dst, b, h) do { _Pragma("unroll") for (int n = 0; n < 2; ++n) { if constexpr (G::FP8) { \
        const i32x4 lo_ = *(const LAS i32x4*)(lds + FG_SB(b, h) + boff + n * 2048), hi_ = *(const LAS i32x4*)(lds + FG_SB(b, h) + boff + n * 2048 + 1024); dst##8[n] = __builtin_shufflevector(lo_, hi_, 0, 1, 2, 3, 4, 5, 6, 7); } \
        else { _Pragma("unroll") for (int k = 0; k < 2; ++k) dst[n][k] = *(const LAS bf16x8*)(lds + FG_SB(b, h) + boff + n * 2048 + k * 1024); } } } while (0)
#define FG_MMA(ai, bj, At, Bt) do { __builtin_amdgcn_s_setprio(1); _Pragma("unroll") for (int m = 0; m < 4; ++m) _Pragma("unroll") for (int n = 0; n < 2; ++n) { \
        if constexpr (G::FP8) {   \
            acc[ai][bj][m][n] = __builtin_amdgcn_mfma_scale_f32_16x16x128_f8f6f4(Bt##8[n], At##8[m], acc[ai][bj][m][n], 0, 0, 0, G::SCALE_W, 0, 0x7F7F7F7F); \
        } else { _Pragma("unroll") for (int k = 0; k < 2; ++k) acc[ai][bj][m][n] = __builtin_amdgcn_mfma_f32_16x16x32_bf16(Bt[n][k], At[m][k], acc[ai][bj][m][n], 0, 0, 0); } } \
        if constexpr (G::FP8) asm volatile("" : "+v"(acc[ai][bj][0][0]), "+v"(acc[ai][bj][0][1]), "+v"(acc[ai][bj][1][0]), "+v"(acc[ai][bj][1][1]), "+v"(acc[ai][bj][2][0]), "+v"(acc[ai][bj][2][1]), "+v"(acc[ai][bj][3][0]), "+v"(acc[ai][bj][3][1]));     \
        __builtin_amdgcn_s_setprio(0); } while (0)
#define FG_WAIT_V(n) asm volatile("s_waitcnt vmcnt(" #n ")" ::: "memory")
#define FG_WAIT_L(n) asm volatile("s_waitcnt lgkmcnt(" #n ")" ::: "memory")
#define FG_BAR __builtin_amdgcn_s_barrier()
#define FG_SCHED __builtin_amdgcn_sched_barrier(0)
#define FG_SCHED8 do { if constexpr (G::FP8) __builtin_amdgcn_sched_barrier(0); } while (0)
#define FG_SETCTX(U_) do { xA = g.abase(U_); xB = g.bbase(U_); const int _K = g.K(U_); \
        oA[0][0] = g.arow_off(U_, R0) + (unsigned)C0 * 2u; oA[0][1] = g.arow_off(U_, R1) + (unsigned)C1 * 2u; \
        if (G::GATHER) { oA[1][0] = g.arow_off(U_, 128 + R0) + (unsigned)C0 * 2u; oA[1][1] = g.arow_off(U_, 128 + R1) + (unsigned)C1 * 2u; } else hstepA = (size_t)128 * _K * 2; \
        oB[0] = (unsigned)(R0 * _K + C0) * 2u; oB[1] = (unsigned)(R1 * _K + C1) * 2u; hstepB = (size_t)128 * _K * 2; } while (0)
    typename G::U cur, nxt; int ui = 0;
    if (!g.sched(0, bid, nblk, cur)) return;
    f32x4 acc[2][2][4][2];
#pragma unroll
    for (int a = 0; a < 2; ++a)
#pragma unroll
        for (int b = 0; b < 2; ++b)
#pragma unroll
            for (int m = 0; m < 4; ++m)
#pragma unroll
                for (int n = 0; n < 2; ++n) acc[a][b][m][n] = (f32x4){0.f, 0.f, 0.f, 0.f};
    bf16x8 At[4][2], B0[2][2], B1[2][2]; i32x8 At8[4], B08[2], B18[2];
    const char* xA; const char* xB; unsigned oA[2][2], oB[2]; size_t hstepB, hstepA = 0;
    FG_SETCTX(cur);
    int nt = g.K(cur) / 64;
    FG_STAGE_B(FG_SB(0, 0), 0, 0); FG_STAGE_A(FG_SA(0, 0), 0, 0); FG_STAGE_B(FG_SB(0, 1), 1, 0); FG_STAGE_A(FG_SA(0, 1), 1, 0);
    if (wr == 1) FG_BAR;
    FG_WAIT_V(4); FG_BAR;
    FG_STAGE_B(FG_SB(1, 0), 0, 1); FG_STAGE_A(FG_SA(1, 0), 0, 1); FG_STAGE_B(FG_SB(1, 1), 1, 1);
    FG_WAIT_V(6); FG_BAR;
    for (;;) {
        const bool has_next = g.sched(ui + 1, bid, nblk, nxt);
        unsigned oAn[2][2] = {{0u, 0u}, {0u, 0u}};
        if constexpr (G::GATHER) { if (has_next) { oAn[0][0] = g.arow_off(nxt, R0) + (unsigned)C0 * 2u; oAn[0][1] = g.arow_off(nxt, R1) + (unsigned)C1 * 2u; oAn[1][0] = g.arow_off(nxt, 128 + R0) + (unsigned)C0 * 2u; oAn[1][1] = g.arow_off(nxt, 128 + R1) + (unsigned)C1 * 2u; } }
        for (int t = 0; t < nt; t += 2) {
            const bool last = (t == nt - 2);
            FG_LDB(B0, 0, 0); FG_SCHED; FG_LDA(At, 0, 0); FG_STAGE_A(FG_SA(1, 1), 1, t + 1);
            FG_WAIT_L(8); FG_BAR; FG_WAIT_L(0); FG_SCHED8; FG_MMA(0, 0, At, B0); FG_BAR; FG_SCHED;
            int t2 = t + 2;
            if (last) { t2 = 0; if (has_next) { if constexpr (G::GATHER) { xA = g.abase(nxt); xB = g.bbase(nxt); const int _K = g.K(nxt); oA[0][0] = oAn[0][0]; oA[0][1] = oAn[0][1]; oA[1][0] = oAn[1][0]; oA[1][1] = oAn[1][1];
                        oB[0] = (unsigned)(R0 * _K + C0) * 2u; oB[1] = (unsigned)(R1 * _K + C1) * 2u; hstepB = (size_t)128 * _K * 2; } else { FG_SETCTX(nxt); } } }
            FG_LDB(B1, 0, 1); FG_STAGE_B(FG_SB(0, 0), 0, t2);
            FG_BAR; FG_WAIT_L(0); FG_SCHED8; FG_MMA(0, 1, At, B1); FG_BAR; FG_SCHED8;
            FG_LDA(At, 0, 1); FG_STAGE_A(FG_SA(0, 0), 0, t2);
            FG_BAR; FG_WAIT_L(0); FG_SCHED8; FG_MMA(1, 0, At, B0); FG_BAR; FG_SCHED;
            FG_STAGE_B(FG_SB(0, 1), 1, t2);
            FG_WAIT_V(6); FG_BAR; FG_SCHED8; FG_MMA(1, 1, At, B1); FG_BAR; FG_SCHED8;
            FG_LDB(B0, 1, 0); FG_SCHED; FG_LDA(At, 1, 0); FG_STAGE_A(FG_SA(0, 1), 1, t2);
            FG_WAIT_L(8); FG_BAR; FG_WAIT_L(0); FG_SCHED8; FG_MMA(0, 0, At, B0); FG_BAR; FG_SCHED;
            FG_LDB(B1, 1, 1); FG_STAGE_B(FG_SB(1, 0), 0, t2 + 1);
            FG_BAR; FG_WAIT_L(0); FG_SCHED8; FG_MMA(0, 1, At, B1); FG_BAR; FG_SCHED8;
            FG_LDA(At, 1, 1); FG_STAGE_A(FG_SA(1, 0), 0, t2 + 1);
            FG_BAR; FG_WAIT_L(0); FG_SCHED8; FG_MMA(1, 0, At, B0); FG_BAR; FG_SCHED;
            FG_STAGE_B(FG_SB(1, 1), 1, t2 + 1);
            FG_WAIT_V(6); FG_BAR; FG_SCHED8; FG_MMA(1, 1, At, B1); FG_BAR; FG_SCHED8;
        }
        const int te_ = tid_();
        const int rbase_ = 64 * ((te_ >> 8) & 1) + (te_ & 15), cb_ = 32 * ((te_ >> 6) & 3) + 4 * ((te_ >> 4) & 3);
#pragma unroll
        for (int bt = 0; bt < 8 / G::EPI_FENCE; ++bt) {
            typename G::Pre pre[G::EPI_FENCE];
#pragma unroll
            for (int q = 0; q < G::EPI_FENCE; ++q) { const int rw = bt * G::EPI_FENCE + q, ai = rw >> 2, m = rw & 3; g.pre(cur, rbase_ + 128 * ai + 16 * m, cb_, pre[q]); }
#pragma unroll
            for (int q = 0; q < G::EPI_FENCE; ++q) { const int rw = bt * G::EPI_FENCE + q, ai = rw >> 2, m = rw & 3;
                if constexpr (G::KEEP) {
                    if (g.keep(cur)) g.mid4(cur, rbase_ + 128 * ai + 16 * m, cb_, acc[ai][0][m][0], acc[ai][0][m][1], acc[ai][1][m][0], acc[ai][1][m][1], pre[q]);
                    else g.epi4(cur, rbase_ + 128 * ai + 16 * m, cb_, acc[ai][0][m][0], acc[ai][0][m][1], acc[ai][1][m][0], acc[ai][1][m][1], pre[q]);
                } else g.epi4(cur, rbase_ + 128 * ai + 16 * m, cb_, acc[ai][0][m][0], acc[ai][0][m][1], acc[ai][1][m][0], acc[ai][1][m][1], pre[q]); }
            asm volatile("" ::: "memory");
        }
        if (!has_next) break;
        bool zero_ = true; if constexpr (G::KEEP) zero_ = !g.keep(cur);
        if (zero_) {
#pragma unroll
        for (int a = 0; a < 2; ++a)
#pragma unroll
            for (int b = 0; b < 2; ++b)
#pragma unroll
                for (int m = 0; m < 4; ++m)
#pragma unroll
                    for (int n = 0; n < 2; ++n) acc[a][b][m][n] = (f32x4){0.f, 0.f, 0.f, 0.f};
        }
        cur = nxt; nt = g.K(cur) / 64; ++ui;
    }
    FG_WAIT_V(0);
    if (wr == 0) FG_BAR;
    FG_BAR;
#undef FG_SA
#undef FG_SB
#undef FG_GLDS
#undef FG_STAGE_A
#undef FG_STAGE_B
#undef FG_LDA
#undef FG_LDB
#undef FG_MMA
#undef FG_WAIT_V
#undef FG_WAIT_L
#undef FG_BAR
#undef FG_SCHED
#undef FG_SCHED8
#undef FG_SETCTX
}

DEVI bool tile_order(int i, int bid, int nblk, int nM, int nN, int& pm, int& pn) {
    const int nwg = nM * nN; const long L = (long)i * nblk + bid; if (L >= nwg) return false;
    int wgid = (int)L; { const int q = nwg / 8, r = nwg % 8, xcd = wgid % 8, off = wgid / 8; wgid = (xcd < r ? xcd * (q + 1) : r * (q + 1) + (xcd - r) * q) + off; }
    const int nig = 8 * nN, gid = wgid / nig, fm = gid * 8, gsz = (nM - fm) < 8 ? (nM - fm) : 8;
    pm = fm + ((wgid % nig) % gsz); pn = (wgid % nig) / gsz; return true;
}
DEVI int xcd_contig(int i, int bid, int nblk, int nwg) {
    const long L = (long)i * nblk + bid; if (L >= nwg) return -1;
    return ((int)L % 8) * (nwg / 8) + (int)L / 8;
}
struct NoPre {};
DEVI int col8(int cb) { return (cb & ~31) + 2 * (cb & 31); }
DEVI void store8bf(bf16_t* o, f32x4 a, f32x4 b) { u32x4 w; w.x = pk2(a.x, a.y); w.y = pk2(a.z, a.w); w.z = pk2(b.x, b.y); w.w = pk2(b.z, b.w); gst16(o, w); }
DEVI void unpack8bf(u32x4 w, f32x4& a, f32x4& b) { a = (f32x4){bflo(w.x), bfhi(w.x), bflo(w.y), bfhi(w.y)}; b = (f32x4){bflo(w.z), bfhi(w.z), bflo(w.w), bfhi(w.w)}; }
DEVI f32x4 gelu4(f32x4 v) { return (f32x4){gelu_tanh(v.x), gelu_tanh(v.y), gelu_tanh(v.z), gelu_tanh(v.w)}; }
DEVI f32x4 sigm4(f32x4 v) { return (f32x4){sigm(v.x), sigm(v.y), sigm(v.z), sigm(v.w)}; }

struct G1 {
    static constexpr bool FP8 = false; static constexpr int SCALE_W = 0;
    static constexpr int EPI_FENCE = 8;
    static constexpr bool GATHER = false; static constexpr bool KEEP = false;
    const bf16_t* A; const bf16_t* Bt; bf16_t *zrnn, *zgelu, *zq, *zkvr, *g;
    struct U { int pm, pn; };
    DEVI bool sched(int i, int bid, int nblk, U& r) const {
        if (tile_order(i, bid, nblk, 128, 10, r.pm, r.pn)) return true;
        const int v = i * nblk + bid - 1280; if (v >= 40) return false;
        const int j = v % 5; r.pm = 128 + v / 5; r.pn = j < 4 ? j : 9; return true; }
    DEVI int K(const U&) const { return 1024; }
    DEVI const char* abase(const U& u) const { return (const char*)(A + (size_t)u.pm * 256 * 1024); }
    DEVI unsigned arow_off(const U&, int r) const { return (unsigned)r * 2048u; }
    DEVI const char* bbase(const U& u) const { return (const char*)(Bt + (size_t)u.pn * 256 * 1024); }
    typedef NoPre Pre;
    DEVI void pre(const U&, int, int, Pre&) const {}
    DEVI void epi4(const U& u, int r, int cb, f32x4 a, f32x4 b, f32x4 c, f32x4 d, const Pre&) const { const int c8 = col8(cb); epi8(u, r, c8, a, b); epi8(u, r, 128 + c8, c, d); }
    DEVI void epi8(const U& u, int r, int c, f32x4 v0, f32x4 v1) const {
        const size_t row = (size_t)u.pm * 256 + r;
        if (u.pn < 4) store8bf(zrnn + row * 1024 + u.pn * 256 + c, v0, v1);
        else if (u.pn < 8) store8bf(zgelu + row * 1024 + (u.pn - 4) * 256 + c, gelu4(v0), gelu4(v1));
        else if (u.pn == 8) store8bf(zq + row * 256 + c, v0, v1);
        else if (u.pn == 9) store8bf(zkvr + row * 256 + c, v0, v1);
        else store8bf(g + row * 2048 + (u.pn - 10) * 256 + c, sigm4(v0), sigm4(v1));
    }
};

DEVI unsigned pk4u8(f32x4 g) { const f32x4 v = g * 255.f; unsigned w = __builtin_amdgcn_cvt_pk_u8_f32(v.x, 0u, 0u); w = __builtin_amdgcn_cvt_pk_u8_f32(v.y, 1u, w); w = __builtin_amdgcn_cvt_pk_u8_f32(v.z, 2u, w); return __builtin_amdgcn_cvt_pk_u8_f32(v.w, 3u, w); }
DEVI f32x4 un4u8(unsigned w) { return (f32x4){(float)(w & 0xffu), (float)((w >> 8) & 0xffu), (float)((w >> 16) & 0xffu), (float)(w >> 24)} * (1.f / 255.f); }
struct G1g {
    static constexpr bool FP8 = true; static constexpr int SCALE_W = W8_MXS;
    static constexpr int EPI_FENCE = 8;
    static constexpr bool GATHER = false; static constexpr bool KEEP = false;
    const unsigned char *A8, *W8; bf16_t* g;
    struct U { int pm, pn; };
    DEVI bool sched(int i, int bid, int nblk, U& r) const { return tile_order(i, bid, nblk, 128, 8, r.pm, r.pn); }
    DEVI int K(const U&) const { return 512; }
    DEVI const char* abase(const U& u) const { return (const char*)(A8 + (size_t)u.pm * 256 * 1024); }
    DEVI unsigned arow_off(const U&, int r) const { return (unsigned)r * 1024u; }
    DEVI const char* bbase(const U& u) const { return (const char*)(W8 + (size_t)u.pn * 256 * 1024); }
    typedef NoPre Pre;
    DEVI void pre(const U&, int, int, Pre&) const {}
    DEVI void epi4(const U& u, int r, int cb, f32x4 a, f32x4 b, f32x4 c, f32x4 d, const Pre&) const {
        unsigned char* o = (unsigned char*)g + ((size_t)u.pm * 256 + r) * 2048 + u.pn * 256 + col8(cb);
        gst8(o, (u32x2){pk4u8(sigm4(a)), pk4u8(sigm4(b))}); gst8(o + 128, (u32x2){pk4u8(sigm4(c)), pk4u8(sigm4(d))});
    }
};

DEVI f32x4 clamp_gate(f32x4 g) { return (f32x4){fmaxf(g.x, 1e-30f), fmaxf(g.y, 1e-30f), fmaxf(g.z, 1e-30f), fmaxf(g.w, 1e-30f)}; }
struct G2 {
    static constexpr bool FP8 = false; static constexpr int SCALE_W = 0;
    static constexpr int EPI_FENCE = 4;
    static constexpr bool GATHER = false; static constexpr bool KEEP = true;
    const bf16_t *rnn, *attn, *WrT, *WmT, *g; bf16_t* merged;
    struct U { int pm, pn, sub; };
    DEVI bool keep(const U& u) const { return u.sub == 0; }
    DEVI bool sched(int i, int bid, int nblk, U& r) const { r.sub = i & 1; return tile_order(i >> 1, bid, nblk, 128, 4, r.pm, r.pn); }
    DEVI int K(const U& u) const { return u.sub ? 1024 : 512; }
    DEVI const char* abase(const U& u) const { return u.sub ? (const char*)(rnn + (size_t)u.pm * 256 * 1024) : (const char*)(attn + (size_t)u.pm * 256 * 512); }
    DEVI unsigned arow_off(const U& u, int r) const { return (unsigned)r * (u.sub ? 2048u : 1024u); }
    DEVI const char* bbase(const U& u) const { return u.sub ? (const char*)(WrT + (size_t)u.pn * 256 * 1024) : (const char*)(WmT + (size_t)u.pn * 256 * 512); }
    struct Pre { u32x2 g[2], m[2]; };
    DEVI void pre(const U& u, int r, int cb, Pre& q) const {
        const size_t row = (size_t)u.pm * 256 + r; const int col = u.pn * 256 + col8(cb);
        const unsigned char* gb = (const unsigned char*)g + row * 2048 + col;
        q.g[0] = gld8(gb); q.g[1] = gld8(gb + 128);
        if (!u.sub) { q.m[0] = gld8(gb + 1024); q.m[1] = gld8(gb + 1024 + 128); }
    }
    DEVI void mid4(const U&, int, int, f32x4& a, f32x4& b, f32x4& c, f32x4& d, const Pre& q) const {
        f32x4 g0 = un4u8(q.g[0].x), g1 = un4u8(q.g[0].y), h0 = un4u8(q.g[1].x), h1 = un4u8(q.g[1].y), p0 = un4u8(q.m[0].x), p1 = un4u8(q.m[0].y), p2 = un4u8(q.m[1].x), p3 = un4u8(q.m[1].y);
        g0 = clamp_gate(g0); g1 = clamp_gate(g1); h0 = clamp_gate(h0); h1 = clamp_gate(h1);
        a = a * p0 * (f32x4){__builtin_amdgcn_rcpf(g0.x), __builtin_amdgcn_rcpf(g0.y), __builtin_amdgcn_rcpf(g0.z), __builtin_amdgcn_rcpf(g0.w)};
        b = b * p1 * (f32x4){__builtin_amdgcn_rcpf(g1.x), __builtin_amdgcn_rcpf(g1.y), __builtin_amdgcn_rcpf(g1.z), __builtin_amdgcn_rcpf(g1.w)};
        c = c * p2 * (f32x4){__builtin_amdgcn_rcpf(h0.x), __builtin_amdgcn_rcpf(h0.y), __builtin_amdgcn_rcpf(h0.z), __builtin_amdgcn_rcpf(h0.w)};
        d = d * p3 * (f32x4){__builtin_amdgcn_rcpf(h1.x), __builtin_amdgcn_rcpf(h1.y), __builtin_amdgcn_rcpf(h1.z), __builtin_amdgcn_rcpf(h1.w)};
    }
    DEVI void epi4(const U& u, int r, int cb, f32x4 a, f32x4 b, f32x4 c, f32x4 d, const Pre& q) const {
        const size_t row = (size_t)u.pm * 256 + r; const int col = u.pn * 256 + col8(cb);
        bf16_t* o = merged + row * 1024 + col;
        const f32x4 g0 = un4u8(q.g[0].x), g1 = un4u8(q.g[0].y), h0 = un4u8(q.g[1].x), h1 = un4u8(q.g[1].y);
        store8bf(o, clamp_gate(g0) * a, clamp_gate(g1) * b); store8bf(o + 128, clamp_gate(h0) * c, clamp_gate(h1) * d);
    }
};

struct G3 {
    static constexpr bool FP8 = false; static constexpr int SCALE_W = 0;
    static constexpr int EPI_FENCE = 4;
    static constexpr bool GATHER = false; static constexpr bool KEEP = false;
    const bf16_t *A, *Bt; const float *x, *mod; bf16_t* out;
    struct U { int pm, pn; };
    DEVI bool sched(int i, int bid, int nblk, U& r) const { return tile_order(i, bid, nblk, 128, 4, r.pm, r.pn); }
    DEVI int K(const U&) const { return 1024; }
    DEVI const char* abase(const U& u) const { return (const char*)(A + (size_t)u.pm * 256 * 1024); }
    DEVI unsigned arow_off(const U&, int r) const { return (unsigned)r * 2048u; }
    DEVI const char* bbase(const U& u) const { return (const char*)(Bt + (size_t)u.pn * 256 * 1024); }
    struct Pre { f32x4 x[4]; };
    DEVI void pre(const U& u, int r, int cb, Pre& q) const {
        const float* xp = x + ((size_t)u.pm * 256 + r) * 1024 + u.pn * 256 + col8(cb);
        q.x[0] = gldf4(xp); q.x[1] = gldf4(xp + 4); q.x[2] = gldf4(xp + 128); q.x[3] = gldf4(xp + 132);
    }
    DEVI void epi4(const U& u, int r, int cb, f32x4 a, f32x4 b, f32x4 c, f32x4 d, const Pre& q) const {
        const size_t row = (size_t)u.pm * 256 + r; const int col = u.pn * 256 + col8(cb);
        const float* mp = mod + (u.pm >> 4) * 6144 + 2048 + col; bf16_t* o = out + row * 1024 + col;
        store8bf(o, q.x[0] + gldf4(mp) * a, q.x[1] + gldf4(mp + 4) * b);
        store8bf(o + 128, q.x[2] + gldf4(mp + 128) * c, q.x[3] + gldf4(mp + 132) * d);
    }
};

struct GM1 {
    static constexpr int EPI_FENCE = 8;
    static constexpr bool GATHER = true; static constexpr bool KEEP = false;
    static constexpr bool FP8 = true; static constexpr int SCALE_W = W8_MXS;
    const unsigned char *h8, *Wgu8; const int* idx; unsigned char* hid8;
    struct U { int be, pm, pn; };
    DEVI bool sched(int i, int bid, int nblk, U& r) const { const int w = xcd_contig(i, bid, nblk, 128 * 16); if (w < 0) return false;
        const int pair = w >> 4, e = pair >> 3, b = pair & 7; r.be = b * 16 + e; r.pm = w & 1; r.pn = (w >> 1) & 7; return true; }
    DEVI int K(const U&) const { return 512; }
    DEVI const char* abase(const U& u) const { return (const char*)(h8 + (size_t)(u.be >> 4) * 4096 * 1024); }
    DEVI unsigned arow_off(const U& u, int r) const { return (unsigned)idx[u.be * 512 + u.pm * 256 + r] * 1024u; }
    DEVI const char* bbase(const U& u) const { return (const char*)(Wgu8 + wgu_off(u.be & 15) + (size_t)u.pn * 256 * 1024); }
    typedef NoPre Pre;
    DEVI void pre(const U&, int, int, Pre&) const {}
    DEVI void epi4(const U& u, int r, int cb, f32x4 g0, f32x4 u0, f32x4 g1, f32x4 u1, const Pre&) const {
        const int hidx = u.pn * 128 + (cb & ~31) + 2 * (cb & 31);
        u32x2 w; w.x = pk4f8(g0 * sigm4(g0) * u0); w.y = pk4f8(g1 * sigm4(g1) * u1);
        gst8(hid8 + ((size_t)u.be * 512 + u.pm * 256 + r) * 1024 + hidx, w);
    }
};

struct GM2 {
    static constexpr int EPI_FENCE = 8;
    static constexpr bool GATHER = false; static constexpr bool KEEP = false;
    static constexpr bool FP8 = true; static constexpr int SCALE_W = W8_MXS;
    const unsigned char *hid8, *Wd8; const float* gate; bf16_t* Y;
    struct U { int be, pm, pn; };
    DEVI bool sched(int i, int bid, int nblk, U& r) const { const int w = xcd_contig(i, bid, nblk, 128 * 8); if (w < 0) return false;
        const int pair = w >> 3, e = pair >> 3, b = pair & 7; r.be = b * 16 + e; r.pm = w & 1; r.pn = (w >> 1) & 3; return true; }
    DEVI int K(const U&) const { return 512; }
    DEVI const char* abase(const U& u) const { return (const char*)(hid8 + ((size_t)u.be * 512 + u.pm * 256) * 1024); }
    DEVI unsigned arow_off(const U&, int r) const { return (unsigned)r * 1024u; }
    DEVI const char* bbase(const U& u) const { return (const char*)(Wd8 + ((size_t)(u.be & 15) * 1024 + u.pn * 256) * 1024); }
    struct Pre { float gt; };
    DEVI void pre(const U& u, int r, int, Pre& q) const { q.gt = gldf(gate + (size_t)u.be * 512 + u.pm * 256 + r); }
    DEVI void epi4(const U& u, int r, int cb, f32x4 a, f32x4 b, f32x4 c, f32x4 d, const Pre& q) const {
        unsigned char* o = (unsigned char*)Y + ((size_t)u.be * 512 + u.pm * 256 + r) * 1024 + u.pn * 256 + col8(cb);
        const float gs = q.gt * 64.f;
        gst8(o, (u32x2){pk4f8(a * gs), pk4f8(b * gs)}); gst8(o + 128, (u32x2){pk4f8(c * gs), pk4f8(d * gs)});
    }
};

DEVI float dot4(f32x4 a) { return a.x * a.x + a.y * a.y + a.z * a.z + a.w * a.w; }
struct GP4 {
    static constexpr bool FP8 = false; static constexpr int SCALE_W = 0;
    static constexpr int EPI_FENCE = 4;
    static constexpr bool GATHER = false; static constexpr bool KEEP = false;
    unsigned char* ws; const LAS float* cst;
    struct U { int type, pm, pn; };
    DEVI bool sched(int i, int bid, int nblk, U& r) const {
        const int u = i * nblk + bid;
        if (u < 384) { r.type = 0; r.pm = u / 3; r.pn = u % 3; return true; }
        if (u < 656) { const int v = u - 384; r.type = 1; r.pm = v >> 1; r.pn = v & 1; return true; }
        if (u < 928) { const int v = u - 656; r.type = 2; r.pm = v & 1; r.pn = v >> 1; return true; }
        return false; }
    DEVI int K(const U&) const { return 256; }
    DEVI const char* abase(const U& u) const { const size_t o = u.type == 0 ? WS_ZQ : (u.type == 1 ? WS_ZKVR : WS_WUV); return (const char*)ws + o + (size_t)u.pm * 256 * 512; }
    DEVI unsigned arow_off(const U&, int r) const { return (unsigned)r * 512u; }
    DEVI const char* bbase(const U& u) const { const size_t o = u.type == 0 ? WS_WUQ : (u.type == 1 ? WS_WUK : WS_ZKVR); return (const char*)ws + o + (size_t)u.pn * 256 * 512; }
    typedef NoPre Pre;
    DEVI void pre(const U&, int, int, Pre&) const {}
    DEVI void epi4(const U& u, int r, int cb, f32x4 v00, f32x4 v01, f32x4 v10, f32x4 v11, const Pre&) const {
        const int wc = cb >> 5, f4 = cb & 31;
        const LAS float* gqn = cst; const LAS float* gkn = cst + 64; const LAS float* gqr = cst + 128; const LAS float* rope = cst + 160;
        bf16_t* Q = (bf16_t*)(ws + WS_A); bf16_t* Kb = (bf16_t*)(ws + WS_K); bf16_t* VT = (bf16_t*)(ws + WS_VT);
        if (u.type == 2) {
            const int dv = u.pm * 256 + r, head = dv >> 6, d = dv & 63;
            int b, key0; size_t m0;
            if (u.pn < 128) { b = u.pn >> 4; key0 = CTXL + (u.pn & 15) * 256; m0 = (size_t)u.pn * 256; } else { b = u.pn - 128; key0 = 0; m0 = (size_t)u.pn * 256; }
            const int cbp = (cb & ~12) | ((cb & 4) << 1) | ((cb & 8) >> 1);
            bf16_t* vo = VT + ((size_t)(b * 8 + head) * 64 + d) * NKEY + key0 + cbp; (void)m0;
            store4bf(vo, v00); store4bf(vo + 16, v01); store4bf(vo + 128, v10); store4bf(vo + 144, v11);
            return;
        }
        const size_t m = (size_t)u.pm * 256 + r;
        if (u.type == 1) {
            float ss = dot4(v00) + dot4(v01) + dot4(v10) + dot4(v11); ss += swz_xor<16>(ss); ss = xor32_sum(ss);
            const float sc = rsqrtf(ss * (1.f / 64.f) + EPS);
            int b, key; if (u.pm < 128) { b = u.pm >> 4; key = CTXL + (int)(m & 4095); } else { b = u.pm - 128; key = r; }
            bf16_t* ko = Kb + ((size_t)(b * 8 + u.pn * 4 + wc) * NKEY + key) * 96 + f4; const LAS float* gp = gkn + f4;
            store4bf(ko, v00 * sc * *(const LAS f32x4*)gp); store4bf(ko + 16, v01 * sc * *(const LAS f32x4*)(gp + 16));
            store4bf(ko + 32, v10 * sc * *(const LAS f32x4*)(gp + 32)); store4bf(ko + 48, v11 * sc * *(const LAS f32x4*)(gp + 48));
            return;
        }
        const int b = (int)(m >> 12), t = (int)(m & 4095);
        if (u.pn < 2) {
            float ss = dot4(v00) + dot4(v01) + dot4(v10) + dot4(v11); ss += swz_xor<16>(ss); ss = xor32_sum(ss);
            const float sc = rsqrtf(ss * (1.f / 64.f) + EPS) * QSCALE;
            bf16_t* qo = Q + ((size_t)(b * 8 + u.pn * 4 + wc) * SEQ + t) * 96 + f4; const LAS float* gp = gqn + f4;
            store4bf(qo, v00 * sc * *(const LAS f32x4*)gp); store4bf(qo + 16, v01 * sc * *(const LAS f32x4*)(gp + 16));
            store4bf(qo + 32, v10 * sc * *(const LAS f32x4*)(gp + 32)); store4bf(qo + 48, v11 * sc * *(const LAS f32x4*)(gp + 48));
        } else {
            const int pos = f4 < 8 ? (t >> 6) : (t & 63); const LAS float* rp = rope + (pos * 8 + (f4 & 7)) * 2;
            const f32x4 c0 = *(const LAS f32x4*)rp, c1 = *(const LAS f32x4*)(rp + 4);
            const f32x4 cs = {c0.x, c0.z, c1.x, c1.z}, sn = {c0.y, c0.w, c1.y, c1.w};
            const f32x4 g1 = *(const LAS f32x4*)(gqr + f4), g2 = *(const LAS f32x4*)(gqr + 16 + f4);
            float s0 = dot4(v00) + dot4(v01), s1 = dot4(v10) + dot4(v11);
            s0 += swz_xor<16>(s0); s0 = xor32_sum(s0); s1 += swz_xor<16>(s1); s1 = xor32_sum(s1);
            const float sc0 = rsqrtf(s0 * (1.f / 32.f) + EPS) * QSCALE, sc1 = rsqrtf(s1 * (1.f / 32.f) + EPS) * QSCALE;
            { const f32x4 y1 = v00 * sc0 * g1, y2 = v01 * sc0 * g2; bf16_t* qo = Q + ((size_t)(b * 8 + wc) * SEQ + t) * 96 + 64 + f4;
              store4bf(qo, y1 * cs - y2 * sn); store4bf(qo + 16, y1 * sn + y2 * cs); }
            { const f32x4 y1 = v10 * sc1 * g1, y2 = v11 * sc1 * g2; bf16_t* qo = Q + ((size_t)(b * 8 + 4 + wc) * SEQ + t) * 96 + 64 + f4;
              store4bf(qo, y1 * cs - y2 * sn); store4bf(qo + 16, y1 * sn + y2 * cs); }
        }
    }
};


constexpr int RNN_XB = 32 * 272;
constexpr int RNN_HOFF = 4 * RNN_XB + 2048;
DEVI void phase_rnn_carry(const P& p, int bid, int nblk) {
    float* S = (float*)(p.ws + WS_RNNSUM);
    for (int id = bid * NTHR + tid_(); id < NB * 2 * 1024; id += nblk * NTHR) {
        const int ch = id & 1023, dir = (id >> 10) & 1, b = id >> 11;
        float* sp = S + ((size_t)(b * 2 + dir) * 34) * 2048 + ch;
        float A[34], B[34];
#pragma unroll
        for (int c = 0; c < 34; ++c) { A[c] = sp[c * 2048]; B[c] = sp[c * 2048 + 1024]; }
        float h = 0.f;
        if (dir == 0) {
#pragma unroll
            for (int k = 0; k < 34; ++k) { sp[k * 2048 + 1024] = h; h = fmaf(A[k], h, B[k]); }
        } else {
#pragma unroll
            for (int k = 0; k < 34; ++k) { const int c = k < 2 ? 1 - k : 35 - k; sp[c * 2048 + 1024] = h; h = fmaf(A[c], h, B[c]); }
        }
    }
}

DEVI void convert_tail(const P& p, int qidx, int e0, int e1, LAS unsigned char* lds) {
    const int tid = tid_(), lane = tid & 63, wave = tid >> 6;
    unsigned* cq = (unsigned*)(p.ws + WS_CTL) + 8192 + qidx * 64;
    volatile LAS unsigned* qs = (volatile LAS unsigned*)(lds + MISC_OFF) + 24;
    float* scr = (float*)(unsigned char*)lds + wave * (64 * 33);
    const int ne = e1 - e0, nbi = 2 * ne * 512 / 8;
    for (;;) {
        __syncthreads();
        if (tid == 0) qs[0] = __hip_atomic_fetch_add(cq, 1u, __ATOMIC_RELAXED, __HIP_MEMORY_SCOPE_AGENT);
        __syncthreads();
        const int bi = (int)qs[0];
        if (bi >= nbi) break;
        const int it = bi * 8 + wave, which = it / (ne * 512), r = it % (ne * 512), e = e0 + r / 512, t = r % 512, k0 = 64 * (t / 32), n0 = 32 * (t % 32);
        if (which == 0) transpose_item8(p.w_e_gate + (size_t)e * 1048576, 1024, 1024, p.ws + wgu_off(e), RmGU{0}, scr, k0, n0, lane);
        else transpose_item8(p.w_e_up + (size_t)e * 1048576, 1024, 1024, p.ws + wgu_off(e), RmGU{1}, scr, k0, n0, lane);
    }
    __syncthreads();
}

template <bool APPLY>
DEVI void phase_rnn(const P& p, int bid, int nblk, LAS unsigned char* lds) {
    const int tid = tid_(), wid = __builtin_amdgcn_readfirstlane(tid >> 6), lane = tid & 63, r = lane & 31, hh = lane >> 5;
    const int dir = wid >> 2, cg = wid & 3;
    const int n = bid & 7, bl = bid >> 3, nbl = (nblk - n + 7) >> 3;
    const bf16_t* z = (const bf16_t*)(p.ws + WS_ZRNN); float* S = (float*)(p.ws + WS_RNNSUM); bf16_t* gl = (bf16_t*)(p.ws + WS_GELU);
    const int ch = n * 128 + cg * 32 + r;
    bf16x8 wfa[8], wfx[8];
    { const bf16_t* wa = (const bf16_t*)(p.ws + WS_WRG) + ((size_t)((0 * 2 + dir) * 8 + n) * 128 + cg * 32 + r) * 128 + hh * 8;
      const bf16_t* wx = (const bf16_t*)(p.ws + WS_WRG) + ((size_t)((1 * 2 + dir) * 8 + n) * 128 + cg * 32 + r) * 128 + hh * 8;
#pragma unroll
      for (int ks = 0; ks < 8; ++ks) { wfa[ks] = *(const bf16x8*)(wa + ks * 16); wfx[ks] = *(const bf16x8*)(wx + ks * 16); } }
    const float eba = __builtin_amdgcn_exp2f(-1.4426950408889634f * p.rg_ba[dir * 1024 + ch]), ebx = __builtin_amdgcn_exp2f(-1.4426950408889634f * p.rg_bx[dir * 1024 + ch]), sp2 = ((const float*)(p.ws + WS_SP))[dir * 1024 + ch] * 1.4426950408889634f;
    const int t8 = tid & 255, c4 = t8 & 31, rgp = t8 >> 5, cch = n * 128 + c4 * 4;
    const f32x4 cw0 = *(const f32x4*)(p.conv_w + cch), cw1 = *(const f32x4*)(p.conv_w + 1024 + cch), cw2 = *(const f32x4*)(p.conv_w + 2048 + cch), cw3 = *(const f32x4*)(p.conv_w + 3072 + cch);
    const f32x4 cb = *(const f32x4*)(p.conv_b + cch);
    const int nitems = APPLY ? NB * 32 : NB * 34;
#define RNN_COORDS(li_, b_, c_, pos0_, len_, m0_) do { if (APPLY) { b_ = (li_) >> 5; c_ = 2 + ((li_) & 31); } else { b_ = (li_) / 34; c_ = (li_) % 34; } \
        if (c_ < 2) { pos0_ = c_ * 128; len_ = CTXL; m0_ = (size_t)NLAT + b_ * CTXL + pos0_; } else { pos0_ = (c_ - 2) * 128; len_ = SEQ; m0_ = (size_t)b_ * SEQ + pos0_; } } while (0)
#define RNN_LOADZ(pos0_, len_, m0_, st_) do { const int row0_ = (st_) * 32 + rgp * 4; _Pragma("unroll") for (int i = 0; i < 7; ++i) { const int pos_ = pos0_ + row0_ - 2 + i; zp[i] = (u32x2){0u, 0u}; \
        if (pos_ >= 0 && pos_ < len_) zp[i] = *(const u32x2*)(z + (m0_ + row0_ + i - 2) * 1024 + cch); } } while (0)
    u32x2 zp[7]; float hnext = 0.f;
    (void)bl; (void)nbl;
    unsigned* qhead = (unsigned*)(p.ws + WS_CTL) + 8192 + ((APPLY ? 8 : 0) + n) * 64;
    volatile LAS unsigned* qs = (volatile LAS unsigned*)(lds + MISC_OFF) + 24;
    if (tid == 0) { qs[0] = __hip_atomic_fetch_add(qhead, 1u, __ATOMIC_RELAXED, __HIP_MEMORY_SCOPE_AGENT); qs[1] = __hip_atomic_fetch_add(qhead, 1u, __ATOMIC_RELAXED, __HIP_MEMORY_SCOPE_AGENT); }
    __syncthreads();
    int li = (int)qs[0], lin = (int)qs[1], par = 0;
    if (li < nitems) { int b, c, pos0, len; size_t m0; RNN_COORDS(li, b, c, pos0, len, m0); RNN_LOADZ(pos0, len, m0, (dir ? 3 : 0));
        if (APPLY) hnext = S[((size_t)((b * 2 + dir) * 34 + c)) * 2048 + ch + 1024]; }
    for (; li < nitems; ) {
        unsigned drawn = 0u; if (tid == 0) drawn = __hip_atomic_fetch_add(qhead, 1u, __ATOMIC_RELAXED, __HIP_MEMORY_SCOPE_AGENT);
        int b, c, pos0, len; size_t m0; RNN_COORDS(li, b, c, pos0, len, m0);
        float* sp = S + ((size_t)((b * 2 + dir) * 34 + c)) * 2048 + ch;
        float h = APPLY ? hnext : 0.f, Ap = 1.f;
        for (int s = 0; s < 4; ++s) {
            const int st = dir ? 3 - s : s;
            LAS unsigned char* xb = lds + (dir * 2 + (s & 1)) * RNN_XB;
            {
                f32x4 zr[7];
#pragma unroll
                for (int i = 0; i < 7; ++i) zr[i] = (f32x4){bflo(zp[i].x), bfhi(zp[i].x), bflo(zp[i].y), bfhi(zp[i].y)};
#pragma unroll
                for (int o = 0; o < 4; ++o) { const f32x4 v = cb + cw0 * zr[o] + cw1 * zr[o + 1] + cw2 * zr[o + 2] + cw3 * zr[o + 3];
                    u32x2 w; w.x = pk2(v.x, v.y); w.y = pk2(v.z, v.w); *(LAS u32x2*)(xb + (rgp * 4 + o) * 272 + c4 * 8) = w; }
                if (s < 3) { RNN_LOADZ(pos0, len, m0, (dir ? 2 - s : s + 1)); }
                else if (lin < nitems) { int nb_, nc_, npos0, nlen; size_t nm0; RNN_COORDS(lin, nb_, nc_, npos0, nlen, nm0); RNN_LOADZ(npos0, nlen, nm0, (dir ? 3 : 0));
                    if (APPLY) hnext = S[((size_t)((nb_ * 2 + dir) * 34 + nc_)) * 2048 + ch + 1024]; }
            }
            if (s == 1 && tid == 0) qs[2 + par] = drawn;
            __syncthreads();
            f32x16 ar, ai;
            {   const f32x16 z16 = {0.f, 0.f, 0.f, 0.f, 0.f, 0.f, 0.f, 0.f, 0.f, 0.f, 0.f, 0.f, 0.f, 0.f, 0.f, 0.f};
                const bf16x8 af0 = *(const LAS bf16x8*)(xb + r * 272 + hh * 16);
                ar = __builtin_amdgcn_mfma_f32_32x32x16_bf16(af0, wfa[0], z16, 0, 0, 0);
                ai = __builtin_amdgcn_mfma_f32_32x32x16_bf16(af0, wfx[0], z16, 0, 0, 0); }
#pragma unroll
            for (int ks = 1; ks < 8; ++ks) {
                const bf16x8 af = *(const LAS bf16x8*)(xb + r * 272 + ks * 32 + hh * 16);
                ar = __builtin_amdgcn_mfma_f32_32x32x16_bf16(af, wfa[ks], ar, 0, 0, 0);
                ai = __builtin_amdgcn_mfma_f32_32x32x16_bf16(af, wfx[ks], ai, 0, 0, 0);
            }
            float a_[16], b_[16];
#pragma unroll
            for (int i = 0; i < 16; ++i) {
                const int row = (i & 3) + 8 * (i >> 2) + 4 * hh;
                const float xv = bf2f(*(const LAS bf16_t*)(xb + row * 272 + (cg * 32 + r) * 2));
                const float rr = __builtin_amdgcn_rcpf(fmaf(__builtin_amdgcn_exp2f(ar[i]), eba, 1.f)), ig = __builtin_amdgcn_rcpf(fmaf(__builtin_amdgcn_exp2f(ai[i]), ebx, 1.f));
                const float a = __builtin_amdgcn_exp2f(-sp2 * rr);
                a_[i] = a; b_[i] = __builtin_amdgcn_sqrtf(fmaxf(fmaf(-a, a, 1.f), 0.f)) * (ig * xv);
            }
            float gA[4], gB[4], fA[4], fB[4], sA[4], sB[4];
#pragma unroll
            for (int q = 0; q < 4; ++q) {
                if (dir == 0) { float hb = b_[4 * q]; hb = fmaf(a_[4 * q + 1], hb, b_[4 * q + 1]); hb = fmaf(a_[4 * q + 2], hb, b_[4 * q + 2]); hb = fmaf(a_[4 * q + 3], hb, b_[4 * q + 3]); gB[q] = hb; }
                else { float hb = b_[4 * q + 3]; hb = fmaf(a_[4 * q + 2], hb, b_[4 * q + 2]); hb = fmaf(a_[4 * q + 1], hb, b_[4 * q + 1]); hb = fmaf(a_[4 * q], hb, b_[4 * q]); gB[q] = hb; }
                gA[q] = (a_[4 * q] * a_[4 * q + 1]) * (a_[4 * q + 2] * a_[4 * q + 3]);
                const u32x2v ra = __builtin_amdgcn_permlane32_swap(__float_as_uint(gA[q]), __float_as_uint(gA[q]), false, false), rb = __builtin_amdgcn_permlane32_swap(__float_as_uint(gB[q]), __float_as_uint(gB[q]), false, false);
                fA[q] = __uint_as_float(ra[0]); sA[q] = __uint_as_float(ra[1]); fB[q] = __uint_as_float(rb[0]); sB[q] = __uint_as_float(rb[1]);
            }
            float hin[4];
#define RNN_STEP(q) do { if (dir == 0) { const float t1 = fmaf(fA[q], h, fB[q]), t2 = fmaf(sA[q], t1, sB[q]); hin[q] = hh ? t1 : h; h = t2; } \
                else { const float t1 = fmaf(sA[q], h, sB[q]), t2 = fmaf(fA[q], t1, fB[q]); hin[q] = hh ? h : t1; h = t2; } \
                if (!APPLY) Ap *= fA[q] * sA[q]; } while (0)
            if (dir == 0) { RNN_STEP(0); RNN_STEP(1); RNN_STEP(2); RNN_STEP(3); } else { RNN_STEP(3); RNN_STEP(2); RNN_STEP(1); RNN_STEP(0); }
#undef RNN_STEP
            if (APPLY) {
                LAS bf16_t* ht = (LAS bf16_t*)(lds + RNN_HOFF + dir * 32768) + (st * 32 + 4 * hh) * 128 + cg * 32 + r;
#pragma unroll
                for (int q = 0; q < 4; ++q) {
                    float hv = hin[q];
                    if (dir == 0) {
#pragma unroll
                        for (int e = 0; e < 4; ++e) { hv = fmaf(a_[4 * q + e], hv, b_[4 * q + e]); ht[(8 * q + e) * 128] = (bf16_t)(pk2(hv, 0.f) & 0xffffu); }
                    } else {
#pragma unroll
                        for (int e = 3; e >= 0; --e) { hv = fmaf(a_[4 * q + e], hv, b_[4 * q + e]); ht[(8 * q + e) * 128] = (bf16_t)(pk2(hv, 0.f) & 0xffffu); }
                    }
                }
            }
        }
        if (APPLY) {
            __syncthreads();
            const int row = tid >> 2, cs = (tid & 3) * 32;
            const LAS unsigned char* hf = lds + RNN_HOFF + row * 256 + cs * 2; const LAS unsigned char* hb = hf + 32768;
            bf16_t* gp = gl + (m0 + row) * 1024 + n * 128 + cs;
#pragma unroll
            for (int j = 0; j < 4; ++j) {
                const u32x4 f = *(const LAS u32x4*)(hf + j * 16), bk = *(const LAS u32x4*)(hb + j * 16), g = *(const u32x4*)(gp + j * 8);
                u32x4 o;
                o.x = pk2((bflo(f.x) + bflo(bk.x)) * bflo(g.x), (bfhi(f.x) + bfhi(bk.x)) * bfhi(g.x));
                o.y = pk2((bflo(f.y) + bflo(bk.y)) * bflo(g.y), (bfhi(f.y) + bfhi(bk.y)) * bfhi(g.y));
                o.z = pk2((bflo(f.z) + bflo(bk.z)) * bflo(g.z), (bfhi(f.z) + bfhi(bk.z)) * bfhi(g.z));
                o.w = pk2((bflo(f.w) + bflo(bk.w)) * bflo(g.w), (bfhi(f.w) + bfhi(bk.w)) * bfhi(g.w));
                *(u32x4*)(gp + j * 8) = o;
            }
        } else if (hh == 0) { sp[0] = Ap; sp[1024] = h; }
        li = lin; lin = (int)qs[2 + par]; par ^= 1;
    }
#undef RNN_COORDS
#undef RNN_LOADZ
    __syncthreads();
    if (nblk == 256) convert_tail(p, 16 + (APPLY ? 1 : 0), APPLY ? 10 : 6, APPLY ? 14 : 10, lds);
}

DEVI void phase_mla_pre(const P& p, int bid, int nblk) {
    const int tid = tid_(), lane = tid & 63, wave = tid >> 6;
    const bf16_t* zq = (const bf16_t*)(p.ws + WS_ZQ); const bf16_t* zkvr = (const bf16_t*)(p.ws + WS_ZKVR);
    bf16_t* Kb = (bf16_t*)(p.ws + WS_K);
    const float* rope = (const float*)(p.ws + WS_ROPE);
    const int NGW = nblk * 8, per = (NROW + NGW - 1) / NGW, m0 = (bid * 8 + wave) * per, m1 = (m0 + per < NROW) ? m0 + per : NROW;
    if (m0 >= m1) return;
    const float gk1 = lane < 16 ? p.g_k_rope[lane] : 0.f, gk2 = lane < 16 ? p.g_k_rope[16 + lane] : 0.f;
    u32x2 qn = {0u, 0u}, kn = {0u, 0u}; unsigned en = 0u;
#define MP_LOAD(m_) do { if ((m_) < NLAT) qn = gld8(zq + (size_t)(m_) * 256 + 4 * lane); if (lane < 32) { kn = gld8(zkvr + (size_t)(m_) * 256 + 4 * lane); en = *(const GAS unsigned short*)(zkvr + (size_t)(m_) * 256 + 128 + lane); } } while (0)
    MP_LOAD(m0);
    for (int m = m0; m < m1; ++m) {
        const u32x2 qc = qn, kc = kn; const float e = lane < 32 ? __uint_as_float(en << 16) : 0.f;
        if (m + 1 < m1) MP_LOAD(m + 1);
        if (m < NLAT) { const f32x4 v = {bflo(qc.x), bfhi(qc.x), bflo(qc.y), bfhi(qc.y)}; const float s = wave_sum(v.x * v.x + v.y * v.y + v.z * v.z + v.w * v.w);
            store4bf((bf16_t*)zq + (size_t)m * 256 + 4 * lane, v * rsqrtf(s * (1.f / 256.f) + EPS)); }
        const f32x4 kv4 = {bflo(kc.x), bfhi(kc.x), bflo(kc.y), bfhi(kc.y)};
        float s1 = 0.f; if (lane < 32) s1 = kv4.x * kv4.x + kv4.y * kv4.y + kv4.z * kv4.z + kv4.w * kv4.w;
        s1 = wave_sum(s1); if (lane < 32) store4bf((bf16_t*)zkvr + (size_t)m * 256 + 4 * lane, kv4 * rsqrtf(s1 * (1.f / 128.f) + EPS));
        const float rkr = rsqrtf(wave_sum(e * e) * (1.f / 32.f) + EPS);
        const float e2 = swz_xor<16>(e);
        if (lane < 16) {
            const float y1 = e * rkr * gk1, y2 = e2 * rkr * gk2;
            float cs = 1.f, sn = 0.f; int b, key;
            if (m < NLAT) { const int t = m & 4095; b = m >> 12; key = CTXL + t; const int pos = lane < 8 ? (t >> 6) : (t & 63); cs = rope[(pos * 8 + (lane & 7)) * 2]; sn = rope[(pos * 8 + (lane & 7)) * 2 + 1]; }
            else { b = (m - NLAT) >> 8; key = (m - NLAT) & 255; }
            const bf16_t o1 = (bf16_t)(pk2(y1 * cs - y2 * sn, 0.f) & 0xffffu), o2 = (bf16_t)(pk2(y1 * sn + y2 * cs, 0.f) & 0xffffu);
#pragma unroll
            for (int h = 0; h < 8; ++h) { bf16_t* kp = Kb + ((size_t)(b * 8 + h) * NKEY + key) * 96 + 64; kp[lane] = o1; kp[16 + lane] = o2; }
        }
    }
#undef MP_LOAD
}

template <bool SHIFT>
DEVI void attn_body(const P& p, int bid, int nblk, LAS unsigned char* lds, const float nshift) {
    const int tid = tid_(), wid = __builtin_amdgcn_readfirstlane(tid >> 6), lane = tid & 63, r = lane & 31, hh = lane >> 5;
    const bf16_t* Q = (const bf16_t*)(p.ws + WS_A); const bf16_t* Kb = (const bf16_t*)(p.ws + WS_K); const bf16_t* VT = (const bf16_t*)(p.ws + WS_VT);
    bf16_t* O = (bf16_t*)(p.ws + WS_ATTN);
    const int vcu = (nblk & 7) == 0 ? (bid & 7) * (nblk >> 3) + (bid >> 3) : bid;
    constexpr int KROW = 208, KBUF = 64 * KROW, VROW = 144, VBUF = 64 * VROW, BUFSZ = KBUF + VBUF, NT = NKEY / 64;
    unsigned ofs0, ofs1, ofs2;
    { const int q = wid * 64 + lane, c = q % 13; ofs0 = (unsigned)((q / 13) * 192 + (c < 12 ? c : 11) * 16); }
    if (wid < 5) { const int q = (wid + 8) * 64 + lane, c = q % 13; ofs1 = (unsigned)((q / 13) * 192 + (c < 12 ? c : 11) * 16); }
    else { const int q = (wid - 5) * 64 + lane, c = q % 9; ofs1 = (unsigned)((q / 9) * (NKEY * 2) + (c < 8 ? c : 7) * 16); }
    { const int q = (wid + 3) * 64 + lane, c = q % 9; ofs2 = (unsigned)((q / 9) * (NKEY * 2) + (c < 8 ? c : 7) * 16); }
    const unsigned d0 = (unsigned)wid * 1024u, d1 = wid < 5 ? (unsigned)(wid + 8) * 1024u : (unsigned)(KBUF + (wid - 5) * 1024), d2 = (unsigned)(KBUF + (wid + 3) * 1024);
#define AT_GLDS(src, dstoff) __builtin_amdgcn_global_load_lds((const unsigned*)(src), (LAS unsigned*)(lds + (dstoff)), 16, 0, 0)
#define AT_DMA(kg_, vg_, j_, boff_) do { const char* kt_ = uptr((kg_) + (size_t)(j_) * (64 * 192)); const char* vt_ = uptr((vg_) + (size_t)(j_) * 128); \
        AT_GLDS(kt_ + ofs0, (boff_) + d0); AT_GLDS((wid < 5 ? kt_ : vt_) + ofs1, (boff_) + d1); if (wid < 6) AT_GLDS(vt_ + ofs2, (boff_) + d2); } while (0)
#define AT_LDK(boff_, sub_) do { _Pragma("unroll") for (int ks = 0; ks < 6; ++ks) kf[ks] = *(const LAS bf16x8*)(lds + (boff_) + ((sub_) * 32 + r) * KROW + ks * 32 + hh * 16); } while (0)
#define SH_(x_) (SHIFT ? (x_) + nshift : (x_))
#define AT_EXP8(S_, LV_, PV_, o_, ONE_) do { const float e0 = __builtin_amdgcn_exp2f(SH_(S_[o_])), e1 = __builtin_amdgcn_exp2f(SH_(S_[o_ + 1])), e2 = __builtin_amdgcn_exp2f(SH_(S_[o_ + 2])), e3 = __builtin_amdgcn_exp2f(SH_(S_[o_ + 3])), \
        e4 = __builtin_amdgcn_exp2f(SH_(S_[o_ + 4])), e5 = __builtin_amdgcn_exp2f(SH_(S_[o_ + 5])), e6 = __builtin_amdgcn_exp2f(SH_(S_[o_ + 6])), e7 = __builtin_amdgcn_exp2f(SH_(S_[o_ + 7])); \
        LV_ = __builtin_fmaf(e7, ONE_, __builtin_fmaf(e6, ONE_, __builtin_fmaf(e5, ONE_, __builtin_fmaf(e4, ONE_, __builtin_fmaf(e3, ONE_, __builtin_fmaf(e2, ONE_, __builtin_fmaf(e1, ONE_, __builtin_fmaf(e0, ONE_, LV_)))))))); \
        PV_.x = pk2(e0, e1); PV_.y = pk2(e2, e3); PV_.z = pk2(e4, e5); PV_.w = pk2(e6, e7); } while (0)
#define AT_STEP(CA_, CB_, NA_, NB_, PP_, PC_, VPREV_, KNEXT_) do { \
        const LAS unsigned char* vp_ = (VPREV_); \
        const bf16x8 va0 = *(const LAS bf16x8*)(vp_), va1 = *(const LAS bf16x8*)(vp_ + 32), vb0 = *(const LAS bf16x8*)(vp_ + 32 * VROW), vb1 = *(const LAS bf16x8*)(vp_ + 32 * VROW + 32); \
        NA_ = __builtin_amdgcn_mfma_f32_32x32x16_bf16(kf[0], qf[0][0], zinit, 0, 0, 0); NB_ = __builtin_amdgcn_mfma_f32_32x32x16_bf16(kf[0], qf[1][0], zinit, 0, 0, 0); \
        NA_ = __builtin_amdgcn_mfma_f32_32x32x16_bf16(kf[1], qf[0][1], NA_, 0, 0, 0); NB_ = __builtin_amdgcn_mfma_f32_32x32x16_bf16(kf[1], qf[1][1], NB_, 0, 0, 0); \
        NA_ = __builtin_amdgcn_mfma_f32_32x32x16_bf16(kf[2], qf[0][2], NA_, 0, 0, 0); NB_ = __builtin_amdgcn_mfma_f32_32x32x16_bf16(kf[2], qf[1][2], NB_, 0, 0, 0); \
        NA_ = __builtin_amdgcn_mfma_f32_32x32x16_bf16(kf[3], qf[0][3], NA_, 0, 0, 0); NB_ = __builtin_amdgcn_mfma_f32_32x32x16_bf16(kf[3], qf[1][3], NB_, 0, 0, 0); \
        NA_ = __builtin_amdgcn_mfma_f32_32x32x16_bf16(kf[4], qf[0][4], NA_, 0, 0, 0); NB_ = __builtin_amdgcn_mfma_f32_32x32x16_bf16(kf[4], qf[1][4], NB_, 0, 0, 0); \
        NA_ = __builtin_amdgcn_mfma_f32_32x32x16_bf16(kf[5], qf[0][5], NA_, 0, 0, 0); NB_ = __builtin_amdgcn_mfma_f32_32x32x16_bf16(kf[5], qf[1][5], NB_, 0, 0, 0); \
        { const LAS unsigned char* kn_ = (KNEXT_); _Pragma("unroll") for (int ks = 0; ks < 6; ++ks) kf[ks] = *(const LAS bf16x8*)(kn_ + ks * 32); }     \
        { const bf16x8 pfa0 = __builtin_bit_cast(bf16x8, PP_[0]), pfa1 = __builtin_bit_cast(bf16x8, PP_[1]), pfb0 = __builtin_bit_cast(bf16x8, PP_[2]), pfb1 = __builtin_bit_cast(bf16x8, PP_[3]); \
        o[0][0] = __builtin_amdgcn_mfma_f32_32x32x16_bf16(va0, pfa0, o[0][0], 0, 0, 0); \
        o[1][0] = __builtin_amdgcn_mfma_f32_32x32x16_bf16(va0, pfb0, o[1][0], 0, 0, 0); \
        o[0][0] = __builtin_amdgcn_mfma_f32_32x32x16_bf16(va1, pfa1, o[0][0], 0, 0, 0); \
        o[1][0] = __builtin_amdgcn_mfma_f32_32x32x16_bf16(va1, pfb1, o[1][0], 0, 0, 0); \
        o[0][1] = __builtin_amdgcn_mfma_f32_32x32x16_bf16(vb0, pfa0, o[0][1], 0, 0, 0); \
        o[1][1] = __builtin_amdgcn_mfma_f32_32x32x16_bf16(vb0, pfb0, o[1][1], 0, 0, 0); \
        o[0][1] = __builtin_amdgcn_mfma_f32_32x32x16_bf16(vb1, pfa1, o[0][1], 0, 0, 0); \
        o[1][1] = __builtin_amdgcn_mfma_f32_32x32x16_bf16(vb1, pfb1, o[1][1], 0, 0, 0); } \
        AT_EXP8(CA_, l0v, PC_[0], 0, 1.0f); AT_EXP8(CA_, l0v, PC_[1], 8, 1.0f); AT_EXP8(CB_, l1v, PC_[2], 0, one_); AT_EXP8(CB_, l1v, PC_[3], 8, one_); \
        _Pragma("unroll") for (int g_ = 0; g_ < 4; ++g_) {   \
            __builtin_amdgcn_sched_group_barrier(0x008, 1, 0); __builtin_amdgcn_sched_group_barrier(0x400, 2, 0); __builtin_amdgcn_sched_group_barrier(0x002, 2, 0); \
            __builtin_amdgcn_sched_group_barrier(0x008, 1, 0); __builtin_amdgcn_sched_group_barrier(0x400, 1, 0); __builtin_amdgcn_sched_group_barrier(0x002, 3, 0); \
            __builtin_amdgcn_sched_group_barrier(0x008, 1, 0); __builtin_amdgcn_sched_group_barrier(0x400, 2, 0); __builtin_amdgcn_sched_group_barrier(0x002, 2, 0); \
            __builtin_amdgcn_sched_group_barrier(0x008, 1, 0); __builtin_amdgcn_sched_group_barrier(0x400, 1, 0); __builtin_amdgcn_sched_group_barrier(0x002, 3, 0); \
            __builtin_amdgcn_sched_group_barrier(0x008, 1, 0); __builtin_amdgcn_sched_group_barrier(0x400, 2, 0); __builtin_amdgcn_sched_group_barrier(0x002, 2, 0); } \
        asm volatile("" : "+v"(PC_[0]), "+v"(PC_[1]), "+v"(PC_[2]), "+v"(PC_[3]), "+v"(l0v), "+v"(l1v));   \
        __builtin_amdgcn_sched_barrier(0); \
    } while (0)
    f32x16 zinit;
#pragma unroll
    for (int i = 0; i < 16; ++i) zinit[i] = 0.f;
    float one_ = 1.0f; asm volatile("" : "+v"(one_));
    unsigned prv = 3u * BUFSZ, cur = 0u, nxt = (unsigned)BUFSZ, nn = 2u * BUFSZ;
    bool primed = false;
    for (int u = vcu; u < NB * 8 * 8; u += nblk) {
        const int bh = u >> 3, qb = u & 7;
        const bool more = u + nblk < NB * 8 * 8; const int bhn = more ? (u + nblk) >> 3 : bh;
        bf16x8 qf[2][6];
#pragma unroll
        for (int qs = 0; qs < 2; ++qs) { const bf16_t* qp = uptr(Q + ((size_t)bh * SEQ + qb * 512 + wid * 64 + qs * 32) * 96) + (unsigned)(r * 96 + hh * 8);
#pragma unroll
          for (int ks = 0; ks < 6; ++ks) { const u32x4 t = gld16(qp + ks * 16); qf[qs][ks] = __builtin_bit_cast(bf16x8, t); } }
        f32x16 o[2][2];
#pragma unroll
        for (int qs = 0; qs < 2; ++qs)
#pragma unroll
            for (int d = 0; d < 2; ++d)
#pragma unroll
                for (int i = 0; i < 16; ++i) o[qs][d][i] = 0.f;
        float l0v = 0.f, l1v = 0.f;
        const char* kg = uptr((const char*)(Kb + (size_t)bh * NKEY * 96)); const char* vg = uptr((const char*)(VT + (size_t)bh * 64 * NKEY));
        const char* kgn = uptr((const char*)(Kb + (size_t)bhn * NKEY * 96)); const char* vgn = uptr((const char*)(VT + (size_t)bhn * 64 * NKEY));
        if (!primed) {
            __syncthreads();
            AT_DMA(kg, vg, 0, cur); AT_DMA(kg, vg, 1, nxt);
            asm volatile("s_waitcnt vmcnt(0)" ::: "memory");
            __syncthreads();
        }
        bf16x8 kf[6];
        f32x16 sa = zinit, sb = zinit, ta, tb;
        AT_LDK(cur, 0);
#pragma unroll
        for (int ks = 0; ks < 6; ++ks) { sa = __builtin_amdgcn_mfma_f32_32x32x16_bf16(kf[ks], qf[0][ks], sa, 0, 0, 0); sb = __builtin_amdgcn_mfma_f32_32x32x16_bf16(kf[ks], qf[1][ks], sb, 0, 0, 0); }
        AT_LDK(cur, 1);
        u32x4 p0[4], p1[4];
#pragma unroll
        for (int i = 0; i < 4; ++i) p1[i] = (u32x4){0u, 0u, 0u, 0u};
        const unsigned vlane = (unsigned)(KBUF + r * VROW + hh * 16), klane = (unsigned)(r * KROW + hh * 16);
#pragma unroll 1
        for (int j = 0; j < NT; ++j) {
            asm volatile("s_waitcnt vmcnt(0)" ::: "memory"); __syncthreads();
            if (j + 2 < NT) AT_DMA(kg, vg, j + 2, nn); else if (more) AT_DMA(kgn, vgn, j + 2 - NT, nn);
            AT_STEP(sa, sb, ta, tb, p1, p0, lds + (j == 0 ? cur : prv + 64u) + vlane, lds + nxt + klane);
            AT_STEP(ta, tb, sa, sb, p0, p1, lds + cur + vlane, lds + nxt + 32 * KROW + klane);
            const unsigned t_ = prv; prv = cur; cur = nxt; nxt = nn; nn = t_;
        }
        {
            const LAS unsigned char* vp_ = lds + prv + 64u + vlane;
            const bf16x8 va0 = *(const LAS bf16x8*)(vp_), va1 = *(const LAS bf16x8*)(vp_ + 32), vb0 = *(const LAS bf16x8*)(vp_ + 32 * VROW), vb1 = *(const LAS bf16x8*)(vp_ + 32 * VROW + 32);
            const bf16x8 pfa0 = __builtin_bit_cast(bf16x8, p1[0]), pfa1 = __builtin_bit_cast(bf16x8, p1[1]), pfb0 = __builtin_bit_cast(bf16x8, p1[2]), pfb1 = __builtin_bit_cast(bf16x8, p1[3]);
            o[0][0] = __builtin_amdgcn_mfma_f32_32x32x16_bf16(va0, pfa0, o[0][0], 0, 0, 0);
            o[1][0] = __builtin_amdgcn_mfma_f32_32x32x16_bf16(va0, pfb0, o[1][0], 0, 0, 0);
            o[0][0] = __builtin_amdgcn_mfma_f32_32x32x16_bf16(va1, pfa1, o[0][0], 0, 0, 0);
            o[1][0] = __builtin_amdgcn_mfma_f32_32x32x16_bf16(va1, pfb1, o[1][0], 0, 0, 0);
            o[0][1] = __builtin_amdgcn_mfma_f32_32x32x16_bf16(vb0, pfa0, o[0][1], 0, 0, 0);
            o[1][1] = __builtin_amdgcn_mfma_f32_32x32x16_bf16(vb0, pfb0, o[1][1], 0, 0, 0);
            o[0][1] = __builtin_amdgcn_mfma_f32_32x32x16_bf16(vb1, pfa1, o[0][1], 0, 0, 0);
            o[1][1] = __builtin_amdgcn_mfma_f32_32x32x16_bf16(vb1, pfb1, o[1][1], 0, 0, 0);
        }
        primed = more;
        const float l0 = l0v, l1 = l1v;
        const int b = bh >> 3, h = bh & 7;
#pragma unroll
        for (int qs = 0; qs < 2; ++qs) {
            const float inv = 1.f / xor32_sum(qs ? l1 : l0);
            bf16_t* op = uptr(O + ((size_t)(b * SEQ + qb * 512 + wid * 64 + qs * 32)) * 512 + h * 64) + (unsigned)(r * 512 + 4 * hh);
#pragma unroll
            for (int g = 0; g < 4; ++g) {
                store4bf(op + 8 * g, (f32x4){o[qs][0][4 * g], o[qs][0][4 * g + 1], o[qs][0][4 * g + 2], o[qs][0][4 * g + 3]} * inv);
                store4bf(op + 32 + 8 * g, (f32x4){o[qs][1][4 * g], o[qs][1][4 * g + 1], o[qs][1][4 * g + 2], o[qs][1][4 * g + 3]} * inv);
            }
        }
    }
#undef AT_STEP
#undef AT_EXP8
#undef SH_
#undef AT_LDK
#undef AT_DMA
#undef AT_GLDS
}

DEVI void phase_attn(const P& p, int bid, int nblk, LAS unsigned char* lds) {
    const float smax = ((const float*)(p.ws + WS_SMAX))[0];
    if (smax <= 64.f) attn_body<false>(p, bid, nblk, lds, 0.f); else attn_body<true>(p, bid, nblk, lds, -smax);
}

DEVI f32x4 ldx4(const bf16_t* q) { const u32x2 w = gld8(q); return (f32x4){bflo(w.x), bfhi(w.x), bflo(w.y), bfhi(w.y)}; }
DEVI void phase_norm2_router(const P& p, int bid, int nblk, unsigned char* lds) {
    const bf16_t* xnb = (const bf16_t*)(p.ws + WS_XNB);
    const int tid = tid_(), lane = tid & 63, wave = __builtin_amdgcn_readfirstlane(tid >> 6);
    float* wrT = (float*)lds;
    float* gsS = wrT + 16384;
    for (int i = tid; i < 16384; i += NTHR) { const int k = i >> 4, e = i & 15; wrT[e * 1024 + k] = p.w_router[i]; }
    const float* mod = (const float*)(p.ws + WS_MOD); bf16_t* hb = (bf16_t*)(p.ws + WS_A); float* aff = (float*)(p.ws + WS_AFF);
    for (int i = tid; i < NB * 1024; i += NTHR) { const int bb = i >> 10, k = i & 1023; gsS[i] = p.g_norm2[k] * (mod[bb * 6144 + 4096 + k] + 1.f); gsS[NB * 1024 + i] = mod[bb * 6144 + 3072 + k]; }
    __syncthreads();
    const int NGW = nblk * 8, per = (NLAT + NGW - 1) / NGW, m0 = (bid * 8 + wave) * per, m1 = (m0 + per < NLAT) ? m0 + per : NLAT;
    if (m0 >= m1) return;
    const bool b4 = (lane & 16) != 0, b3 = (lane & 8) != 0, b2 = (lane & 4) != 0;
    f32x4 na[4], nb[4];
#pragma unroll
    for (int j = 0; j < 4; ++j) { na[j] = ldx4(uptr(xnb + (size_t)m0 * 1024) + (unsigned)(4 * lane) + 256 * j); nb[j] = ldx4(uptr(xnb + (size_t)(m0 + 1 < m1 ? m0 + 1 : m0) * 1024) + (unsigned)(4 * lane) + 256 * j); }
    for (int m = m0; m < m1; m += 2) {
        const bool two = m + 1 < m1;
        const int ma = m, mb = two ? m + 1 : m;
        f32x4 va[4], vb[4];
#pragma unroll
        for (int j = 0; j < 4; ++j) { va[j] = na[j]; vb[j] = nb[j]; }
        if (m + 2 < m1) { const int pa = m + 2, pb = (m + 3 < m1) ? m + 3 : m + 2;
#pragma unroll
            for (int j = 0; j < 4; ++j) { na[j] = ldx4(uptr(xnb + (size_t)pa * 1024) + (unsigned)(4 * lane) + 256 * j); nb[j] = ldx4(uptr(xnb + (size_t)pb * 1024) + (unsigned)(4 * lane) + 256 * j); } }
        float sa = 0.f, sb = 0.f;
#pragma unroll
        for (int j = 0; j < 4; ++j) { sa += va[j].x * va[j].x + va[j].y * va[j].y + va[j].z * va[j].z + va[j].w * va[j].w; sb += vb[j].x * vb[j].x + vb[j].y * vb[j].y + vb[j].z * vb[j].z + vb[j].w * vb[j].w; }
        const float ra = rsqrtf(wave_sum(sa) * (1.f / 1024.f) + EPS), rb = rsqrtf(wave_sum(sb) * (1.f / 1024.f) + EPS);
        const float* gpa = gsS + (ma >> 12) * 1024; const float* gpb = gsS + (mb >> 12) * 1024;
        f32x2 vv[4][4];
#pragma unroll
        for (int j = 0; j < 4; ++j) { const int k = 4 * (lane + 64 * j);
            const f32x4 xa = va[j] * ra * *(const f32x4*)(gpa + k) + *(const f32x4*)(gpa + NB * 1024 + k), xb = vb[j] * rb * *(const f32x4*)(gpb + k) + *(const f32x4*)(gpb + NB * 1024 + k);
            *(GAS unsigned*)(uptr((unsigned char*)hb + (size_t)ma * 1024) + (unsigned)(4 * lane) + 256 * j) = pk4f8(xa);
            if (two) *(GAS unsigned*)(uptr((unsigned char*)hb + (size_t)mb * 1024) + (unsigned)(4 * lane) + 256 * j) = pk4f8(xb);
            vv[j][0] = (f32x2){xa.x, xb.x}; vv[j][1] = (f32x2){xa.y, xb.y}; vv[j][2] = (f32x2){xa.z, xb.z}; vv[j][3] = (f32x2){xa.w, xb.w}; }
        f32x2 lg[16];
        unsigned wo = (unsigned)lane * 16u; asm volatile("" : "+v"(wo));
        const unsigned char* wb = (const unsigned char*)wrT + wo;
#pragma unroll
        for (int e = 0; e < 16; ++e) {
            f32x2 acc = {0.f, 0.f};
#pragma unroll
            for (int j = 0; j < 4; ++j) { const f32x4 w = *(const f32x4*)(wb + e * 4096 + j * 1024);
                acc += vv[j][0] * (f32x2){w.x, w.x}; acc += vv[j][1] * (f32x2){w.y, w.y}; acc += vv[j][2] * (f32x2){w.z, w.z}; acc += vv[j][3] * (f32x2){w.w, w.w}; }
            lg[e] = acc;
        }
#pragma unroll
        for (int r = 0; r < 2; ++r) {
            float r8[8], r4[4], r2[2];
#pragma unroll
            for (int e = 0; e < 8; ++e) { const u32x2v q = __builtin_amdgcn_permlane32_swap(__float_as_uint(r ? lg[e].y : lg[e].x), __float_as_uint(r ? lg[e + 8].y : lg[e + 8].x), false, false); r8[e] = __uint_as_float(q[0]) + __uint_as_float(q[1]); }
#pragma unroll
            for (int e = 0; e < 4; ++e) r4[e] = (b4 ? r8[e + 4] : r8[e]) + swz_xor<16>(b4 ? r8[e] : r8[e + 4]);
#pragma unroll
            for (int e = 0; e < 2; ++e) r2[e] = (b3 ? r4[e + 2] : r4[e]) + swz_xor<8>(b3 ? r4[e] : r4[e + 2]);
            float lgt = (b2 ? r2[1] : r2[0]) + swz_xor<4>(b2 ? r2[0] : r2[1]);
            lgt += swz_xor<2>(lgt); lgt += swz_xor<1>(lgt);
            const float mx = wave_max(lgt), ex = expf(lgt - mx), den = wave_sum(ex) * 0.25f;
            const int mr = r ? mb : ma, b = mr >> 12, t = mr & 4095;
            if ((r == 0 || two) && (lane & 3) == 0) *(GAS float*)(uptr(aff + (size_t)b * 16 * 4096 + t) + (unsigned)(((lane >> 2) & 15) * 4096)) = ex / den;
        }
    }
}

DEVI void phase_topk(const P& p, int bid, int nblk, unsigned char* lds) {
    const int tid = tid_(), lane = tid & 63, wave = tid >> 6;
    unsigned* hist = (unsigned*)lds; unsigned* sh = hist + 256;
    const float* aff = (const float*)(p.ws + WS_AFF); int* idx = (int*)(p.ws + WS_IDX); float* gate = (float*)(p.ws + WS_GATE); int* slot_of = (int*)(p.ws + WS_SLOT);
    for (int item = bid; item < NB * NE; item += nblk) {
        const float* a = aff + (size_t)item * 4096 + tid * 8;
        unsigned u[8];
        { const u32x4 t0 = *(const u32x4*)a, t1 = *(const u32x4*)(a + 4); u[0] = t0.x; u[1] = t0.y; u[2] = t0.z; u[3] = t0.w; u[4] = t1.x; u[5] = t1.y; u[6] = t1.z; u[7] = t1.w; }
        unsigned prefix = 0u, mask = 0u, need = CAP;
        for (int pass = 0; pass < 4; ++pass) {
            const int shift = 24 - 8 * pass;
            if (tid < 256) hist[tid] = 0u;
            __syncthreads();
#pragma unroll
            for (int j = 0; j < 8; ++j) if ((u[j] & mask) == prefix) atomicAdd(&hist[(u[j] >> shift) & 255u], 1u);
            __syncthreads();
            if (wave == 0) {
                const unsigned c0 = hist[255 - 4 * lane], c1 = hist[254 - 4 * lane], c2 = hist[253 - 4 * lane], c3 = hist[252 - 4 * lane], T4 = c0 + c1 + c2 + c3;
                unsigned inc = T4;
#pragma unroll
                for (int o = 1; o < 64; o <<= 1) { const unsigned n = (unsigned)__builtin_amdgcn_ds_bpermute(((lane - o) & 63) << 2, (int)inc); if (lane >= o) inc += n; }
                const unsigned exc = inc - T4;
                if (exc < need && need <= inc) {
                    unsigned cum = exc; int sel = 255 - 4 * lane;
                    if (cum + c0 < need) { cum += c0; --sel; if (cum + c1 < need) { cum += c1; --sel; if (cum + c2 < need) { cum += c2; --sel; } } }
                    sh[0] = (unsigned)sel; sh[1] = need - cum;
                }
            }
            __syncthreads();
            prefix |= sh[0] << shift; mask |= 255u << shift; need = sh[1];
            __syncthreads();
        }
        const unsigned T = prefix;
        unsigned cg = 0u, ce = 0u;
#pragma unroll
        for (int j = 0; j < 8; ++j) { cg += (u[j] > T) ? 1u : 0u; ce += (u[j] == T) ? 1u : 0u; }
        const unsigned packed = cg | (ce << 16);
        unsigned incl = packed;
#pragma unroll
        for (int o = 1; o < 64; o <<= 1) { const unsigned n = (unsigned)__builtin_amdgcn_ds_bpermute(((lane - o) & 63) << 2, (int)incl); if (lane >= o) incl += n; }
        if (lane == 63) sh[8 + wave] = incl;
        __syncthreads();
        unsigned woff = 0u;
        for (int w = 0; w < wave; ++w) woff += sh[8 + w];
        const unsigned excl = incl - packed + woff;
        unsigned gb = excl & 0xffffu, eb = excl >> 16;
#pragma unroll
        for (int j = 0; j < 8; ++j) {
            const int i = tid * 8 + j; const bool gt = u[j] > T, eq = u[j] == T;
            int slot = -1;
            if (gt) slot = (int)(gb + (eb < need ? eb : need));
            else if (eq && eb < need) slot = (int)(gb + eb);
            if (slot >= 0) { idx[item * CAP + slot] = i; gate[item * CAP + slot] = __uint_as_float(u[j]); }
            slot_of[(size_t)item * 4096 + i] = slot;
            gb += gt ? 1u : 0u; eb += eq ? 1u : 0u;
        }
        __syncthreads();
    }
}

DEVI void phase_combine(const P& p, int bid, int nblk) {
    const int tid = tid_(), lane = tid & 63, wave = tid >> 6;
    const float* mod = (const float*)(p.ws + WS_MOD); const int* slot_of = (const int*)(p.ws + WS_SLOT); const bf16_t* Y = (const bf16_t*)(p.ws + WS_Y);
    const int NGW = nblk * 8, per = (NLAT + NGW - 1) / NGW, m0 = (bid * 8 + wave) * per, m1 = (m0 + per < NLAT) ? m0 + per : NLAT;
    if (m0 >= m1) return;
    int sln = -1; f32x4 xn[4];
#define CB_LOAD(m_) do { sln = -1; if (lane < NE) sln = *(const GAS int*)(slot_of + ((size_t)(((m_) >> 12) * 16 + lane)) * 4096 + ((m_) & 4095)); \
        _Pragma("unroll") for (int j = 0; j < 4; ++j) xn[j] = ldx4((const bf16_t*)(p.ws + WS_XNB) + (size_t)(m_) * 1024 + 4 * (lane + 64 * j)); } while (0)
    CB_LOAD(m0);
    int bc = -1; f32x4 md[4];
    for (int m = m0; m < m1; ++m) {
        const int b = m >> 12;
        const int sl = sln; f32x4 xv[4], acc[4];
#pragma unroll
        for (int j = 0; j < 4; ++j) { xv[j] = xn[j]; acc[j] = (f32x4){0.f, 0.f, 0.f, 0.f}; }
        if (m + 1 < m1) CB_LOAD(m + 1);
        if (b != bc) { bc = b;
#pragma unroll
            for (int j = 0; j < 4; ++j) md[j] = gldf4(mod + b * 6144 + 5120 + 4 * (lane + 64 * j)); }
        unsigned long long mask = __ballot(sl >= 0);
        while (mask) {
            int e[4]; float w[4];
#pragma unroll
            for (int q = 0; q < 4; ++q) {
                if (mask) { e[q] = __builtin_ctzll(mask); mask &= mask - 1; w[q] = 1.f; } else { e[q] = e[0]; w[q] = 0.f; }
            }
            unsigned y[4][4];
#pragma unroll
            for (int q = 0; q < 4; ++q) {
                const int sq = __builtin_amdgcn_readlane(sl, e[q]);
                const unsigned char* yp = (const unsigned char*)Y + ((size_t)(b * 16 + e[q]) * CAP + sq) * 1024 + 4 * lane;
#pragma unroll
                for (int j = 0; j < 4; ++j) y[q][j] = *(const GAS unsigned*)(yp + 256 * j);
            }
#pragma unroll
            for (int q = 0; q < 4; ++q)
#pragma unroll
                for (int j = 0; j < 4; ++j) acc[j] += (f32x4){__builtin_amdgcn_cvt_f32_fp8(y[q][j], 0), __builtin_amdgcn_cvt_f32_fp8(y[q][j], 1), __builtin_amdgcn_cvt_f32_fp8(y[q][j], 2), __builtin_amdgcn_cvt_f32_fp8(y[q][j], 3)} * w[q];
        }
#pragma unroll
        for (int j = 0; j < 4; ++j) gstf4(p.out + (size_t)m * 1024 + 4 * (lane + 64 * j), xv[j] + md[j] * acc[j] * (1.f / 64.f));
    }
#undef CB_LOAD
}

template <int PH>
DEVI void run_phase(const P& p, int bid, int nblk, unsigned char* lds) {
    LAS unsigned char* l3 = (LAS unsigned char*)lds;
    if (PH == 0) { phase_prep(p, bid, nblk, lds);
        if (nblk == 256) { __syncthreads(); phase_expert_convert(p, 0, 192, bid, nblk, lds, 0, 1); } }
    if (PH == 1) phase_norm1(p, bid, nblk);
    if (PH == 2) { G1 g{(const bf16_t*)(p.ws + WS_A), (const bf16_t*)(p.ws + WS_WIN), (bf16_t*)(p.ws + WS_ZRNN), (bf16_t*)(p.ws + WS_GELU), (bf16_t*)(p.ws + WS_ZQ), (bf16_t*)(p.ws + WS_ZKVR), (bf16_t*)(p.ws + WS_G)}; G1g g8{p.ws + WS_A18, p.ws + WS_WIN8, (bf16_t*)(p.ws + WS_G)};
        if (bid & 8) { gemm_fast(g8, bid, nblk, l3); gemm_fast(g, bid, nblk, l3); } else { gemm_fast(g, bid, nblk, l3); gemm_fast(g8, bid, nblk, l3); }
        __syncthreads(); phase_expert_convert(p, 1, (nblk == 256 ? 40 : 0), bid, nblk, lds); }
    if (PH == 3) { phase_mla_pre(p, bid, nblk); phase_rnn<false>(p, bid, nblk, l3); }
    if (PH == 4) { phase_rnn_carry(p, bid, nblk);
        LAS float* cst = (LAS float*)(l3 + 131072);
        { const int tid = tid_(); const float* rope = (const float*)(p.ws + WS_ROPE);
          for (int i = tid; i < 160 + 1024; i += NTHR) cst[i] = i < 64 ? p.g_q_nope[i] : i < 128 ? p.g_k_nope[i - 64] : i < 160 ? p.g_q_rope[i - 128] : rope[i - 160]; }
        __syncthreads();
        GP4 g{p.ws, cst}; gemm_fast(g, bid, nblk, l3);
        if (nblk == 256) { __syncthreads(); phase_expert_convert(p, 0, 160, bid, nblk, lds, 1, 3); } }
    if (PH == 5) { phase_attn(p, bid, nblk, l3); __syncthreads(); phase_rnn<true>(p, bid, nblk, l3); }
    if (PH == 6) {
        if (nblk != 256 || !(bid & 8)) { phase_expert_convert(p, 0, 0, bid, nblk, lds, nblk == 256 ? E_EARLY : 0, 16); __syncthreads(); }
        G2 g{(const bf16_t*)(p.ws + WS_GELU), (const bf16_t*)(p.ws + WS_ATTN), (const bf16_t*)(p.ws + WS_WRNN), (const bf16_t*)(p.ws + WS_WMLA), (const bf16_t*)(p.ws + WS_G), (bf16_t*)(p.ws + WS_A)}; gemm_fast(g, bid, nblk, l3); }
    if (PH == 7) { if (nblk == 256 && (bid & 8)) { phase_expert_convert(p, 0, 0, bid, nblk, lds, E_EARLY, 16); __syncthreads(); }
        G3 g{(const bf16_t*)(p.ws + WS_A), (const bf16_t*)(p.ws + WS_WO), p.x, (const float*)(p.ws + WS_MOD), (bf16_t*)(p.ws + WS_XNB)}; gemm_fast(g, bid, nblk, l3); }
    if (PH == 8) phase_norm2_router(p, bid, nblk, lds);
    if (PH == 9) { phase_topk(p, bid, nblk, lds);
        if (nblk == 256) { __syncthreads(); phase_expert_convert(p, 0, 128, bid, nblk, lds, 3, 6); } }
    if (PH == 10) { GM1 g{p.ws + WS_A, p.ws, (const int*)(p.ws + WS_IDX), p.ws + WS_HID}; gemm_fast(g, bid, nblk, l3); }
    if (PH == 11) { GM2 g{p.ws + WS_HID, p.ws + WS_WD, (const float*)(p.ws + WS_GATE), (bf16_t*)(p.ws + WS_Y)}; gemm_fast(g, bid, nblk, l3); }
    if (PH == 12) phase_combine(p, bid, nblk);
}

#define XB_TMO      128
#define XB_XCNT(j)  (256  + 64 * (j))
#define XB_XSUB(j)  (1280 + 64 * (j))
#define XB_XGEN(j)  (2304 + 64 * (j))
#define XB_TOP      3328
#define XB_TOPGEN   3392
#define XCD_BAR_WORDS 3456
#define XB_SPIN_CAP (1u << 20)
DEVI unsigned xb_ld(unsigned* p)              { return __hip_atomic_load(p, __ATOMIC_RELAXED, __HIP_MEMORY_SCOPE_AGENT); }
DEVI unsigned xb_add(unsigned* p, unsigned v) { return __hip_atomic_fetch_add(p, v, __ATOMIC_RELAXED, __HIP_MEMORY_SCOPE_AGENT); }
DEVI unsigned xb_xcc_id() { return (unsigned)__builtin_amdgcn_s_getreg((3 << 11) | 20) & 0xFu; }
#define XB_SPIN(cond, bar) do { unsigned _sp = 0; while (cond) { __builtin_amdgcn_s_sleep(1); \
    if ((++_sp & 255u) == 0u) { if (xb_ld(&(bar)[XB_TMO])) break; if (_sp > XB_SPIN_CAP) { atomicAdd(&(bar)[XB_TMO], 1u); break; } } } } while (0)
struct XcdBarrier { unsigned* bar; unsigned x; volatile LAS unsigned* st; };
DEVI XcdBarrier xcd_barrier_post(unsigned* bar, volatile LAS unsigned* st) {
    XcdBarrier b; b.bar = bar; b.x = xb_xcc_id(); b.st = st;
    if (threadIdx.x == 0) (void)xb_add(&bar[XB_XCNT(b.x)], 1u);
    return b;
}
DEVI void xcd_barrier_complete(unsigned* bar, unsigned x, unsigned& nloc, unsigned& nx) {
    const unsigned G = gridDim.x * gridDim.y * gridDim.z;
    unsigned sum, cnt, mine, sp = 0u;
    for (;;) {
        sum = 0u; cnt = 0u; mine = 0u;
#pragma unroll
        for (unsigned j = 0; j < 16; ++j) { const unsigned c = xb_ld(&bar[XB_XCNT(j)]); sum += c; cnt += (c > 0u) ? 1u : 0u; mine = (j == x) ? c : mine; }
        if (sum == G) break;
        __builtin_amdgcn_s_sleep(1);
        if ((++sp & 255u) == 0u) { if (xb_ld(&bar[XB_TMO])) break; if (sp > XB_SPIN_CAP) { atomicAdd(&bar[XB_TMO], 1u); break; } }
    }
    nloc = mine > 0u ? mine : 1u; nx = cnt > 0u ? cnt : 1u;
}
DEVI void xcd_barrier(const XcdBarrier& b) {
    asm volatile("s_waitcnt vmcnt(0)" ::: "memory");
    __syncthreads();
    if (threadIdx.x == 0) {
        unsigned* bar = b.bar;
        __builtin_amdgcn_s_waitcnt(0);
        unsigned nloc = b.st[0], nx = b.st[1];
        if (nloc == 0u) { xcd_barrier_complete(bar, b.x, nloc, nx); b.st[0] = nloc; b.st[1] = nx; }
        const unsigned old = xb_add(&bar[XB_XSUB(b.x)], 1u);
        const unsigned gen = old / nloc;
        if (old + 1u == (gen + 1u) * nloc) {
            __builtin_amdgcn_fence(__ATOMIC_RELEASE, "agent");
            asm volatile("s_waitcnt vmcnt(0)" ::: "memory");
            const unsigned og = xb_add(&bar[XB_TOP], 1u);
            const unsigned tg = og / nx;
            if (og + 1u == (tg + 1u) * nx) xb_add(&bar[XB_TOPGEN], 1u);
            else XB_SPIN(xb_ld(&bar[XB_TOPGEN]) == tg, bar);
            __builtin_amdgcn_fence(__ATOMIC_ACQUIRE, "agent");
            xb_add(&bar[XB_XGEN(b.x)], 1u);
            asm volatile("s_waitcnt vmcnt(0)" ::: "memory");
        } else {
            XB_SPIN(xb_ld(&bar[XB_XGEN(b.x)]) == gen, bar);
            __builtin_amdgcn_fence(__ATOMIC_ACQUIRE, "agent");
            asm volatile("s_waitcnt vmcnt(0)" ::: "memory");
        }
    }
    __syncthreads();
}

constexpr int CW_BAR = 4096;

constexpr unsigned PROBE_MASK = 0u;
__global__ void __launch_bounds__(NTHR, 2) mega_fwd(P p) {
    extern __shared__ __attribute__((aligned(16))) unsigned char lds[];
    const int bid = (int)blockIdx.x, nblk = (int)gridDim.x;
    volatile LAS unsigned* MISC = (volatile LAS unsigned*)((LAS unsigned char*)lds + MISC_OFF);
    if (threadIdx.x < 32) MISC[threadIdx.x] = 0u;
    if ((threadIdx.x & 63) == 0) MISC[32 + hw_slot_()] = threadIdx.x >> 6;
    __syncthreads();
    XcdBarrier bar = xcd_barrier_post((unsigned*)(p.ws + WS_CTL) + CW_BAR, MISC + 8);
    unsigned long long t_prev = 0ull;
    if (PROBE_MASK) t_prev = __builtin_amdgcn_s_memrealtime();
#define SEAM(k) do { xcd_barrier(bar); asm volatile("" : "+s"(p.ws)); \
    if (PROBE_MASK) { const unsigned long long t1_ = __builtin_amdgcn_s_memrealtime(); \
        if ((PROBE_MASK >> (k)) & 1u) { const unsigned long long d_ = t1_ - t_prev; while (__builtin_amdgcn_s_memrealtime() - t1_ < d_) __builtin_amdgcn_s_sleep(8); } \
        t_prev = __builtin_amdgcn_s_memrealtime(); } } while (0)
    run_phase<0>(p, bid, nblk, lds); SEAM(0);
    run_phase<1>(p, bid, nblk, lds); SEAM(1);
    run_phase<2>(p, bid, nblk, lds); SEAM(2);
    run_phase<3>(p, bid, nblk, lds); SEAM(3);
    run_phase<4>(p, bid, nblk, lds); SEAM(4);
    run_phase<5>(p, bid, nblk, lds); SEAM(5);
    run_phase<6>(p, bid, nblk, lds); SEAM(6);
    run_phase<7>(p, bid, nblk, lds); SEAM(7);
    run_phase<8>(p, bid, nblk, lds); SEAM(8);
    run_phase<9>(p, bid, nblk, lds); SEAM(9);
    run_phase<10>(p, bid, nblk, lds); SEAM(10);
    run_phase<11>(p, bid, nblk, lds); SEAM(11);
    run_phase<12>(p, bid, nblk, lds);
    if (PROBE_MASK) SEAM(12);
#undef SEAM
}

extern "C" void kernel_launch(void* const* d_in, const int* in_sizes, int n_in, void* d_out, int out_size, void* d_ws, size_t ws_size, hipStream_t stream) {
    static int grid = 0;
    if (grid == 0) {
        if (n_in != 32 || ws_size < WS_END) { fprintf(stderr, "kernel_launch: unexpected n_in %d / ws_size %zu\n", n_in, ws_size); grid = -1; return; }
        int dev = 0, cus = 0, per_cu = 0;
        if (hipGetDevice(&dev) != hipSuccess || hipDeviceGetAttribute(&cus, hipDeviceAttributeMultiprocessorCount, dev) != hipSuccess) { grid = -1; return; }
        if (hipFuncSetAttribute((const void*)mega_fwd, hipFuncAttributeMaxDynamicSharedMemorySize, LDS_BYTES) != hipSuccess) { fprintf(stderr, "kernel_launch: hipFuncSetAttribute failed\n"); grid = -1; return; }
        if (hipOccupancyMaxActiveBlocksPerMultiprocessor(&per_cu, (const void*)mega_fwd, NTHR, LDS_BYTES) != hipSuccess || per_cu < 1) { fprintf(stderr, "kernel_launch: occupancy query says %d\n", per_cu); }
        (void)hipGetLastError();
        grid = cus;
    }
    if (grid < 0) return;
    P p{};
    const float** fp = (const float**)&p;
    for (int i = 0; i < 32; ++i) fp[i] = (const float*)d_in[i];
    p.out = (float*)d_out; p.ws = (unsigned char*)d_ws;
    (void)hipMemsetAsync((char*)d_ws + WS_CTL, 0, 64 * 1024, stream);
    hipLaunchKernelGGL(mega_fwd, dim3(grid), dim3(NTHR), LDS_BYTES, stream, p);
}
```
